# Optimizing an MI355X kernel written in HIP

```python
import math
import jax, jax.numpy as jnp
from jax import lax
import numpy as np

D_MODEL = 2048
BATCH = 2
SEQ = 4096
DEPTH = 1
DEC_BATCH = 128
DEC_SEQ = 8
PAST_LEN = 8192
PAGE_SIZE = 128

SSM_WIDTH = D_MODEL // 4
SSM_GROUP = 16
SSM_GROUPS = SSM_WIDTH // SSM_GROUP
SSM_STATE = 64
MLA_HEADS = 8
MLA_NOPE = 128
MLA_ROPE = 64
MLA_QK = MLA_NOPE + MLA_ROPE
MLA_V = 128
MLA_WIDTH = MLA_HEADS * MLA_V
Q_LORA = D_MODEL // 4
KV_LORA = D_MODEL // 8
ROPE_THETA = 10000.0
MEM_TOKENS = 256
MEM_HEADS = 4
MEM_HEAD_DIM = 128
MEM_WIDTH = MEM_HEADS * MEM_HEAD_DIM
MIX_WIDTH = SSM_WIDTH + MLA_WIDTH + MEM_WIDTH
Q_BLOCK = 128
EPS = 1e-6
NEG_INF = -1e30
F32 = jnp.float32

IN_SIZES = (SSM_WIDTH, SSM_WIDTH, Q_LORA, KV_LORA, MLA_ROPE, MLA_WIDTH, MEM_WIDTH, MEM_WIDTH)
IN_WIDTH = sum(IN_SIZES)
IN_SPLITS = tuple(int(s) for s in np.cumsum(IN_SIZES)[:-1])

kernel_name = 'hymba_s5_mla_memxattn_step'


def rmsnorm(x, g):
    xf = x.astype(F32)
    xf = xf * lax.rsqrt(jnp.mean(xf * xf, axis=-1, keepdims=True) + EPS)
    return xf.astype(x.dtype) * g.astype(x.dtype)


def rope(x, pos):
    half = x.shape[-1] // 2
    inv_freq = ROPE_THETA ** (-jnp.arange(half, dtype=F32) / half)
    ang = pos.astype(F32)[:, None] * inv_freq[None, :]
    shape = (pos.shape[0],) + (1,) * (x.ndim - 3) + (half,)
    cos = jnp.cos(ang).reshape(shape).astype(x.dtype)
    sin = jnp.sin(ang).reshape(shape).astype(x.dtype)
    x1, x2 = x[..., :half], x[..., half:]
    return jnp.concatenate([x1 * cos - x2 * sin, x1 * sin + x2 * cos], axis=-1)


def attend(q, k, v, q_pos, k_pos):
    s = jnp.einsum('bqhd,bkhd->bhqk', q, k, preferred_element_type=F32) * (q.shape[-1] ** -0.5)
    s = jnp.where(k_pos[None, :] <= q_pos[:, None], s, NEG_INF)
    pr = jax.nn.softmax(s, axis=-1).astype(v.dtype)
    return jnp.einsum('bhqk,bkhd->bqhd', pr, v)


def in_projection(x, p):
    z = rmsnorm(x, p['norm_g']) @ p['w_in']
    return jnp.split(z, IN_SPLITS, axis=-1)


def ssm_mixer(u, h0_re, h0_im, p):
    B, T, _ = u.shape
    dt = jnp.exp(p['ssm_log_dt'].astype(F32))[:, None]
    ar, ai = p['ssm_a_re'].astype(F32), p['ssm_a_im'].astype(F32)
    mag = jnp.exp(dt * ar)
    abar_re, abar_im = mag * jnp.cos(dt * ai), mag * jnp.sin(dt * ai)
    den = ar * ar + ai * ai
    nr, ni = abar_re - 1.0, abar_im
    f_re = ((nr * ar + ni * ai) / den)[..., None]
    f_im = ((ni * ar - nr * ai) / den)[..., None]
    b_re, b_im = p['ssm_b_re'].astype(F32), p['ssm_b_im'].astype(F32)
    bbar_re = f_re * b_re - f_im * b_im
    bbar_im = f_re * b_im + f_im * b_re
    uf = u.astype(F32)
    ug = uf.reshape(B, T, SSM_GROUPS, SSM_GROUP)
    bu_re = jnp.einsum('btgp,gnp->btgn', ug, bbar_re)
    bu_im = jnp.einsum('btgp,gnp->btgn', ug, bbar_im)
    a_re = jnp.broadcast_to(abar_re, bu_re.shape)
    a_im = jnp.broadcast_to(abar_im, bu_re.shape)

    def combine(l, r):
        a1r, a1i, b1r, b1i = l
        a2r, a2i, b2r, b2i = r
        return (a2r * a1r - a2i * a1i, a2r * a1i + a2i * a1r,
                a2r * b1r - a2i * b1i + b2r, a2r * b1i + a2i * b1r + b2i)

    acr, aci, xr, xi = lax.associative_scan(combine, (a_re, a_im, bu_re, bu_im), axis=1)
    h0r = h0_re.astype(F32)[:, None]
    h0i = h0_im.astype(F32)[:, None]
    xr = xr + acr * h0r - aci * h0i
    xi = xi + acr * h0i + aci * h0r
    y = (jnp.einsum('btgn,gpn->btgp', xr, p['ssm_c_re'].astype(F32))
         - jnp.einsum('btgn,gpn->btgp', xi, p['ssm_c_im'].astype(F32)))
    y = y.reshape(B, T, SSM_WIDTH) + p['ssm_d'].astype(F32) * uf
    g = jax.nn.gelu(y)
    y = g * jax.nn.sigmoid(g @ p['ssm_glu_w'].astype(F32) + p['ssm_glu_b'].astype(F32))
    return y.astype(u.dtype), xr[:, -1].astype(h0_re.dtype), xi[:, -1].astype(h0_im.dtype)


def mla_project(cq, ckv, kr, pos, p):
    B, T, _ = cq.shape
    q = (rmsnorm(cq, p['mla_q_norm_g']) @ p['mla_w_uq']).reshape(B, T, MLA_HEADS, MLA_QK)
    q = jnp.concatenate([q[..., :MLA_NOPE], rope(q[..., MLA_NOPE:], pos)], axis=-1)
    q = rmsnorm(q, p['mla_qk_norm_q'])
    return q, rmsnorm(ckv, p['mla_kv_norm_g']), rope(kr, pos)


def mla_keys(ckv, kr, p):
    B, T, _ = ckv.shape
    kv = (ckv @ p['mla_w_ukv']).reshape(B, T, MLA_HEADS, MLA_NOPE + MLA_V)
    k = jnp.concatenate([kv[..., :MLA_NOPE],
                         jnp.broadcast_to(kr[:, :, None, :], (B, T, MLA_HEADS, MLA_ROPE))], axis=-1)
    return rmsnorm(k, p['mla_qk_norm_k']), kv[..., MLA_NOPE:]


def mem_kv(mem, p):
    B, M, _ = mem.shape
    m = rmsnorm(mem, p['mem_norm_g'])
    k = rmsnorm((m @ p['mem_w_k']).reshape(B, M, MEM_HEADS, MEM_HEAD_DIM), p['mem_qk_norm_k'])
    v = (m @ p['mem_w_v']).reshape(B, M, MEM_HEADS, MEM_HEAD_DIM)
    return k, v


def mem_attend(qm, mk, mv, p):
    B, T, _ = qm.shape
    q = rmsnorm(qm.reshape(B, T, MEM_HEADS, MEM_HEAD_DIM), p['mem_qk_norm_q'])
    s = jnp.einsum('bqhd,bkhd->bhqk', q, mk, preferred_element_type=F32) * (MEM_HEAD_DIM ** -0.5)
    pr = jax.nn.softmax(s, axis=-1).astype(mv.dtype)
    return jnp.einsum('bhqk,bkhd->bqhd', pr, mv).reshape(B, T, MEM_WIDTH)


def merge(x, y_ssm, y_mla, y_mem, g_ssm, g_mla, g_mem, p):
    o = jnp.concatenate([rmsnorm(y_ssm, p['out_norm_ssm']) * jax.nn.silu(g_ssm),
                         rmsnorm(y_mla, p['out_norm_mla']) * jax.nn.silu(g_mla),
                         rmsnorm(y_mem, p['out_norm_mem']) * jax.nn.silu(g_mem)], axis=-1)
    return x + o @ p['w_out']


def setup_inputs(seed: int = 0) -> dict:
    key = jax.random.key(seed)
    ks = iter(jax.random.split(key, 64))

    def nrm(shape, scale):
        return jax.random.normal(next(ks), shape, F32) * scale

    def gain(n):
        return 1.0 + nrm((n,), 0.01)

    n_pages = PAST_LEN // PAGE_SIZE
    n_used = DEC_BATCH * n_pages
    n_pool = (n_used * 5) // 4
    inp = {}
    inp['x_prompt'] = nrm((BATCH, SEQ, D_MODEL), 1.0)
    inp['x_sample'] = nrm((DEC_BATCH, DEC_SEQ, D_MODEL), 1.0)
    inp['mem_prompt'] = nrm((BATCH, MEM_TOKENS, D_MODEL), 1.0)
    inp['cache_ckv'] = nrm((n_pool, PAGE_SIZE, KV_LORA), 1.0)
    inp['cache_krope'] = nrm((n_pool, PAGE_SIZE, MLA_ROPE), 1.0)
    inp['cache_mem_k'] = nrm((DEC_BATCH, MEM_TOKENS, MEM_HEADS, MEM_HEAD_DIM), 1.0)
    inp['cache_mem_v'] = nrm((DEC_BATCH, MEM_TOKENS, MEM_HEADS, MEM_HEAD_DIM), 1.0)
    inp['state_ssm_re'] = nrm((DEC_BATCH, SSM_GROUPS, SSM_STATE), 1.0)
    inp['state_ssm_im'] = nrm((DEC_BATCH, SSM_GROUPS, SSM_STATE), 1.0)
    inp['page_table'] = jax.random.permutation(next(ks), n_pool)[:n_used].reshape(DEC_BATCH, n_pages).astype(jnp.int32)
    inp['norm_g'] = gain(D_MODEL)
    inp['w_in'] = nrm((D_MODEL, IN_WIDTH), D_MODEL ** -0.5)
    inp['ssm_a_re'] = -0.5 + nrm((SSM_GROUPS, SSM_STATE), 0.01)
    inp['ssm_a_im'] = math.pi * jnp.arange(SSM_STATE, dtype=F32)[None, :] + nrm((SSM_GROUPS, SSM_STATE), 0.01)
    inp['ssm_log_dt'] = jax.random.uniform(next(ks), (SSM_GROUPS,), F32, math.log(1e-3), math.log(1e-1))
    inp['ssm_b_re'] = nrm((SSM_GROUPS, SSM_STATE, SSM_GROUP), (2.0 * SSM_GROUP) ** -0.5)
    inp['ssm_b_im'] = nrm((SSM_GROUPS, SSM_STATE, SSM_GROUP), (2.0 * SSM_GROUP) ** -0.5)
    inp['ssm_c_re'] = nrm((SSM_GROUPS, SSM_GROUP, SSM_STATE), (2.0 * SSM_STATE) ** -0.5)
    inp['ssm_c_im'] = nrm((SSM_GROUPS, SSM_GROUP, SSM_STATE), (2.0 * SSM_STATE) ** -0.5)
    inp['ssm_d'] = 1.0 + nrm((SSM_WIDTH,), 0.1)
    inp['ssm_glu_w'] = nrm((SSM_WIDTH, SSM_WIDTH), SSM_WIDTH ** -0.5)
    inp['ssm_glu_b'] = nrm((SSM_WIDTH,), 0.01)
    inp['mla_q_norm_g'] = gain(Q_LORA)
    inp['mla_w_uq'] = nrm((Q_LORA, MLA_HEADS * MLA_QK), Q_LORA ** -0.5)
    inp['mla_kv_norm_g'] = gain(KV_LORA)
    inp['mla_w_ukv'] = nrm((KV_LORA, MLA_HEADS * (MLA_NOPE + MLA_V)), KV_LORA ** -0.5)
    inp['mla_qk_norm_q'] = gain(MLA_QK)
    inp['mla_qk_norm_k'] = gain(MLA_QK)
    inp['mem_norm_g'] = gain(D_MODEL)
    inp['mem_w_k'] = nrm((D_MODEL, MEM_WIDTH), D_MODEL ** -0.5)
    inp['mem_w_v'] = nrm((D_MODEL, MEM_WIDTH), D_MODEL ** -0.5)
    inp['mem_qk_norm_q'] = gain(MEM_HEAD_DIM)
    inp['mem_qk_norm_k'] = gain(MEM_HEAD_DIM)
    inp['out_norm_ssm'] = gain(SSM_WIDTH)
    inp['out_norm_mla'] = gain(MLA_WIDTH)
    inp['out_norm_mem'] = gain(MEM_WIDTH)
    inp['w_out'] = nrm((MIX_WIDTH, D_MODEL), MIX_WIDTH ** -0.5)
    return inp


def reference(x_prompt, x_sample, mem_prompt, cache_ckv, cache_krope, cache_mem_k, cache_mem_v,
              state_ssm_re, state_ssm_im, page_table,
              norm_g, w_in, ssm_a_re, ssm_a_im, ssm_log_dt, ssm_b_re, ssm_b_im, ssm_c_re, ssm_c_im,
              ssm_d, ssm_glu_w, ssm_glu_b,
              mla_q_norm_g, mla_w_uq, mla_kv_norm_g, mla_w_ukv, mla_qk_norm_q, mla_qk_norm_k,
              mem_norm_g, mem_w_k, mem_w_v, mem_qk_norm_q, mem_qk_norm_k,
              out_norm_ssm, out_norm_mla, out_norm_mem, w_out):
    p = dict(norm_g=norm_g, w_in=w_in, ssm_a_re=ssm_a_re, ssm_a_im=ssm_a_im, ssm_log_dt=ssm_log_dt,
             ssm_b_re=ssm_b_re, ssm_b_im=ssm_b_im, ssm_c_re=ssm_c_re, ssm_c_im=ssm_c_im,
             ssm_d=ssm_d, ssm_glu_w=ssm_glu_w, ssm_glu_b=ssm_glu_b,
             mla_q_norm_g=mla_q_norm_g, mla_w_uq=mla_w_uq, mla_kv_norm_g=mla_kv_norm_g,
             mla_w_ukv=mla_w_ukv, mla_qk_norm_q=mla_qk_norm_q, mla_qk_norm_k=mla_qk_norm_k,
             mem_norm_g=mem_norm_g, mem_w_k=mem_w_k, mem_w_v=mem_w_v,
             mem_qk_norm_q=mem_qk_norm_q, mem_qk_norm_k=mem_qk_norm_k,
             out_norm_ssm=out_norm_ssm, out_norm_mla=out_norm_mla, out_norm_mem=out_norm_mem,
             w_out=w_out)

    B = x_prompt.shape[0]
    pos_p = jnp.arange(SEQ, dtype=jnp.int32)
    u, g_ssm, cq, ckv, kr, g_mla, qm, g_mem = in_projection(x_prompt, p)
    h0 = jnp.zeros((B, SSM_GROUPS, SSM_STATE), x_prompt.dtype)
    y_ssm_p, ssm_re_p, ssm_im_p = ssm_mixer(u, h0, h0, p)
    q_p, ckv_p, kr_p = mla_project(cq, ckv, kr, pos_p, p)
    k_p, v_p = mla_keys(ckv_p, kr_p, p)
    nb = SEQ // Q_BLOCK
    qb = q_p.reshape(B, nb, Q_BLOCK, MLA_HEADS, MLA_QK).transpose(1, 0, 2, 3, 4)
    ob = lax.map(lambda a: attend(a[0], k_p, v_p, a[1], pos_p), (qb, pos_p.reshape(nb, Q_BLOCK)))
    y_mla_p = ob.transpose(1, 0, 2, 3, 4).reshape(B, SEQ, MLA_WIDTH)
    memk_p, memv_p = mem_kv(mem_prompt, p)
    y_mem_p = mem_attend(qm, memk_p, memv_p, p)
    y_prompt = merge(x_prompt, y_ssm_p, y_mla_p, y_mem_p, g_ssm, g_mla, g_mem, p)

    Bs = x_sample.shape[0]
    pos_s = PAST_LEN + jnp.arange(DEC_SEQ, dtype=jnp.int32)
    k_pos_s = jnp.arange(PAST_LEN + DEC_SEQ, dtype=jnp.int32)
    u, g_ssm, cq, ckv, kr, g_mla, qm, g_mem = in_projection(x_sample, p)
    y_ssm_s, ssm_re_s, ssm_im_s = ssm_mixer(u, state_ssm_re, state_ssm_im, p)
    q_s, ckv_s, kr_s = mla_project(cq, ckv, kr, pos_s, p)

    def one_seq(a):
        pages, q1, ckv1, kr1 = a
        ckv_all = jnp.concatenate([cache_ckv[pages].reshape(-1, KV_LORA), ckv1.astype(cache_ckv.dtype)], axis=0)
        kr_all = jnp.concatenate([cache_krope[pages].reshape(-1, MLA_ROPE), kr1.astype(cache_krope.dtype)], axis=0)
        k1, v1 = mla_keys(ckv_all[None], kr_all[None], p)
        return attend(q1[None], k1, v1, pos_s, k_pos_s)[0]

    y_mla_s = lax.map(one_seq, (page_table, q_s, ckv_s, kr_s)).reshape(Bs, DEC_SEQ, MLA_WIDTH)
    y_mem_s = mem_attend(qm, cache_mem_k, cache_mem_v, p)
    y_sample = merge(x_sample, y_ssm_s, y_mla_s, y_mem_s, g_ssm, g_mla, g_mem, p)

    return (y_prompt, y_sample, ckv_p, kr_p, ckv_s, kr_s, memk_p, memv_p,
            ssm_re_p, ssm_im_p, ssm_re_s, ssm_im_s)
```

```cpp
#include <hip/hip_runtime.h>
#include <cstdio>
#include <cstdint>
namespace pg8 {
#define PG8_LAS __attribute__((address_space(3)))
typedef unsigned short bf16_t;
typedef short bf16x8 __attribute__((ext_vector_type(8)));
typedef float f32x4 __attribute__((ext_vector_type(4)));
typedef unsigned u32x4 __attribute__((ext_vector_type(4)));
constexpr int BM = 256, BK = 64, HALF = 128, HTB = HALF * BK * 2  , STAGE_BYTES = 8 * HTB, NXCD = 8, WGM = 8;

__host__ __device__ __forceinline__ int lds_byte(int r, int c) { const int st = (r >> 4) * 2 + (c >> 5), rr = r & 15, cc = c & 31, ob = rr * 64 + cc * 2; return st * 1024 + (ob ^ (((ob >> 9) & 1) << 5)); }
__host__ __device__ __forceinline__ void stage_rc(int b, int& R, int& C) { const int st = b / 1024, sb = b % 1024, swz = sb ^ (((sb >> 9) & 1) << 5); R = (st >> 1) * 16 + swz / 64; C = (st & 1) * 32 + (swz % 64) / 2; }
__host__ __device__ __forceinline__ int perm32(int rho) { const int n = rho >> 4, i = rho & 15; return 8 * (i >> 2) + 4 * n + (i & 3); }

struct Unit { int pm, pn; };
struct Gemm { const bf16_t* A; const bf16_t* Bt; int M, N, K; };

struct StaticOrder {
    int nM, nN, nwg, G, c;
    __host__ __device__ void init(int M, int N, int G_, int c_) { nM = M / BM; nN = N / BM; nwg = nM * nN; G = G_; c = c_; }
    __host__ __device__ bool next(int i, Unit& u) const {
        const long L = (long)i * G + c; if (L >= nwg) return false;
        int wgid = (int)L; { const int q = nwg / NXCD, r = nwg % NXCD, xcd = wgid % NXCD, off = wgid / NXCD; wgid = (xcd < r ? xcd * (q + 1) : r * (q + 1) + (xcd - r) * q) + off; }
        const int nig = WGM * nN, gid = wgid / nig, fm = gid * WGM, gsz = (nM - fm) < WGM ? (nM - fm) : WGM;
        u.pm = fm + ((wgid % nig) % gsz); u.pn = (wgid % nig) / gsz; return true;
    }
    __device__ __forceinline__ void a_ready(const Unit&) const {}
    __device__ __forceinline__ void done(const Unit&) const {}
};
__device__ __forceinline__ unsigned cvt_pk_bf16(float lo, float hi) { unsigned r; asm volatile("v_cvt_pk_bf16_f32 %0, %1, %2" : "=v"(r) : "v"(lo), "v"(hi)); return r; }
template <class Epi, class Sched, bool STAMP = false>
__device__ __forceinline__ void gemm_phase(PG8_LAS unsigned char* lds, const Gemm g, const Sched& S, const Epi& E, unsigned long long* stamps) {
    int tid_l = threadIdx.x; asm volatile("" : "+v"(tid_l));
    const int tid = tid_l, wid = __builtin_amdgcn_readfirstlane(tid >> 6), lane = tid & 63, wr = wid >> 2, wc = wid & 3, fr = lane & 15, fq = lane >> 4;
    const int K = g.K, nt = K / BK;
    int ts_lo = 0, ts_hi = 0, nts = 0; const unsigned long long rt_entry = STAMP ? (unsigned long long)wall_clock64() : 0ull;
#define PG8_STAMP() do { if (STAMP && wid == 0 && nts < 64) { const unsigned long long _c = (unsigned long long)clock64(); \
        ts_lo = (lane == nts) ? (int)(unsigned)_c : ts_lo; ts_hi = (lane == nts) ? (int)(unsigned)(_c >> 32) : ts_hi; ++nts; } } while (0)
    PG8_STAMP();
    unsigned voffA[2], voffB[2];
#pragma unroll
    for (int i = 0; i < 2; ++i) { int R, C; stage_rc(tid * 16 + i * 8192, R, C); const int Rb = Epi::PERM ? ((R & ~31) + perm32(R & 31)) : R;
        voffA[i] = (unsigned)(R * K + C) * 2u; voffB[i] = (unsigned)(Rb * K + C) * 2u; }
    const size_t kstep = (size_t)(BK * 2);
    const size_t hstep = (size_t)HALF * K * 2;
    const size_t tstep = 2 * hstep;
    const unsigned ldsw = (unsigned)wid * 1024u;
    const int aoff = lds_byte(wr * 64 + fr, fq * 8), boff = lds_byte(wc * 32 + fr, fq * 8);
#define PG8_SA(b, h) (((b) * 2 + (h)) * HTB)
#define PG8_SB(b, h) ((4 + (b) * 2 + (h)) * HTB)
#define PG8_STAGE(bufoff, gbase, voff) do { _Pragma("unroll") for (int _i = 0; _i < 2; ++_i) \
        __builtin_amdgcn_global_load_lds((const unsigned*)((const char*)(gbase) + (voff)[_i]), (PG8_LAS unsigned*)(lds + (bufoff) + ldsw + _i * 8192), 16, 0, 0); } while (0)
#define PG8_LDA(dst, b, h) do { _Pragma("unroll") for (int m = 0; m < 4; ++m) _Pragma("unroll") for (int k = 0; k < 2; ++k) dst[m][k] = *(const PG8_LAS bf16x8*)(lds + PG8_SA(b, h) + aoff + m * 2048 + k * 1024); } while (0)
#define PG8_LDB(dst, b, h) do { _Pragma("unroll") for (int n = 0; n < 2; ++n) _Pragma("unroll") for (int k = 0; k < 2; ++k) dst[n][k] = *(const PG8_LAS bf16x8*)(lds + PG8_SB(b, h) + boff + n * 2048 + k * 1024); } while (0)
#define PG8_MMA(ai, bj, At, Bt) do { __builtin_amdgcn_s_setprio(1); _Pragma("unroll") for (int m = 0; m < 4; ++m) _Pragma("unroll") for (int n = 0; n < 2; ++n) _Pragma("unroll") for (int k = 0; k < 2; ++k) \
        acc[ai][bj][m][n] = __builtin_amdgcn_mfma_f32_16x16x32_bf16(Bt[n][k], At[m][k], acc[ai][bj][m][n], 0, 0, 0); __builtin_amdgcn_s_setprio(0); } while (0)
#define PG8_WAIT_V(n) asm volatile("s_waitcnt vmcnt(" #n ")" ::: "memory")
#define PG8_WAIT_L(n) asm volatile("s_waitcnt lgkmcnt(" #n ")" ::: "memory")
#define PG8_BAR __builtin_amdgcn_s_barrier()
#define PG8_SCHED __builtin_amdgcn_sched_barrier(0)
    Unit cur, nxt; int ui = 0;
    if (!S.next(0, cur)) return;
    f32x4 acc[2][2][4][2];
#pragma unroll
    for (int a = 0; a < 2; ++a)
#pragma unroll
        for (int b = 0; b < 2; ++b)
#pragma unroll
            for (int m = 0; m < 4; ++m)
#pragma unroll
                for (int n = 0; n < 2; ++n) acc[a][b][m][n] = (f32x4){0.f, 0.f, 0.f, 0.f};
    bf16x8 At[4][2], B0[2][2], B1[2][2];
    const char* cA = (const char*)g.A + (size_t)cur.pm * tstep; const char* cB = (const char*)g.Bt + (size_t)cur.pn * tstep;
    S.a_ready(cur);
    PG8_STAGE(PG8_SB(0, 0), cB, voffB); PG8_STAGE(PG8_SA(0, 0), cA, voffA); PG8_STAGE(PG8_SB(0, 1), cB + hstep, voffB); PG8_STAGE(PG8_SA(0, 1), cA + hstep, voffA);
    if (wr == 1) PG8_BAR;
    PG8_WAIT_V(4); PG8_BAR;
    PG8_STAGE(PG8_SB(1, 0), cB + kstep, voffB); PG8_STAGE(PG8_SA(1, 0), cA + kstep, voffA); PG8_STAGE(PG8_SB(1, 1), cB + hstep + kstep, voffB);
    PG8_WAIT_V(6); PG8_BAR;
    PG8_STAMP();
    for (;;) {
        const bool has_next = S.next(ui + 1, nxt);
        const char* nA = has_next ? (const char*)g.A + (size_t)nxt.pm * tstep : cA; const char* nB = has_next ? (const char*)g.Bt + (size_t)nxt.pn * tstep : cB;
        for (int t = 0; t < nt; t += 2) {
            const bool last = (t == nt - 2);
            const char* a1 = cA + (size_t)(t + 1) * kstep;
            const char* a2 = last ? nA : cA + (size_t)(t + 2) * kstep; const char* b2 = last ? nB : cB + (size_t)(t + 2) * kstep;
            const char* a3 = a2 + kstep; const char* b3 = b2 + kstep;
            if (last && has_next) S.a_ready(nxt);
            PG8_LDB(B0, 0, 0); PG8_SCHED; PG8_LDA(At, 0, 0); PG8_STAGE(PG8_SA(1, 1), a1 + hstep, voffA);
            PG8_WAIT_L(8); PG8_BAR; PG8_WAIT_L(0); PG8_MMA(0, 0, At, B0); PG8_BAR; PG8_SCHED;
            PG8_LDB(B1, 0, 1); PG8_STAGE(PG8_SB(0, 0), b2, voffB);
            PG8_BAR; PG8_WAIT_L(0); PG8_MMA(0, 1, At, B1); PG8_BAR;
            PG8_LDA(At, 0, 1); PG8_STAGE(PG8_SA(0, 0), a2, voffA);
            PG8_BAR; PG8_WAIT_L(0); PG8_MMA(1, 0, At, B0); PG8_BAR; PG8_SCHED;
            PG8_STAGE(PG8_SB(0, 1), b2 + hstep, voffB);
            PG8_WAIT_V(6); PG8_BAR; PG8_MMA(1, 1, At, B1); PG8_BAR;
            PG8_LDB(B0, 1, 0); PG8_SCHED; PG8_LDA(At, 1, 0); PG8_STAGE(PG8_SA(0, 1), a2 + hstep, voffA);
            PG8_WAIT_L(8); PG8_BAR; PG8_WAIT_L(0); PG8_MMA(0, 0, At, B0); PG8_BAR; PG8_SCHED;
            PG8_LDB(B1, 1, 1); PG8_STAGE(PG8_SB(1, 0), b3, voffB);
            PG8_BAR; PG8_WAIT_L(0); PG8_MMA(0, 1, At, B1); PG8_BAR;
            PG8_LDA(At, 1, 1); PG8_STAGE(PG8_SA(1, 0), a3, voffA);
            PG8_BAR; PG8_WAIT_L(0); PG8_MMA(1, 0, At, B0); PG8_BAR; PG8_SCHED;
            PG8_STAGE(PG8_SB(1, 1), b3 + hstep, voffB);
            PG8_WAIT_V(6); PG8_BAR; PG8_MMA(1, 1, At, B1); PG8_BAR;
        }
        PG8_STAMP();
        if constexpr (!Epi::AFTER_DRAIN) { E(acc, cur, wr, wc, fr, fq); S.done(cur); }
        PG8_STAMP();
        if (!has_next) break;
#pragma unroll
        for (int a = 0; a < 2; ++a)
#pragma unroll
            for (int b = 0; b < 2; ++b)
#pragma unroll
                for (int m = 0; m < 4; ++m)
#pragma unroll
                    for (int n = 0; n < 2; ++n) acc[a][b][m][n] = (f32x4){0.f, 0.f, 0.f, 0.f};
        cur = nxt; cA = nA; cB = nB; ++ui;
    }
    PG8_WAIT_V(0);
    if (wr == 0) PG8_BAR;
    PG8_BAR;
    if constexpr (Epi::AFTER_DRAIN) { E.fused(acc, cur, wr, wc, fr, fq, lds, wid, lane); S.done(cur); }
    PG8_STAMP();
    if (STAMP && wid == 0) { stamps[lane] = lane < nts ? (((unsigned long long)(unsigned)ts_hi << 32) | (unsigned)ts_lo) : 0ull;
        if (lane == 62) stamps[62] = rt_entry; if (lane == 63) stamps[63] = (unsigned long long)wall_clock64(); }
#undef PG8_STAMP
#undef PG8_SA
#undef PG8_SB
#undef PG8_STAGE
#undef PG8_LDA
#undef PG8_LDB
#undef PG8_MMA
#undef PG8_WAIT_V
#undef PG8_WAIT_L
#undef PG8_BAR
#undef PG8_SCHED
}
}

#define GAS __attribute__((address_space(1)))
#define LAS __attribute__((address_space(3)))
typedef unsigned short bf16_t;
typedef short bf16x8 __attribute__((ext_vector_type(8)));
typedef short s16x4 __attribute__((ext_vector_type(4)));
typedef float f32x4 __attribute__((ext_vector_type(4)));
typedef float f32x2 __attribute__((ext_vector_type(2)));
typedef float f32x16 __attribute__((ext_vector_type(16)));
typedef unsigned u32x4 __attribute__((ext_vector_type(4)));
typedef unsigned u32x2 __attribute__((ext_vector_type(2)));

constexpr int D = 2048, SEQ = 4096, NB = 2, NP = NB * SEQ  , NSB = 128  , NS = NSB * 8  , NR = NP + NS  ;
constexpr int NIN = 4096;
constexpr int PAST = 8192, PAGE = 128, NPAGES = 64;
constexpr int MEMT = 256;
constexpr float EPS = 1e-6f;
constexpr float LOG2E = 1.4426950408889634f;
constexpr size_t O_Y = 0, O_CKV_P = 18874368, O_KR_P = 20971520, O_CKV_S = 21495808, O_KR_S = 21757952, O_MK = 21823488, O_MV = 22085632,
                 O_SRE_P = 22347776, O_SIM_P = 22351872, O_SRE_S = 22355968, O_SIM_S = 22618112;

constexpr size_t al256(size_t x) { return (x + 255) & ~(size_t)255; }
constexpr size_t WS_CTL = 0, CTL_BYTES = 1u << 20;
constexpr size_t WS_WIN_T   = WS_CTL + CTL_BYTES;
constexpr size_t WS_WUQ_T   = WS_WIN_T + (size_t)4096 * 2048 * 2;
constexpr size_t WS_WKV_TG  = WS_WUQ_T + (size_t)2048 * 512 * 2;
constexpr size_t WS_WKV_T   = WS_WKV_TG + (size_t)2048 * 256 * 2;
constexpr size_t WS_WKV_B   = WS_WKV_T + (size_t)2048 * 256 * 2;
constexpr size_t WS_WF      = WS_WKV_B + (size_t)256 * 2048 * 2;
constexpr size_t WS_MEMKV_T = WS_WF + (size_t)32 * 16 * 1024;
constexpr size_t WS_WOUT_T  = WS_MEMKV_T + (size_t)1024 * 2048 * 2;
constexpr size_t WS_GLUF    = WS_WOUT_T + (size_t)2048 * 2048 * 2;
constexpr size_t WS_ABAR    = WS_GLUF + (size_t)16 * 32 * 1024;
constexpr size_t WS_ABARL   = WS_ABAR + 32 * 64 * 8;
constexpr size_t WS_BBAR    = WS_ABARL + 32 * 64 * 8;
constexpr size_t WS_CSTB    = WS_BBAR + (size_t)32 * 64 * 16 * 8;
constexpr size_t WS_QCG     = WS_CSTB + (size_t)32 * 32 * 128 * 2;
constexpr size_t WS_XN      = WS_QCG + 1024;
constexpr size_t WS_MEMN    = WS_XN + (size_t)NR * 2048 * 2;
constexpr size_t WS_UF      = WS_MEMN + (size_t)512 * 2048 * 2;
constexpr size_t WS_CQ      = WS_UF + (size_t)NR * 512 * 4;
constexpr size_t WS_SSQ_CQ  = WS_CQ + (size_t)NR * 512 * 2;
constexpr size_t WS_CKVF    = WS_SSQ_CQ + (size_t)NR * 8 * 4;
constexpr size_t WS_CKVB    = WS_CKVF + (size_t)NR * 256 * 4;
constexpr size_t WS_SSQ_CKV = WS_CKVB + (size_t)NR * 256 * 2;
constexpr size_t WS_QMR     = WS_SSQ_CKV + (size_t)NR * 4 * 4;
constexpr size_t WS_SSQ_QM  = WS_QMR + (size_t)NR * 512 * 2;
constexpr size_t WS_KRF     = WS_SSQ_QM + (size_t)NR * 16 * 4;
constexpr size_t WS_GATES   = WS_KRF + (size_t)NR * 64 * 4;
constexpr size_t WS_MKRAW   = WS_GATES + (size_t)NR * 2048 * 2;
constexpr size_t WS_SSQ_MK  = WS_MKRAW + (size_t)512 * 512 * 4;
constexpr size_t WS_VTM     = WS_SSQ_MK + (size_t)512 * 16 * 4;
constexpr size_t WS_MKB     = WS_VTM + (size_t)2 * 4 * 128 * 256 * 2;
constexpr size_t WS_CKVS    = WS_MKB + (size_t)2 * 4 * 256 * 128 * 2;
constexpr size_t WS_KRB     = WS_CKVS + (size_t)1024 * 256 * 2;
constexpr size_t WS_SSQ_KR  = WS_KRB + (size_t)NR * 64 * 2;
constexpr size_t WS_QM      = WS_SSQ_KR + (size_t)NR * 4;
constexpr size_t WS_MQM     = WS_QM + (size_t)NR * 512 * 2;
constexpr size_t WS_QG      = WS_MQM + (size_t)NR * 4 * 4;
constexpr size_t WS_SSQ_Q   = WS_QG + (size_t)NR * 1536 * 2;
constexpr size_t WS_KNB     = WS_SSQ_Q + (size_t)NR * 64 * 4;
constexpr size_t WS_SSQ_KN  = WS_KNB + (size_t)2 * 8 * 4096 * 128 * 2;
constexpr size_t WS_VT      = WS_SSQ_KN + (size_t)NP * 32 * 4;
constexpr size_t WS_SCH     = WS_VT + (size_t)2 * 8 * 128 * 4096 * 2;
constexpr size_t WS_YSSM    = WS_SCH + (size_t)2 * 128 * 32 * 64 * 8;
constexpr size_t WS_YMLA    = WS_YSSM + (size_t)NR * 512 * 2;
constexpr size_t WS_YMEM    = WS_YMLA + (size_t)NP * 1024 * 2;
constexpr size_t WS_YPS     = WS_YMEM + (size_t)NR * 512 * 2;
constexpr size_t WS_LPS     = WS_YPS + (size_t)128 * 2 * 64 * 128 * 4;
constexpr size_t WS_O       = WS_LPS + (size_t)128 * 2 * 64 * 4;
constexpr size_t WS_END     = WS_O + (size_t)NR * 2048 * 2;
static_assert(WS_END < ((size_t)1 << 30), "workspace map");

constexpr int LDS_TOTAL = 163840 - 256;
constexpr int LDS_MISC = LDS_TOTAL - 64;

__device__ __forceinline__ unsigned f2bf(float f) { unsigned u = __builtin_bit_cast(unsigned, f); return (u + 0x7fffu + ((u >> 16) & 1u)) >> 16; }
__device__ __forceinline__ unsigned pk2(float lo, float hi) { unsigned r; asm volatile("v_cvt_pk_bf16_f32 %0, %1, %2" : "=v"(r) : "v"(lo), "v"(hi)); return r; }
__device__ __forceinline__ float bf2f(unsigned short b) { return __builtin_bit_cast(float, ((unsigned)b) << 16); }
__device__ __forceinline__ float bflo(unsigned w) { return __builtin_bit_cast(float, w << 16); }
__device__ __forceinline__ float bfhi(unsigned w) { return __builtin_bit_cast(float, w & 0xffff0000u); }
__device__ __forceinline__ float wave_sum(float v) {
#pragma unroll
    for (int o = 1; o < 64; o <<= 1) v += __shfl_xor(v, o);
    return v;
}
__device__ __forceinline__ float ex2(float x) { return __builtin_amdgcn_exp2f(x); }
#define LDS_WAIT() asm volatile("s_waitcnt lgkmcnt(0)" ::: "memory")
__device__ __forceinline__ f32x16 mfma32(bf16x8 a, bf16x8 b, f32x16 c) { return __builtin_amdgcn_mfma_f32_32x32x16_bf16(a, b, c, 0, 0, 0); }
__device__ __forceinline__ f32x16 zero16() { f32x16 z;
#pragma unroll
    for (int i = 0; i < 16; ++i) z[i] = 0.f; return z; }
__device__ __forceinline__ int crow(int r, int hh) { return (r & 3) + 8 * (r >> 2) + 4 * hh; }
__device__ __forceinline__ int perm23(int k) { return (k & ~0xC) | ((k & 4) << 1) | ((k & 8) >> 1); }

__device__ const double ROPE_TURNS[32] = {
    0.15915494309189535, 0.11934937021124886, 0.08949940160889101, 0.06711508300522726, 0.050329212104487035, 0.03774158471741977, 0.0283021958306234, 0.02122365276477766, 0.015915494309189534, 0.011934937021124886, 0.008949940160889102, 0.006711508300522725, 0.005032921210448704, 0.003774158471741977, 0.00283021958306234, 0.0021223652764777662, 0.0015915494309189536, 0.0011934937021124885, 0.0008949940160889102, 0.0006711508300522726, 0.0005032921210448703, 0.00037741584717419774, 0.00028302195830623395, 0.0002122365276477766, 0.00015915494309189535, 0.00011934937021124886, 8.949940160889102e-05, 6.711508300522725e-05, 5.0329212104487035e-05, 3.774158471741978e-05, 2.8302195830623396e-05, 2.122365276477766e-05
};
__device__ __forceinline__ void rope_cs(int pos, int i, float& c, float& s) {
    double a = (double)pos * ROPE_TURNS[i]; a -= __builtin_rint(a);
    const float t = (float)a;
    s = __builtin_amdgcn_sinf(t); c = __builtin_amdgcn_cosf(t);
}

#define XB_TMO      128
#define XB_XCNT(j)  (256  + 64 * (j))
#define XB_XSUB(j)  (1280 + 64 * (j))
#define XB_XGEN(j)  (2304 + 64 * (j))
#define XB_TOP      3328
#define XB_TOPGEN   3392
#define XCD_BAR_WORDS 3456
#define XB_SPIN_CAP (1u << 18)
__device__ __forceinline__ unsigned xb_ld(unsigned* p)              { return __hip_atomic_load(p, __ATOMIC_RELAXED, __HIP_MEMORY_SCOPE_AGENT); }
__device__ __forceinline__ unsigned xb_add(unsigned* p, unsigned v) { return __hip_atomic_fetch_add(p, v, __ATOMIC_RELAXED, __HIP_MEMORY_SCOPE_AGENT); }
__device__ __forceinline__ unsigned xb_xcc_id() { return (unsigned)__builtin_amdgcn_s_getreg((3 << 11) | 20) & 0xFu; }
#define XB_SPIN(cond, bar) do { unsigned _sp = 0; while (cond) { __builtin_amdgcn_s_sleep(1); \
    if ((++_sp & 255u) == 0u) { if (xb_ld(&(bar)[XB_TMO])) break; if (_sp > XB_SPIN_CAP) { atomicAdd(&(bar)[XB_TMO], 1u); break; } } } } while (0)
struct XcdBarrier { unsigned* bar; unsigned x; volatile LAS unsigned* st; };
__device__ __forceinline__ XcdBarrier xcd_barrier_post(unsigned* bar, volatile LAS unsigned* st) {
    XcdBarrier b; b.bar = bar; b.x = xb_xcc_id(); b.st = st;
    if (threadIdx.x == 0) (void)xb_add(&bar[XB_XCNT(b.x)], 1u);
    return b;
}
__device__ __forceinline__ void xcd_barrier_complete(unsigned* bar, unsigned x, unsigned& nloc, unsigned& nx) {
    const unsigned G = gridDim.x * gridDim.y * gridDim.z;
    unsigned sum, cnt, mine, sp = 0u;
    for (;;) {
        sum = 0u; cnt = 0u; mine = 0u;
#pragma unroll
        for (unsigned j = 0; j < 16; ++j) { const unsigned c = xb_ld(&bar[XB_XCNT(j)]); sum += c; cnt += (c > 0u) ? 1u : 0u; mine = (j == x) ? c : mine; }
        if (sum == G) break;
        __builtin_amdgcn_s_sleep(1);
        if ((++sp & 255u) == 0u) { if (xb_ld(&bar[XB_TMO])) break; if (sp > XB_SPIN_CAP) { atomicAdd(&bar[XB_TMO], 1u); break; } }
    }
    nloc = mine > 0u ? mine : 1u; nx = cnt > 0u ? cnt : 1u;
}
__device__ __forceinline__ void xcd_barrier(const XcdBarrier& b) {
    asm volatile("s_waitcnt vmcnt(0)" ::: "memory");
    __syncthreads();
    if (threadIdx.x == 0) {
        unsigned* bar = b.bar;
        __builtin_amdgcn_s_waitcnt(0);
        unsigned nloc = b.st[0], nx = b.st[1];
        if (nloc == 0u) { xcd_barrier_complete(bar, b.x, nloc, nx); b.st[0] = nloc; b.st[1] = nx; }
        const unsigned old = xb_add(&bar[XB_XSUB(b.x)], 1u);
        const unsigned gen = old / nloc;
        if (old + 1u == (gen + 1u) * nloc) {
            __builtin_amdgcn_fence(__ATOMIC_RELEASE, "agent");
            asm volatile("s_waitcnt vmcnt(0)" ::: "memory");
            const unsigned og = xb_add(&bar[XB_TOP], 1u);
            const unsigned tg = og / nx;
            if (og + 1u == (tg + 1u) * nx) xb_add(&bar[XB_TOPGEN], 1u);
            else XB_SPIN(xb_ld(&bar[XB_TOPGEN]) == tg, bar);
            __builtin_amdgcn_fence(__ATOMIC_ACQUIRE, "agent");
            xb_add(&bar[XB_XGEN(b.x)], 1u);
            asm volatile("s_waitcnt vmcnt(0)" ::: "memory");
        } else {
            XB_SPIN(xb_ld(&bar[XB_XGEN(b.x)]) == gen, bar);
            __builtin_amdgcn_fence(__ATOMIC_ACQUIRE, "agent");
            asm volatile("s_waitcnt vmcnt(0)" ::: "memory");
        }
    }
    __syncthreads();
}

struct Params {
    const float* in[37];
    float* out;
    unsigned char* ws;
};
struct Frame {
    LAS unsigned char* lds;
    unsigned char* ws;
    float* out;
    int tid, lane, wave, G, bid;
};
#define WSP(T, off) ((T*)(F.ws + (off)))

template <class Map>
__device__ __forceinline__ void p0_transpose_item(const float* W, int K, int Nsrc, int Ndst, bf16_t* WT, const float* gain, const Map& map, LAS float* scr, int item, int lane) {
    const int nblk = Ndst / 32, kb = item / nblk, nb = item % nblk, k0 = 64 * kb, n0 = 32 * nb;
    const int sc = map(n0 + (lane & 31));
#pragma unroll 8
    for (int i = 0; i < 32; ++i) { const int kk = 2 * i + (lane >> 5); float v = 0.f; if (sc >= 0) { v = W[(size_t)(k0 + kk) * Nsrc + sc]; if (gain) v *= gain[k0 + kk]; } scr[kk * 33 + (lane & 31)] = v; }
    LDS_WAIT(); asm volatile("" ::: "memory");
    const int c = lane & 7;
#pragma unroll
    for (int j = 0; j < 4; ++j) { const int n = (lane >> 3) + 8 * j; const LAS float* s = scr + (8 * c) * 33 + n;
        u32x4 o; o.x = pk2(s[0 * 33], s[1 * 33]); o.y = pk2(s[2 * 33], s[3 * 33]); o.z = pk2(s[4 * 33], s[5 * 33]); o.w = pk2(s[6 * 33], s[7 * 33]);
        *(u32x4*)(WT + (size_t)(n0 + n) * K + k0 + 8 * c) = o; }
    LDS_WAIT(); asm volatile("" ::: "memory");
}
struct MapIn { __device__ __forceinline__ int operator()(int n) const {
    if (n < 512) return n;
    if (n < 1024) return 1024 + (n - 512);
    if (n < 1280) return 1536 + (n - 1024);
    if (n < 1792) return 2880 + (n - 1280);
    if (n < 1856) return n;
    if (n < 2048) return -1;
    if (n < 2560) return 512 + (n - 2048);
    if (n < 3584) return 1856 + (n - 2560);
    return 3392 + (n - 3584);
} };
struct MapUq { __device__ __forceinline__ int operator()(int n) const {
    const int h = n >> 8, p = n & 255;
    if (p < 128) return h * 192 + p;
    if (p >= 192) return -1;
    const int pp = p - 128, wc = pp >> 5, nn = (pp >> 4) & 1, rest = pp & 15;
    return h * 192 + 128 + 32 * nn + 16 * wc + rest;
} };
struct MapId { __device__ __forceinline__ int operator()(int n) const { return n; } };
struct MapOff { int off; __device__ __forceinline__ int operator()(int n) const { return n - off; } };

__device__ __forceinline__ void p0_norm_row(const float* xrow, const float* g, bf16_t* orow, int lane) {
    const f32x4* xr = (const f32x4*)xrow + lane; const f32x4* gr = (const f32x4*)g + lane;
    f32x4 v[8]; float s = 0.f;
#pragma unroll
    for (int j = 0; j < 8; ++j) { v[j] = xr[64 * j]; s += (v[j].x * v[j].x + v[j].y * v[j].y) + (v[j].z * v[j].z + v[j].w * v[j].w); }
    const float rinv = 1.0f / sqrtf(wave_sum(s) * (1.f / 2048.f) + EPS);
    u32x2* o8 = (u32x2*)orow + lane;
#pragma unroll
    for (int j = 0; j < 8; ++j) { const f32x4 gg = gr[64 * j]; u32x2 w; w.x = pk2(v[j].x * rinv * gg.x, v[j].y * rinv * gg.y); w.y = pk2(v[j].z * rinv * gg.z, v[j].w * rinv * gg.w); o8[64 * j] = w; }
}

__device__ __forceinline__ void p0_prologue(Frame& F, const Params& P) {
    int tid = F.tid; asm volatile("" : "+v"(tid)); const int lane_ = tid & 63;
    LAS float* scr = (LAS float*)(F.lds + F.wave * 16384);
    const int gw = F.bid * 8 + F.wave, NGW = F.G * 8;
    const int gt = F.bid * 512 + tid, NGT = F.G * 512;
    constexpr int I_IN = (2048 / 64) * (4096 / 32), I_UQ = (512 / 64) * (2048 / 32), I_KV = (256 / 64) * (2048 / 32), I_MK = (2048 / 64) * (512 / 32), I_OUT = (2048 / 64) * (2048 / 32);
    constexpr int NITEMS = I_IN + I_UQ + 2 * I_KV + 2 * I_MK + I_OUT;
    for (int it = gw; it < NITEMS; it += NGW) {
        int r = it;
        if (r < I_IN) { p0_transpose_item(P.in[11], 2048, 3904, 4096, WSP(bf16_t, WS_WIN_T), (const float*)nullptr, MapIn{}, scr, r, lane_); continue; } r -= I_IN;
        if (r < I_UQ) { p0_transpose_item(P.in[23], 512, 1536, 2048, WSP(bf16_t, WS_WUQ_T), P.in[22], MapUq{}, scr, r, lane_); continue; } r -= I_UQ;
        if (r < I_KV) { p0_transpose_item(P.in[25], 256, 2048, 2048, WSP(bf16_t, WS_WKV_TG), P.in[24], MapId{}, scr, r, lane_); continue; } r -= I_KV;
        if (r < I_KV) { p0_transpose_item(P.in[25], 256, 2048, 2048, WSP(bf16_t, WS_WKV_T), (const float*)nullptr, MapId{}, scr, r, lane_); continue; } r -= I_KV;
        if (r < I_MK) { p0_transpose_item(P.in[29], 2048, 512, 512, WSP(bf16_t, WS_MEMKV_T), (const float*)nullptr, MapId{}, scr, r, lane_); continue; } r -= I_MK;
        if (r < I_MK) { p0_transpose_item(P.in[30], 2048, 512, 512, WSP(bf16_t, WS_MEMKV_T) + (size_t)512 * 2048, (const float*)nullptr, MapId{}, scr, r, lane_); continue; } r -= I_MK;
        p0_transpose_item(P.in[36], 2048, 2048, 2048, WSP(bf16_t, WS_WOUT_T), (const float*)nullptr, MapId{}, scr, r, lane_);
    }
    { const float* w = P.in[25]; bf16_t* o = WSP(bf16_t, WS_WKV_B);
      for (int i = gt; i < 256 * 2048 / 4; i += NGT) { const f32x4 v = ((const f32x4*)w)[i]; u32x2 q; q.x = pk2(v.x, v.y); q.y = pk2(v.z, v.w); ((u32x2*)o)[i] = q; } }
    { const float* w = P.in[25]; u32x4* o = WSP(u32x4, WS_WF);
      for (int i = gt; i < 32 * 16 * 64; i += NGT) { const int ln = i & 63, ks = (i >> 6) & 15, hn = i >> 10, h = hn >> 2, nb = hn & 3, ii = ln & 31, hh = ln >> 5;
          const float* s = w + (size_t)(16 * ks + 8 * hh) * 2048 + h * 256 + nb * 32 + ii;
          u32x4 q; q.x = pk2(s[0], s[2048]); q.y = pk2(s[2 * 2048], s[3 * 2048]); q.z = pk2(s[4 * 2048], s[5 * 2048]); q.w = pk2(s[6 * 2048], s[7 * 2048]); o[i] = q; } }
    { const float* w = P.in[20]; u32x4* o = WSP(u32x4, WS_GLUF);
      for (int i = gt; i < 16 * 32 * 64; i += NGT) { const int ln = i & 63, ks = (i >> 6) & 31, cb = i >> 11, ii = ln & 31, hh = ln >> 5;
          const float* s = w + (size_t)(16 * ks + 8 * hh) * 512 + cb * 32 + ii;
          u32x4 q; q.x = pk2(s[0], s[512]); q.y = pk2(s[2 * 512], s[3 * 512]); q.z = pk2(s[4 * 512], s[5 * 512]); q.w = pk2(s[6 * 512], s[7 * 512]); o[i] = q; } }
    { const float* a_re = P.in[12]; const float* a_im = P.in[13]; const float* ldt = P.in[14]; const float* b_re = P.in[15]; const float* b_im = P.in[16];
      f32x2* abar = WSP(f32x2, WS_ABAR); f32x2* abarl = WSP(f32x2, WS_ABARL); f32x2* bbar = WSP(f32x2, WS_BBAR);
      for (int i = gt; i < 32 * 64; i += NGT) { const int g = i >> 6;
          const float dt = expf(ldt[g]), ar = a_re[i], ai = a_im[i];
          const float mag = expf(dt * ar), ph = dt * ai;
          const float abr = mag * cosf(ph), abi = mag * sinf(ph);
          abar[i] = (f32x2){abr, abi};
          const float magl = expf(32.f * dt * ar), phl = 32.f * ph;
          abarl[i] = (f32x2){magl * cosf(phl), magl * sinf(phl)};
          const float den = ar * ar + ai * ai, nr = abr - 1.0f, ni = abi;
          const float fr = (nr * ar + ni * ai) / den, fi = (ni * ar - nr * ai) / den;
#pragma unroll
          for (int p = 0; p < 16; ++p) { const float br = b_re[i * 16 + p], bi = b_im[i * 16 + p]; bbar[i * 16 + p] = (f32x2){fr * br - fi * bi, fr * bi + fi * br}; } } }
    { const float* c_re = P.in[17]; const float* c_im = P.in[18]; bf16_t* o = WSP(bf16_t, WS_CSTB);
      for (int i = gt; i < 32 * 32 * 128; i += NGT) { const int k = i & 127, p = (i >> 7) & 31, g = i >> 12; float v = 0.f;
          if (p < 16) v = (k < 64) ? c_re[(g * 16 + p) * 64 + k] : -c_im[(g * 16 + p) * 64 + (k - 64)];
          o[i] = (bf16_t)f2bf(v); } }
    if (gt < 192) WSP(float, WS_QCG)[gt] = P.in[26][gt] * P.in[27][gt] * (0.07216878364870322f * LOG2E);
    for (int m = gw; m < NR; m += NGW) {
        const float* src = (m < NP) ? P.in[0] + (size_t)m * 2048 : P.in[1] + (size_t)(m - NP) * 2048;
        p0_norm_row(src, P.in[10], WSP(bf16_t, WS_XN) + (size_t)m * 2048, lane_);
    }
    for (int m = gw; m < 512; m += NGW) p0_norm_row(P.in[2] + (size_t)m * 2048, P.in[28], WSP(bf16_t, WS_MEMN) + (size_t)m * 2048, lane_);
}

#define EPI_RELANE() do { int ln_ = (int)__builtin_amdgcn_mbcnt_hi(~0u, __builtin_amdgcn_mbcnt_lo(~0u, 0u)); asm volatile("" : "+v"(ln_)); fr = ln_ & 15; fq = ln_ >> 4; } while (0)
__device__ __forceinline__ float sq4(const f32x4 v) { return (v.x * v.x + v.y * v.y) + (v.z * v.z + v.w * v.w); }
__device__ __forceinline__ void st_bf4(bf16_t* p, const f32x4 v) { u32x2 w; w.x = pk2(v.x, v.y); w.y = pk2(v.z, v.w); *(u32x2*)p = w; }
__device__ __forceinline__ float red_fq(float s) { s += __shfl_xor(s, 16); s += __shfl_xor(s, 32); return s; }

struct EpiInProj {
    static constexpr bool PERM = false, AFTER_DRAIN = false;
    float* UF; bf16_t* CQ; float* SSQ_CQ; float* CKVF; bf16_t* CKVB; float* SSQ_CKV; bf16_t* QMR; float* SSQ_QM; float* KRF; bf16_t* GATES;
    __device__ __forceinline__ void operator()(const f32x4 (&acc)[2][2][4][2], const pg8::Unit& u, int wr, int wc, int fr, int fq) const {
        EPI_RELANE();
        const int pn = u.pn;
#pragma unroll
        for (int ai = 0; ai < 2; ++ai)
#pragma unroll
            for (int m = 0; m < 4; ++m) {
                const int row = u.pm * 256 + ai * 128 + wr * 64 + m * 16 + fr;
                const int cl = wc * 32 + 4 * fq;
                if (pn < 2) {
#pragma unroll
                    for (int bj = 0; bj < 2; ++bj)
#pragma unroll
                        for (int n = 0; n < 2; ++n) *(f32x4*)(UF + (size_t)row * 512 + pn * 256 + bj * 128 + cl + 16 * n) = acc[ai][bj][m][n];
                } else if (pn < 4) {
                    float s = 0.f;
#pragma unroll
                    for (int bj = 0; bj < 2; ++bj)
#pragma unroll
                        for (int n = 0; n < 2; ++n) { st_bf4(CQ + (size_t)row * 512 + (pn - 2) * 256 + bj * 128 + cl + 16 * n, acc[ai][bj][m][n]); s += sq4(acc[ai][bj][m][n]); }
                    s = red_fq(s); if (fq == 0) SSQ_CQ[row * 8 + (pn - 2) * 4 + wc] = s;
                } else if (pn == 4) {
                    float s = 0.f;
#pragma unroll
                    for (int bj = 0; bj < 2; ++bj)
#pragma unroll
                        for (int n = 0; n < 2; ++n) { const int c = bj * 128 + cl + 16 * n; *(f32x4*)(CKVF + (size_t)row * 256 + c) = acc[ai][bj][m][n]; st_bf4(CKVB + (size_t)row * 256 + c, acc[ai][bj][m][n]); s += sq4(acc[ai][bj][m][n]); }
                    s = red_fq(s); if (fq == 0) SSQ_CKV[row * 4 + wc] = s;
                } else if (pn < 7) {
#pragma unroll
                    for (int bj = 0; bj < 2; ++bj) { float s = 0.f; const int head = 2 * (pn - 5) + bj;
#pragma unroll
                        for (int n = 0; n < 2; ++n) { st_bf4(QMR + (size_t)row * 512 + head * 128 + cl + 16 * n, acc[ai][bj][m][n]); s += sq4(acc[ai][bj][m][n]); }
                        s = red_fq(s); if (fq == 0) SSQ_QM[row * 16 + head * 4 + wc] = s; }
                } else if (pn == 7) {
                    if (wc < 2) {
#pragma unroll
                        for (int n = 0; n < 2; ++n) *(f32x4*)(KRF + (size_t)row * 64 + cl + 16 * n) = acc[ai][0][m][n];
                    }
                } else {
#pragma unroll
                    for (int bj = 0; bj < 2; ++bj)
#pragma unroll
                        for (int n = 0; n < 2; ++n) st_bf4(GATES + (size_t)row * 2048 + (pn - 8) * 256 + bj * 128 + cl + 16 * n, acc[ai][bj][m][n]);
                }
            }
    }
};

struct EpiMemKV {
    static constexpr bool PERM = false, AFTER_DRAIN = false;
    float* MKRAW; float* SSQ_MK; float* OUTV; bf16_t* VTM;
    __device__ __forceinline__ void operator()(const f32x4 (&acc)[2][2][4][2], const pg8::Unit& u, int wr, int wc, int fr, int fq) const {
        EPI_RELANE();
        const int pn = u.pn;
#pragma unroll
        for (int ai = 0; ai < 2; ++ai)
#pragma unroll
            for (int m = 0; m < 4; ++m) {
                const int row = u.pm * 256 + ai * 128 + wr * 64 + m * 16 + fr;
                const int cl = wc * 32 + 4 * fq;
                if (pn < 2) {
#pragma unroll
                    for (int bj = 0; bj < 2; ++bj) { float s = 0.f; const int head = 2 * pn + bj;
#pragma unroll
                        for (int n = 0; n < 2; ++n) { *(f32x4*)(MKRAW + (size_t)row * 512 + head * 128 + cl + 16 * n) = acc[ai][bj][m][n]; s += sq4(acc[ai][bj][m][n]); }
                        s = red_fq(s); if (fq == 0) SSQ_MK[row * 16 + head * 4 + wc] = s; }
                } else {
                    const int b = row >> 8, key = row & 255, kp = perm23(key);
#pragma unroll
                    for (int bj = 0; bj < 2; ++bj) { const int head = 2 * (pn - 2) + bj;
#pragma unroll
                        for (int n = 0; n < 2; ++n) { const f32x4 v = acc[ai][bj][m][n]; const int dv = cl + 16 * n;
                            *(f32x4*)(OUTV + (size_t)row * 512 + head * 128 + dv) = v;
                            bf16_t* t = VTM + ((size_t)(b * 4 + head) * 128 + dv) * 256 + kp;
                            t[0] = (bf16_t)f2bf(v.x); t[256] = (bf16_t)f2bf(v.y); t[512] = (bf16_t)f2bf(v.z); t[768] = (bf16_t)f2bf(v.w); } }
                }
            }
    }
};

struct EpiQ {
    static constexpr bool PERM = false, AFTER_DRAIN = false;
    const float* SSQ_CQ; const float* QCG; bf16_t* QG; float* SSQ_Q;
    __device__ __forceinline__ void operator()(const f32x4 (&acc)[2][2][4][2], const pg8::Unit& u, int wr, int wc, int fr, int fq) const {
        EPI_RELANE();
        const int h = u.pn;
        const int cl = wc * 32 + 4 * fq;
        const f32x4 g00 = *(const f32x4*)(QCG + cl), g01 = *(const f32x4*)(QCG + cl + 16);
        const int ri = 16 * wc + 4 * fq;
        f32x4 g10 = (f32x4){0.f, 0.f, 0.f, 0.f}, g11 = g10;
        if (wc < 2) { g10 = *(const f32x4*)(QCG + 128 + ri); g11 = *(const f32x4*)(QCG + 160 + ri); }
#pragma unroll
        for (int ai = 0; ai < 2; ++ai)
#pragma unroll
            for (int m = 0; m < 4; ++m) {
                const int row = u.pm * 256 + ai * 128 + wr * 64 + m * 16 + fr;
                const float* sp = SSQ_CQ + row * 8;
                const float rinv = 1.0f / sqrtf(((sp[0] + sp[1]) + (sp[2] + sp[3]) + (sp[4] + sp[5]) + (sp[6] + sp[7])) * (1.f / 512.f) + EPS);
                const f32x4 a0 = acc[ai][0][m][0] * rinv, a1 = acc[ai][0][m][1] * rinv;
                float sr = sq4(a0) + sq4(a1);
                const f32x4 q0 = a0 * g00, q1 = a1 * g01;
                float sg = sq4(q0) + sq4(q1);
                bf16_t* qrow = QG + (size_t)row * 1536 + h * 192;
                st_bf4(qrow + cl, q0); st_bf4(qrow + cl + 16, q1);
                if (wc < 2) {
                    const int pos = (row < NP) ? (row & (SEQ - 1)) : PAST + ((row - NP) & 7);
                    const f32x4 x1 = acc[ai][1][m][0] * rinv, x2 = acc[ai][1][m][1] * rinv;
                    f32x4 o1, o2;
#pragma unroll
                    for (int e = 0; e < 4; ++e) { float c, s; rope_cs(pos, ri + e, c, s); o1[e] = x1[e] * c - x2[e] * s; o2[e] = x1[e] * s + x2[e] * c; }
                    sr += sq4(o1) + sq4(o2);
                    const f32x4 r1 = o1 * g10, r2 = o2 * g11;
                    sg += sq4(r1) + sq4(r2);
                    st_bf4(qrow + 128 + ri, r1); st_bf4(qrow + 160 + ri, r2);
                }
                sr = red_fq(sr); sg = red_fq(sg);
                if (fq == 0) { float* d = SSQ_Q + ((size_t)row * 8 + h) * 8 + wc * 2; d[0] = sr; d[1] = sg; }
            }
    }
};

struct EpiKV {
    static constexpr bool PERM = false, AFTER_DRAIN = false;
    const float* SSQ_CKV; bf16_t* KNB; float* SSQ_KN; bf16_t* VT;
    __device__ __forceinline__ void operator()(const f32x4 (&acc)[2][2][4][2], const pg8::Unit& u, int wr, int wc, int fr, int fq) const {
        EPI_RELANE();
        const int h = u.pn;
        const int cl = wc * 32 + 4 * fq;
#pragma unroll
        for (int ai = 0; ai < 2; ++ai)
#pragma unroll
            for (int m = 0; m < 4; ++m) {
                const int row = u.pm * 256 + ai * 128 + wr * 64 + m * 16 + fr;
                const int b = row >> 12, t = row & (SEQ - 1);
                const float* sp = SSQ_CKV + row * 4;
                const float rinv = 1.0f / sqrtf(((sp[0] + sp[1]) + (sp[2] + sp[3])) * (1.f / 256.f) + EPS);
                const f32x4 k0 = acc[ai][0][m][0] * rinv, k1 = acc[ai][0][m][1] * rinv;
                bf16_t* kr = KNB + ((size_t)(b * 8 + h) * SEQ + t) * 128;
                st_bf4(kr + cl, k0); st_bf4(kr + cl + 16, k1);
                float s = red_fq(sq4(k0) + sq4(k1));
                if (fq == 0) SSQ_KN[((size_t)row * 8 + h) * 4 + wc] = s;
                const int tp = perm23(t);
#pragma unroll
                for (int n = 0; n < 2; ++n) { const f32x4 v = acc[ai][1][m][n] * rinv; const int dv = cl + 16 * n;
                    bf16_t* vp = VT + ((size_t)(b * 8 + h) * 128 + dv) * SEQ + tp;
                    vp[0] = (bf16_t)f2bf(v.x); vp[SEQ] = (bf16_t)f2bf(v.y); vp[2 * SEQ] = (bf16_t)f2bf(v.z); vp[3 * SEQ] = (bf16_t)f2bf(v.w); }
            }
    }
};

struct EpiMerge {
    static constexpr bool PERM = false, AFTER_DRAIN = false;
    const float* XP; const float* XS; float* Y;
    __device__ __forceinline__ void operator()(const f32x4 (&acc)[2][2][4][2], const pg8::Unit& u, int wr, int wc, int fr, int fq) const {
        EPI_RELANE();
#pragma unroll
        for (int ai = 0; ai < 2; ++ai)
#pragma unroll
            for (int m = 0; m < 4; ++m) {
                const int row = u.pm * 256 + ai * 128 + wr * 64 + m * 16 + fr;
                const float* xr = (row < NP) ? XP + (size_t)row * 2048 : XS + (size_t)(row - NP) * 2048;
                const int c0 = u.pn * 256 + wc * 32 + 4 * fq;
#pragma unroll
                for (int bj = 0; bj < 2; ++bj)
#pragma unroll
                    for (int n = 0; n < 2; ++n) { const int c = c0 + bj * 128 + 16 * n; *(f32x4*)(Y + (size_t)row * 2048 + c) = acc[ai][bj][m][n] + *(const f32x4*)(xr + c); }
            }
    }
};

__device__ __forceinline__ void p2a_rows(Frame& F, const Params& P) {
    int tid = F.tid; asm volatile("" : "+v"(tid));
    const int gw = F.bid * 8 + F.wave, NGW = F.G * 8, lane = tid & 63;
    const float* g_kv = P.in[24]; const float* g_mq = P.in[31]; const float* g_mk = P.in[32];
    for (int row = gw; row < NR + 512; row += NGW) {
        if (row < NR) {
            const bool prompt = row < NP;
            const int pos = prompt ? (row & (SEQ - 1)) : PAST + ((row - NP) & 7);
            { const float* sp = WSP(float, WS_SSQ_CKV) + row * 4;
              const float rinv = 1.0f / sqrtf(((sp[0] + sp[1]) + (sp[2] + sp[3])) * (1.f / 256.f) + EPS);
              const f32x4 v = *((const f32x4*)(WSP(float, WS_CKVF) + (size_t)row * 256) + lane) * rinv * *((const f32x4*)g_kv + lane);
              float* o = prompt ? F.out + O_CKV_P + (size_t)row * 256 : F.out + O_CKV_S + (size_t)(row - NP) * 256;
              *((f32x4*)o + lane) = v;
              if (!prompt) st_bf4(WSP(bf16_t, WS_CKVS) + (size_t)(row - NP) * 256 + 4 * lane, v); }
            { const float* kr = WSP(float, WS_KRF) + (size_t)row * 64;
              const int i = lane & 31; const float x1 = kr[i], x2 = kr[i + 32];
              float c, s; rope_cs(pos, i, c, s);
              const float o = (lane < 32) ? (x1 * c - x2 * s) : (x1 * s + x2 * c);
              float* op = prompt ? F.out + O_KR_P + (size_t)row * 64 : F.out + O_KR_S + (size_t)(row - NP) * 64;
              op[lane] = o;
              WSP(bf16_t, WS_KRB)[(size_t)row * 64 + lane] = (bf16_t)f2bf(o);
              const float ss = wave_sum(o * o);
              if (lane == 0) WSP(float, WS_SSQ_KR)[row] = ss; }
            { const u32x4 w = *((const u32x4*)(WSP(bf16_t, WS_QMR) + (size_t)row * 512) + lane);
              const int head = lane >> 4, j0 = (8 * lane) & 127;
              const float* sp = WSP(float, WS_SSQ_QM) + row * 16 + head * 4;
              const float rinv = 1.0f / sqrtf(((sp[0] + sp[1]) + (sp[2] + sp[3])) * (1.f / 128.f) + EPS);
              const float sc = rinv * (0.08838834764831845f * LOG2E);
              float q[8] = {bflo(w.x), bfhi(w.x), bflo(w.y), bfhi(w.y), bflo(w.z), bfhi(w.z), bflo(w.w), bfhi(w.w)};
              float sb = 0.f;
#pragma unroll
              for (int e = 0; e < 8; ++e) { q[e] *= sc * g_mq[j0 + e]; const float t = q[e] * g_mk[j0 + e]; sb += t * t; }
              u32x4 o; o.x = pk2(q[0], q[1]); o.y = pk2(q[2], q[3]); o.z = pk2(q[4], q[5]); o.w = pk2(q[6], q[7]);
              *((u32x4*)(WSP(bf16_t, WS_QM) + (size_t)row * 512) + lane) = o;
              sb += __shfl_xor(sb, 1); sb += __shfl_xor(sb, 2); sb += __shfl_xor(sb, 4); sb += __shfl_xor(sb, 8);
              if ((lane & 15) == 0) WSP(float, WS_MQM)[row * 4 + head] = sqrtf(sb) * 11.313708498984761f; }
        } else {
            const int mr = row - NR, b = mr >> 8, key = mr & 255;
            const int head = lane >> 4, j0 = (8 * lane) & 127;
            const float* src = WSP(float, WS_MKRAW) + (size_t)mr * 512 + 8 * lane;
            const float* sp = WSP(float, WS_SSQ_MK) + mr * 16 + head * 4;
            const float rinv = 1.0f / sqrtf(((sp[0] + sp[1]) + (sp[2] + sp[3])) * (1.f / 128.f) + EPS);
            f32x4 a = *(const f32x4*)src * rinv * *(const f32x4*)(g_mk + j0), c = *(const f32x4*)(src + 4) * rinv * *(const f32x4*)(g_mk + j0 + 4);
            float* o = F.out + O_MK + (size_t)mr * 512 + 8 * lane;
            *(f32x4*)o = a; *(f32x4*)(o + 4) = c;
            u32x4 w; w.x = pk2(a.x, a.y); w.y = pk2(a.z, a.w); w.z = pk2(c.x, c.y); w.w = pk2(c.z, c.w);
            *(u32x4*)(WSP(bf16_t, WS_MKB) + ((size_t)(b * 4 + head) * 256 + key) * 128 + j0) = w;
        }
    }
}

constexpr int SSM_U_OFF = 0, SSM_X_OFF = 16384, SSM_X_BYTES = 32 * 136 * 2, SSM_G_OFF = SSM_X_OFF + 8 * SSM_X_BYTES, SSM_G_PITCH = 520;
__device__ __forceinline__ float sigmoidf_(float a) { return 1.0f / (1.0f + ex2(-a * LOG2E)); }
template <int MODE>
__device__ __forceinline__ void ssm_unit(Frame& F, const Params& P, int unit) {
    int tid = F.tid; asm volatile("" : "+v"(tid));
    const int lane = tid & 63, w = F.wave, n = lane;
    const int b = unit >> 7, c = unit & 127;
    const int base = (MODE == 2) ? NP + 32 * unit : b * SEQ + c * 32;
    LAS float* Uw = (LAS float*)(F.lds + SSM_U_OFF + w * 2048);
    LAS bf16_t* Xw = (LAS bf16_t*)(F.lds + SSM_X_OFF + w * SSM_X_BYTES);
    LAS bf16_t* Gt = (LAS bf16_t*)(F.lds + SSM_G_OFF);
    const float* UF = WSP(float, WS_UF);
    for (int gi = 0; gi < 4; ++gi) {
        const int g = 4 * w + gi;
        { const int t = lane >> 1, p0 = (lane & 1) * 8; const float* s = UF + (size_t)(base + t) * 512 + 16 * g + p0;
          const f32x4 a = *(const f32x4*)s, d = *(const f32x4*)(s + 4);
          *(LAS f32x4*)(Uw + t * 16 + p0) = a; *(LAS f32x4*)(Uw + t * 16 + p0 + 4) = d; }
        f32x2 bb[16];
        { const f32x4* s = (const f32x4*)(WSP(f32x2, WS_BBAR) + (size_t)(g * 64 + n) * 16);
#pragma unroll
          for (int q = 0; q < 8; ++q) { const f32x4 v = s[q]; bb[2 * q] = (f32x2){v.x, v.y}; bb[2 * q + 1] = (f32x2){v.z, v.w}; } }
        const f32x2 ab = WSP(f32x2, WS_ABAR)[g * 64 + n];
        float xr = 0.f, xi = 0.f;
        if (MODE == 1) {
            const f32x2 al = WSP(f32x2, WS_ABARL)[g * 64 + n];
            const f32x2* sch = WSP(f32x2, WS_SCH) + ((size_t)(b * 128) * 32 + g) * 64 + n;
            for (int cc = 0; cc < c; ++cc) { const f32x2 s = sch[(size_t)cc * 2048]; const float nr = al.x * xr - al.y * xi + s.x, ni = al.x * xi + al.y * xr + s.y; xr = nr; xi = ni; }
        }
        LDS_WAIT();
        for (int t = 0; t < 32; ++t) {
            if (MODE == 2 && (t & 7) == 0) { const int bs = 4 * unit + (t >> 3); xr = P.in[7][(size_t)(bs * 32 + g) * 64 + n]; xi = P.in[8][(size_t)(bs * 32 + g) * 64 + n]; }
            const f32x4 u0 = *(LAS f32x4*)(Uw + t * 16), u1 = *(LAS f32x4*)(Uw + t * 16 + 4), u2 = *(LAS f32x4*)(Uw + t * 16 + 8), u3 = *(LAS f32x4*)(Uw + t * 16 + 12);
            const float uu[16] = {u0.x, u0.y, u0.z, u0.w, u1.x, u1.y, u1.z, u1.w, u2.x, u2.y, u2.z, u2.w, u3.x, u3.y, u3.z, u3.w};
            float br = 0.f, bi = 0.f;
#pragma unroll
            for (int p = 0; p < 16; ++p) { br += bb[p].x * uu[p]; bi += bb[p].y * uu[p]; }
            const float nr = ab.x * xr - ab.y * xi + br, ni = ab.x * xi + ab.y * xr + bi; xr = nr; xi = ni;
            if (MODE >= 1) { Xw[t * 136 + n] = (bf16_t)f2bf(xr); Xw[t * 136 + 64 + n] = (bf16_t)f2bf(xi); }
            if (MODE == 2 && (t & 7) == 7) { const int bs = 4 * unit + (t >> 3); F.out[O_SRE_S + (size_t)(bs * 32 + g) * 64 + n] = xr; F.out[O_SIM_S + (size_t)(bs * 32 + g) * 64 + n] = xi; }
        }
        if (MODE == 0) WSP(f32x2, WS_SCH)[((size_t)(b * 128 + c) * 32 + g) * 64 + n] = (f32x2){xr, xi};
        if (MODE == 1 && c == 127) { F.out[O_SRE_P + (size_t)(b * 32 + g) * 64 + n] = xr; F.out[O_SIM_P + (size_t)(b * 32 + g) * 64 + n] = xi; }
        if (MODE >= 1) {
            LDS_WAIT();
            f32x16 acc = zero16();
            const int i32 = lane & 31, hh = lane >> 5;
            const bf16_t* cb = WSP(bf16_t, WS_CSTB) + (size_t)(g * 32 + i32) * 128 + 8 * hh;
#pragma unroll
            for (int ks = 0; ks < 8; ++ks) { const bf16x8 a = *(LAS bf16x8*)(Xw + i32 * 136 + 16 * ks + 8 * hh); const bf16x8 bq = *(const bf16x8*)(cb + 16 * ks); acc = mfma32(a, bq, acc); }
            if (i32 < 16) { const float dp = P.in[19][16 * g + i32];
#pragma unroll
                for (int r = 0; r < 16; ++r) { const int t = crow(r, hh); const float y = acc[r] + dp * Uw[t * 16 + i32];
                    const float gl = y * sigmoidf_(1.5957691216057308f * (y + 0.044715f * y * y * y));
                    Gt[t * SSM_G_PITCH + 16 * g + i32] = (bf16_t)f2bf(gl); } }
        }
        LDS_WAIT();
    }
    if (MODE >= 1) {
        __syncthreads();
        const int i32 = lane & 31, hh = lane >> 5;
        const u32x4* gf = WSP(u32x4, WS_GLUF);
#pragma unroll
        for (int q = 0; q < 2; ++q) { const int cbk = 2 * w + q; f32x16 acc = zero16();
#pragma unroll 8
            for (int ks = 0; ks < 32; ++ks) { const bf16x8 a = *(LAS bf16x8*)(Gt + i32 * SSM_G_PITCH + 16 * ks + 8 * hh); const u32x4 bw = gf[(size_t)(cbk * 32 + ks) * 64 + lane]; acc = mfma32(a, __builtin_bit_cast(bf16x8, bw), acc); }
            const int ch = cbk * 32 + i32; const float bias = P.in[21][ch];
#pragma unroll
            for (int r = 0; r < 16; ++r) { const int t = crow(r, hh); const float gv = bf2f(Gt[t * SSM_G_PITCH + ch]);
                WSP(bf16_t, WS_YSSM)[(size_t)(base + t) * 512 + ch] = (bf16_t)f2bf(gv * sigmoidf_(acc[r] + bias)); } }
        __syncthreads();
    }
}

template <bool MLA> struct AttnCfg { static constexpr int DQK = MLA ? 192 : 128, KP = DQK + 8, KS = DQK / 16, KBUF = 64 * KP * 2, VP = 72, VBUF = 128 * VP * 2,
                                     K_OFF = 0, V_OFF = 2 * KBUF, RK_OFF = V_OFF + 2 * VBUF; };
template <bool MLA>
__device__ __forceinline__ void attn_qblock(Frame& F, int b, int h, int qb) {
    typedef AttnCfg<MLA> C;
    int tid = F.tid; asm volatile("" : "+v"(tid));
    const int lane = tid & 63, w = F.wave, i32 = lane & 31, hh = lane >> 5, qs = w & 3, kh = w >> 2;
    const int qrow = qb * 128 + qs * 32 + i32, grow = b * SEQ + qrow;
    LAS unsigned char* lds = F.lds;
    bf16x8 qf[C::KS]; float M2;
    if (MLA) {
        const float* sp = WSP(float, WS_SSQ_Q) + ((size_t)grow * 8 + h) * 8;
        const float sr = (sp[0] + sp[2]) + (sp[4] + sp[6]), sg = (sp[1] + sp[3]) + (sp[5] + sp[7]);
        const float rinv = 1.0f / sqrtf(sr * (1.f / 192.f) + EPS);
        M2 = 13.856406460551018f * rinv * sqrtf(sg);
        const bf16_t* qp = WSP(bf16_t, WS_QG) + (size_t)grow * 1536 + h * 192 + 8 * hh;
#pragma unroll
        for (int ks = 0; ks < C::KS; ++ks) { const u32x4 v = *(const u32x4*)(qp + 16 * ks); u32x4 o;
            o.x = pk2(bflo(v.x) * rinv, bfhi(v.x) * rinv); o.y = pk2(bflo(v.y) * rinv, bfhi(v.y) * rinv); o.z = pk2(bflo(v.z) * rinv, bfhi(v.z) * rinv); o.w = pk2(bflo(v.w) * rinv, bfhi(v.w) * rinv);
            qf[ks] = __builtin_bit_cast(bf16x8, o); }
    } else {
        M2 = WSP(float, WS_MQM)[grow * 4 + h];
        const bf16_t* qp = WSP(bf16_t, WS_QM) + (size_t)grow * 512 + h * 128 + 8 * hh;
#pragma unroll
        for (int ks = 0; ks < C::KS; ++ks) qf[ks] = *(const bf16x8*)(qp + 16 * ks);
    }
    const int ntiles = MLA ? 2 * qb + 2 : 4;
    u32x4 sk0, sk1, skr, sv0, sv1; float srk = 0.f;
    auto issue = [&](int j) {
        const int t0 = j * 64;
        if (MLA) {
            const bf16_t* kn = WSP(bf16_t, WS_KNB) + ((size_t)(b * 8 + h) * SEQ + t0) * 128;
            sk0 = *(const u32x4*)(kn + (size_t)tid * 8); sk1 = *(const u32x4*)(kn + (size_t)(tid + 512) * 8);
            skr = *(const u32x4*)(WSP(bf16_t, WS_KRB) + ((size_t)(b * SEQ + t0)) * 64 + (size_t)tid * 8);
            const bf16_t* vt = WSP(bf16_t, WS_VT) + ((size_t)(b * 8 + h) * 128) * SEQ + t0;
            sv0 = *(const u32x4*)(vt + (size_t)(tid >> 3) * SEQ + (tid & 7) * 8); sv1 = *(const u32x4*)(vt + (size_t)((tid >> 3) + 64) * SEQ + (tid & 7) * 8);
            if (tid < 64) { const int gk = b * SEQ + t0 + tid; const float* sp = WSP(float, WS_SSQ_KN) + ((size_t)gk * 8 + h) * 4;
                srk = 1.0f / sqrtf(((sp[0] + sp[1]) + (sp[2] + sp[3]) + WSP(float, WS_SSQ_KR)[gk]) * (1.f / 192.f) + EPS); }
        } else {
            const bf16_t* kn = WSP(bf16_t, WS_MKB) + ((size_t)(b * 4 + h) * MEMT + t0) * 128;
            sk0 = *(const u32x4*)(kn + (size_t)tid * 8); sk1 = *(const u32x4*)(kn + (size_t)(tid + 512) * 8);
            const bf16_t* vt = WSP(bf16_t, WS_VTM) + ((size_t)(b * 4 + h) * 128) * MEMT + t0;
            sv0 = *(const u32x4*)(vt + (size_t)(tid >> 3) * MEMT + (tid & 7) * 8); sv1 = *(const u32x4*)(vt + (size_t)((tid >> 3) + 64) * MEMT + (tid & 7) * 8);
        }
    };
    auto commit = [&](int buf) {
        LAS bf16_t* kt = (LAS bf16_t*)(lds + C::K_OFF + buf * C::KBUF); LAS bf16_t* vt = (LAS bf16_t*)(lds + C::V_OFF + buf * C::VBUF);
        *(LAS u32x4*)(kt + (tid >> 4) * C::KP + (tid & 15) * 8) = sk0; *(LAS u32x4*)(kt + ((tid >> 4) + 32) * C::KP + (tid & 15) * 8) = sk1;
        if (MLA) { *(LAS u32x4*)(kt + (tid >> 3) * C::KP + 128 + (tid & 7) * 8) = skr; if (tid < 64) ((LAS float*)(lds + C::RK_OFF))[buf * 64 + tid] = srk; }
        *(LAS u32x4*)(vt + (tid >> 3) * C::VP + (tid & 7) * 8) = sv0; *(LAS u32x4*)(vt + ((tid >> 3) + 64) * C::VP + (tid & 7) * 8) = sv1;
    };
    f32x16 o[4]; o[0] = zero16(); o[1] = zero16(); o[2] = zero16(); o[3] = zero16();
    float lsum = 0.f;
    issue(0); commit(0); __syncthreads();
    for (int j = 0; j < ntiles; ++j) {
        const int buf = j & 1;
        if (j + 1 < ntiles) issue(j + 1);
        LAS bf16_t* kt = (LAS bf16_t*)(lds + C::K_OFF + buf * C::KBUF) + (kh * 32 + i32) * C::KP + 8 * hh;
        f32x16 s = zero16();
#pragma unroll
        for (int ks = 0; ks < C::KS; ++ks) s = mfma32(*(LAS bf16x8*)(kt + 16 * ks), qf[ks], s);
        float p[16];
        if (MLA) {
            const LAS float* rk = (const LAS float*)(lds + C::RK_OFF) + buf * 64 + kh * 32 + 4 * hh;
#pragma unroll
            for (int g4 = 0; g4 < 4; ++g4) { const f32x4 r4 = *(const LAS f32x4*)(rk + 8 * g4);
#pragma unroll
                for (int e = 0; e < 4; ++e) p[4 * g4 + e] = s[4 * g4 + e] * r4[e] - M2; }
            if (j >= 2 * qb) {
                const int kbase = j * 64 + kh * 32 + 4 * hh;
#pragma unroll
                for (int r = 0; r < 16; ++r) if (kbase + (r & 3) + 8 * (r >> 2) > qrow) p[r] = -__builtin_inff();
            }
        } else {
#pragma unroll
            for (int r = 0; r < 16; ++r) p[r] = s[r] - M2;
        }
#pragma unroll
        for (int r = 0; r < 16; ++r) { p[r] = ex2(p[r]); lsum += p[r]; }
        u32x4 w0, w1; w0.x = pk2(p[0], p[1]); w0.y = pk2(p[2], p[3]); w0.z = pk2(p[4], p[5]); w0.w = pk2(p[6], p[7]);
        w1.x = pk2(p[8], p[9]); w1.y = pk2(p[10], p[11]); w1.z = pk2(p[12], p[13]); w1.w = pk2(p[14], p[15]);
        const bf16x8 pb0 = __builtin_bit_cast(bf16x8, w0), pb1 = __builtin_bit_cast(bf16x8, w1);
        LAS bf16_t* vt = (LAS bf16_t*)(lds + C::V_OFF + buf * C::VBUF) + i32 * C::VP + kh * 32 + 8 * hh;
#pragma unroll
        for (int db = 0; db < 4; ++db) { o[db] = mfma32(*(LAS bf16x8*)(vt + db * 32 * C::VP), pb0, o[db]); o[db] = mfma32(*(LAS bf16x8*)(vt + db * 32 * C::VP + 16), pb1, o[db]); }
        if (j + 1 < ntiles) commit(buf ^ 1);
        __syncthreads();
    }
    lsum += __shfl_xor(lsum, 32);
    LAS float* xo = (LAS float*)lds + qs * 4096;
    LAS float* xl = (LAS float*)lds + 4 * 4096 + qs * 64;
    if (kh == 1) {
#pragma unroll
        for (int db = 0; db < 4; ++db)
#pragma unroll
            for (int r = 0; r < 16; ++r) xo[(db * 16 + r) * 64 + lane] = o[db][r];
        xl[lane] = lsum;
    }
    __syncthreads();
    if (kh == 0) {
        const float inv = 1.0f / (lsum + xl[lane]);
        bf16_t* yp = MLA ? WSP(bf16_t, WS_YMLA) + (size_t)grow * 1024 + h * 128 : WSP(bf16_t, WS_YMEM) + (size_t)grow * 512 + h * 128;
#pragma unroll
        for (int db = 0; db < 4; ++db)
#pragma unroll
            for (int g4 = 0; g4 < 4; ++g4) { f32x4 v;
#pragma unroll
                for (int e = 0; e < 4; ++e) v[e] = (o[db][4 * g4 + e] + xo[(db * 16 + 4 * g4 + e) * 64 + lane]) * inv;
                st_bf4(yp + db * 32 + 8 * g4 + 4 * hh, v); }
    }
    __syncthreads();
}

constexpr int SM_CT = 0, SM_RT = 65536, SM_RP = 72, SM_QA = SM_RT + 128 * SM_RP * 2, SM_QP = 328, SM_PT = SM_QA + 64 * SM_QP * 2, SM_PP = 136,
              SM_RINV = SM_PT + 64 * SM_PP * 2, SM_SSQR = SM_RINV + 8 * 128 * 4, SM_M2 = SM_SSQR + 512, SM_LX = SM_M2 + 256, SM_END = SM_LX + 2048;
static_assert(SM_END <= LDS_MISC, "sample-MLA LDS map");
__device__ __forceinline__ int ct_off(int row, int col) {
    const int ch = (col & 127) >> 3;
    return ((col >> 7) << 15) + 256 * row + 16 * (ch ^ (((row & 3) << 2) | ((row >> 2) & 3))) + (col & 7) * 2;
}
template <int NTB, bool RELOAD>
__device__ __forceinline__ void z_block(u32x4 (&af)[16], LAS unsigned char* lds, int i32, int hh, float (&ssq)[4], __amdgpu_buffer_rsrc_t rs, int voff, int soff_next) {
    constexpr int NP2 = (NTB + 1) / 2, W2 = NTB > 1 ? 2 : 1;
#pragma unroll
    for (int hb = 0; hb < NP2; ++hb) {
        f32x16 acc[W2];
#pragma unroll
        for (int q = 0; q < W2; ++q) acc[q] = zero16();
        bf16x8 bc[W2], bn[W2];
#pragma unroll
        for (int q = 0; q < W2; ++q) bc[q] = *(LAS bf16x8*)(lds + SM_CT + ct_off((2 * hb + q) * 32 + i32, 8 * hh));
#pragma unroll
        for (int ks = 0; ks < 16; ++ks) {
            if (ks < 15) {
#pragma unroll
                for (int q = 0; q < W2; ++q) bn[q] = *(LAS bf16x8*)(lds + SM_CT + ct_off((2 * hb + q) * 32 + i32, 16 * (ks + 1) + 8 * hh));
            }
            const bf16x8 a = __builtin_bit_cast(bf16x8, af[ks]);
#pragma unroll
            for (int q = 0; q < W2; ++q) acc[q] = mfma32(a, bc[q], acc[q]);
            if (RELOAD && hb == NP2 - 1) af[ks] = __builtin_bit_cast(u32x4, __builtin_amdgcn_raw_buffer_load_b128(rs, voff, soff_next + ks * 1024, 0));
#pragma unroll
            for (int q = 0; q < W2; ++q) bc[q] = bn[q];
            __builtin_amdgcn_sched_barrier(0);
        }
#pragma unroll
        for (int q = 0; q < W2; ++q) { float s0 = 0.f;
#pragma unroll
            for (int r = 0; r < 16; ++r) s0 += acc[q][r] * acc[q][r];
            asm volatile("" : "+v"(s0));
            ssq[2 * hb + q] += s0; }
        __builtin_amdgcn_sched_barrier(0);
    }
}
__device__ __forceinline__ void z_load(u32x4 (&af)[16], __amdgpu_buffer_rsrc_t rs, int voff, int soff) {
#pragma unroll
    for (int ks = 0; ks < 16; ++ks) af[ks] = __builtin_bit_cast(u32x4, __builtin_amdgcn_raw_buffer_load_b128(rs, voff, soff + ks * 1024, 0));
}
template <int PAR, bool FRESH>
__device__ __forceinline__ void smla_tile(Frame& F, const Params& P, int bs, int page, f32x16 (&oacc)[2], float& lsum, u32x4 (&af)[16], __amdgpu_buffer_rsrc_t wrs) {
    int tid = F.tid; asm volatile("" : "+v"(tid));
    const int lane = tid & 63, w = F.wave, i32 = lane & 31, hh = lane >> 5;
    const int wvo = lane * 16, wso = w * 65536;
    LAS unsigned char* lds = F.lds;
    LAS bf16_t* RT = (LAS bf16_t*)(lds + SM_RT); LAS bf16_t* QA = (LAS bf16_t*)(lds + SM_QA); LAS bf16_t* PT = (LAS bf16_t*)(lds + SM_PT);
    LAS float* RINV = (LAS float*)(lds + SM_RINV); LAS float* SSQR = (LAS float*)(lds + SM_SSQR); LAS float* M2S = (LAS float*)(lds + SM_M2);
    {
#ifndef SM_NOLOAD
        if (!FRESH) {
            const float* cs = P.in[3] + (size_t)page * (PAGE * 256); const float* rs = P.in[4] + (size_t)page * (PAGE * 64);
#pragma unroll 4
            for (int it = 0; it < 8; ++it) { const int id = it * 512 + tid, row = id >> 5, col = (id & 31) * 8;
                const f32x4 a = *(const f32x4*)(cs + (size_t)id * 8), d = *(const f32x4*)(cs + (size_t)id * 8 + 4);
                u32x4 o; o.x = pk2(a.x, a.y); o.y = pk2(a.z, a.w); o.z = pk2(d.x, d.y); o.w = pk2(d.z, d.w);
                *(LAS u32x4*)(lds + SM_CT + ct_off(row, col)) = o; }
#pragma unroll
            for (int it = 0; it < 2; ++it) { const int id = it * 512 + tid, row = id >> 3, c8 = (id & 7) * 8;
                const f32x4 a = *(const f32x4*)(rs + (size_t)id * 8), d = *(const f32x4*)(rs + (size_t)id * 8 + 4);
                u32x4 o; o.x = pk2(a.x, a.y); o.y = pk2(a.z, a.w); o.z = pk2(d.x, d.y); o.w = pk2(d.z, d.w);
                *(LAS u32x4*)(RT + row * SM_RP + c8) = o;
                float ss = sq4(a) + sq4(d); ss += __shfl_xor(ss, 1); ss += __shfl_xor(ss, 2); ss += __shfl_xor(ss, 4);
                if ((id & 7) == 0) SSQR[row] = ss; }
        } else {
            for (int id = tid; id < 32 * 32; id += 512) { const int row = id >> 5, col = (id & 31) * 8; u32x4 o = (u32x4){0u, 0u, 0u, 0u};
                if (row < 8) o = *(const u32x4*)(WSP(bf16_t, WS_CKVS) + (size_t)(bs * 8 + row) * 256 + col);
                *(LAS u32x4*)(lds + SM_CT + ct_off(row, col)) = o; }
            if (tid < 256) { const int row = tid >> 3, c8 = (tid & 7) * 8; u32x4 o = (u32x4){0u, 0u, 0u, 0u};
                if (row < 8) o = *(const u32x4*)(WSP(bf16_t, WS_KRB) + (size_t)(NP + bs * 8 + row) * 64 + c8);
                *(LAS u32x4*)(RT + row * SM_RP + c8) = o; }
            if (tid < 32) SSQR[tid] = (tid < 8) ? WSP(float, WS_SSQ_KR)[NP + bs * 8 + tid] : 0.f;
        }
#endif
        __syncthreads();
#ifndef SM_NOZ
        {
            float ssq[4] = {0.f, 0.f, 0.f, 0.f};
            constexpr int NTBZ = FRESH ? 1 : 4;
            if (PAR == 0) { z_block<NTBZ, true>(af, lds, i32, hh, ssq, wrs, wvo, wso + 16384); z_block<NTBZ, true>(af, lds, i32, hh, ssq, wrs, wvo, wso + 32768);
                            z_block<NTBZ, true>(af, lds, i32, hh, ssq, wrs, wvo, wso + 49152); z_block<NTBZ, false>(af, lds, i32, hh, ssq, wrs, wvo, 0); }
            else          { z_block<NTBZ, true>(af, lds, i32, hh, ssq, wrs, wvo, wso + 32768); z_block<NTBZ, true>(af, lds, i32, hh, ssq, wrs, wvo, wso + 16384);
                            z_block<NTBZ, true>(af, lds, i32, hh, ssq, wrs, wvo, wso + 0); z_block<NTBZ, false>(af, lds, i32, hh, ssq, wrs, wvo, 0); }
            const int ntb = FRESH ? 1 : 4;
#pragma unroll
            for (int tb = 0; tb < 4; ++tb) if (tb < ntb) { float s = ssq[tb]; s += __shfl_xor(s, 32);
                if (hh == 0) RINV[w * 128 + tb * 32 + i32] = 1.0f / sqrtf((s + SSQR[tb * 32 + i32]) * (1.f / 192.f) + EPS); }
        }
#endif
        __syncthreads();
#ifndef SM_NOS
        {
            const int tb = w & 3, rb = w >> 2;
            if (!FRESH || tb == 0) {
                f32x16 s = zero16();
                const LAS bf16_t* qa = QA + (rb * 32 + i32) * SM_QP + 8 * hh;
#pragma unroll
                for (int ks = 0; ks < 16; ++ks) s = mfma32(*(LAS bf16x8*)(lds + SM_CT + ct_off(tb * 32 + i32, 16 * ks + 8 * hh)), *(const LAS bf16x8*)(qa + 16 * ks), s);
#pragma unroll
                for (int ks = 0; ks < 4; ++ks) s = mfma32(*(LAS bf16x8*)(RT + (tb * 32 + i32) * SM_RP + 16 * ks + 8 * hh), *(const LAS bf16x8*)(qa + 256 + 16 * ks), s);
                const int head = rb * 4 + (i32 >> 3), qi = i32 & 7;
                const float m2 = M2S[rb * 32 + i32];
                const LAS float* rv = RINV + head * 128 + tb * 32 + 4 * hh;
#pragma unroll
                for (int g4 = 0; g4 < 4; ++g4) { const f32x4 r4 = *(const LAS f32x4*)(rv + 8 * g4); float p[4];
#pragma unroll
                    for (int e = 0; e < 4; ++e) { float x = s[4 * g4 + e] * r4[e] - m2; if (FRESH && (8 * g4 + 4 * hh + e) > qi) x = -__builtin_inff(); p[e] = ex2(x); lsum += p[e]; }
                    u32x2 pw; pw.x = pk2(p[0], p[1]); pw.y = pk2(p[2], p[3]);
                    *(LAS u32x2*)(PT + (rb * 32 + i32) * SM_PP + tb * 32 + 8 * g4 + 4 * hh) = pw; }
            }
        }
#endif
        __syncthreads();
#ifndef SM_NOPV
        {
            const int rb = w >> 2, lb0 = 2 * (w & 3), nks = FRESH ? 2 : 8;
            const int blk = (lane >> 4) & 1, qq = (lane & 15) >> 2, pp = lane & 3;
            const LAS bf16_t* pt = PT + (rb * 32 + i32) * SM_PP + 8 * hh;
            for (int ks = 0; ks < nks; ++ks) {
                const bf16x8 bfr = *(const LAS bf16x8*)(pt + 16 * ks);
#pragma unroll
                for (int q = 0; q < 2; ++q) { const int lb = lb0 + q;
                    const int r0 = 16 * ks + 8 * hh + qq, col = lb * 32 + 16 * blk + 4 * pp;
                    const s16x4 t0 = __builtin_amdgcn_ds_read_tr16_b64_v4i16((LAS s16x4*)(lds + SM_CT + ct_off(r0, col)));
                    const s16x4 t1 = __builtin_amdgcn_ds_read_tr16_b64_v4i16((LAS s16x4*)(lds + SM_CT + ct_off(r0 + 4, col)));
                    const bf16x8 a = {t0[0], t0[1], t0[2], t0[3], t1[0], t1[1], t1[2], t1[3]};
                    oacc[q] = mfma32(a, bfr, oacc[q]); }
            }
        }
#endif
        __syncthreads();
    }
}
__device__ __forceinline__ void smla_unit(Frame& F, const Params& P, int unit) {
    int tid = F.tid; asm volatile("" : "+v"(tid));
    const int lane = tid & 63, w = F.wave, i32 = lane & 31, hh = lane >> 5;
    const int bs = unit >> 1, half = unit & 1;
    LAS unsigned char* lds = F.lds;
    LAS bf16_t* RT = (LAS bf16_t*)(lds + SM_RT); LAS bf16_t* QA = (LAS bf16_t*)(lds + SM_QA); LAS bf16_t* PT = (LAS bf16_t*)(lds + SM_PT);
    LAS float* RINV = (LAS float*)(lds + SM_RINV); LAS float* SSQR = (LAS float*)(lds + SM_SSQR); LAS float* M2S = (LAS float*)(lds + SM_M2); LAS float* LX = (LAS float*)(lds + SM_LX);
    {
        const int qi = lane & 7, grow = NP + bs * 8 + qi;
        const float* sp = WSP(float, WS_SSQ_Q) + ((size_t)grow * 8 + w) * 8;
        const float sr = (sp[0] + sp[2]) + (sp[4] + sp[6]), sg = (sp[1] + sp[3]) + (sp[5] + sp[7]);
        const float rinv = 1.0f / sqrtf(sr * (1.f / 192.f) + EPS);
        if (lane < 8) M2S[w * 8 + lane] = 13.856406460551018f * rinv * sqrtf(sg);
        const float ra = __shfl(rinv, i32 & 7);
        const bf16_t* qp = WSP(bf16_t, WS_QG) + (size_t)(NP + bs * 8 + (i32 & 7)) * 1536 + w * 192 + 8 * hh;
        bf16x8 af[8];
#pragma unroll
        for (int ks = 0; ks < 8; ++ks) { const u32x4 v = *(const u32x4*)(qp + 16 * ks); u32x4 o;
            o.x = pk2(bflo(v.x) * ra, bfhi(v.x) * ra); o.y = pk2(bflo(v.y) * ra, bfhi(v.y) * ra); o.z = pk2(bflo(v.z) * ra, bfhi(v.z) * ra); o.w = pk2(bflo(v.w) * ra, bfhi(v.w) * ra);
            af[ks] = __builtin_bit_cast(bf16x8, o); }
        const bf16_t* wb = WSP(bf16_t, WS_WKV_B) + (size_t)i32 * 2048 + w * 256 + 8 * hh;
#pragma unroll 1
        for (int lb = 0; lb < 8; ++lb) { f32x16 acc = zero16();
#pragma unroll
            for (int ks = 0; ks < 8; ++ks) acc = mfma32(af[ks], *(const bf16x8*)(wb + (size_t)lb * 32 * 2048 + 16 * ks), acc);
#pragma unroll
            for (int r = 0; r < 4; ++r) QA[(w * 8 + r + 4 * hh) * SM_QP + lb * 32 + i32] = (bf16_t)f2bf(acc[r]); }
        { const int q2 = lane >> 3, c8 = (lane & 7) * 8; const float rq = __shfl(rinv, q2);
          const u32x4 v = *(const u32x4*)(WSP(bf16_t, WS_QG) + (size_t)(NP + bs * 8 + q2) * 1536 + w * 192 + 128 + c8); u32x4 o;
          o.x = pk2(bflo(v.x) * rq, bfhi(v.x) * rq); o.y = pk2(bflo(v.y) * rq, bfhi(v.y) * rq); o.z = pk2(bflo(v.z) * rq, bfhi(v.z) * rq); o.w = pk2(bflo(v.w) * rq, bfhi(v.w) * rq);
          *(LAS u32x4*)(QA + (w * 8 + q2) * SM_QP + 256 + c8) = o; }
    }
    f32x16 oacc[2]; oacc[0] = zero16(); oacc[1] = zero16();
    float lsum = 0.f;
    u32x4 af[16];
    const __amdgpu_buffer_rsrc_t wrs = __builtin_amdgcn_make_buffer_rsrc((void*)(F.ws + WS_WF), 0, 32 * 16 * 1024, 0x00020000);
    z_load(af, wrs, lane * 16, w * 65536);
    const int* ptab = (const int*)P.in[9] + bs * NPAGES + half * 32;
    for (int tl = 0; tl < 32; tl += 2) {
        smla_tile<0, false>(F, P, bs, ptab[tl], oacc, lsum, af, wrs);
        smla_tile<1, false>(F, P, bs, ptab[tl + 1], oacc, lsum, af, wrs);
    }
    if (half) smla_tile<0, true>(F, P, bs, 0, oacc, lsum, af, wrs);
    {
        LAS bf16_t* OL = (LAS bf16_t*)(lds + SM_CT);
        const int rb = w >> 2, lb0 = 2 * (w & 3);
#pragma unroll
        for (int q = 0; q < 2; ++q)
#pragma unroll
            for (int g4 = 0; g4 < 4; ++g4) { u32x2 pw; pw.x = pk2(oacc[q][4 * g4], oacc[q][4 * g4 + 1]); pw.y = pk2(oacc[q][4 * g4 + 2], oacc[q][4 * g4 + 3]);
                *(LAS u32x2*)(OL + (rb * 32 + i32) * 264 + (lb0 + q) * 32 + 8 * g4 + 4 * hh) = pw; }
        LX[w * 64 + lane] = lsum;
        __syncthreads();
        const LAS bf16_t* ar = OL + (w * 8 + (i32 & 7)) * 264 + 8 * hh;
        bf16x8 af[16];
#pragma unroll
        for (int ks = 0; ks < 16; ++ks) af[ks] = *(const LAS bf16x8*)(ar + 16 * ks);
        float* yp = WSP(float, WS_YPS) + ((size_t)(bs * 2 + half) * 64 + w * 8) * 128;
#pragma unroll 1
        for (int nb = 0; nb < 4; ++nb) { f32x16 acc = zero16();
            const bf16_t* wt = WSP(bf16_t, WS_WKV_T) + (size_t)(w * 256 + 128 + nb * 32 + i32) * 256 + 8 * hh;
#pragma unroll
            for (int ks = 0; ks < 16; ++ks) acc = mfma32(af[ks], *(const bf16x8*)(wt + 16 * ks), acc);
#pragma unroll
            for (int r = 0; r < 4; ++r) yp[(size_t)(r + 4 * hh) * 128 + nb * 32 + i32] = acc[r]; }
        if (lane < 8) { const int r32 = (w & 3) * 8 + lane; float l = 0.f;
#pragma unroll
            for (int tb = 0; tb < 4; ++tb) l += LX[((w >> 2) * 4 + tb) * 64 + r32] + LX[((w >> 2) * 4 + tb) * 64 + 32 + r32];
            WSP(float, WS_LPS)[(size_t)(bs * 2 + half) * 64 + w * 8 + lane] = l; }
        __syncthreads();
    }
}

__device__ __forceinline__ void smem_unit(Frame& F, const Params& P, int bs) {
    int tid = F.tid; asm volatile("" : "+v"(tid));
    const int lane = tid & 63, w = F.wave;
    LAS float* Qs = (LAS float*)F.lds;
    LAS float* Ps = Qs + 4096;
    LAS float* Ls = Ps + 8192;
    { const int row = NP + bs * 8 + (tid >> 6), c8 = (tid & 63) * 8;
      const u32x4 v = *(const u32x4*)(WSP(bf16_t, WS_QM) + (size_t)row * 512 + c8);
      LAS float* d = Qs + (tid >> 6) * 512 + c8;
      *(LAS f32x4*)d = (f32x4){bflo(v.x), bfhi(v.x), bflo(v.y), bfhi(v.y)}; *(LAS f32x4*)(d + 4) = (f32x4){bflo(v.z), bfhi(v.z), bflo(v.w), bfhi(v.w)}; }
    __syncthreads();
    { const int key = tid & 255, hp = tid >> 8;
#pragma unroll
      for (int q = 0; q < 2; ++q) { const int hd = 2 * hp + q;
          const f32x4* kp = (const f32x4*)(P.in[5] + ((size_t)(bs * MEMT + key) * 4 + hd) * 128);
          float acc[8] = {0.f, 0.f, 0.f, 0.f, 0.f, 0.f, 0.f, 0.f};
#pragma unroll 4
          for (int j4 = 0; j4 < 32; ++j4) { const f32x4 kv = kp[j4];
#pragma unroll
              for (int i = 0; i < 8; ++i) { const f32x4 qv = *(LAS f32x4*)(Qs + (i * 4 + hd) * 128 + 4 * j4); acc[i] += (kv.x * qv.x + kv.y * qv.y) + (kv.z * qv.z + kv.w * qv.w); } }
#pragma unroll
          for (int i = 0; i < 8; ++i) Ps[(hd * 8 + i) * 256 + key] = ex2(acc[i] - WSP(float, WS_MQM)[(NP + bs * 8 + i) * 4 + hd]); } }
    __syncthreads();
#pragma unroll
    for (int q = 0; q < 4; ++q) { const int r = 4 * w + q; const LAS float* p = Ps + r * 256 + lane;
        const float s = wave_sum((p[0] + p[64]) + (p[128] + p[192])); if (lane == 0) Ls[r] = s; }
    { const int dv = tid & 127, hd = tid >> 7;
      const float* vp = P.in[6] + ((size_t)(bs * MEMT) * 4 + hd) * 128 + dv;
      float acc[8] = {0.f, 0.f, 0.f, 0.f, 0.f, 0.f, 0.f, 0.f};
      for (int k4 = 0; k4 < 64; ++k4) {
          const float v0 = vp[(size_t)(4 * k4) * 512], v1 = vp[(size_t)(4 * k4 + 1) * 512], v2 = vp[(size_t)(4 * k4 + 2) * 512], v3 = vp[(size_t)(4 * k4 + 3) * 512];
#pragma unroll
          for (int i = 0; i < 8; ++i) { const f32x4 pv = *(LAS f32x4*)(Ps + (hd * 8 + i) * 256 + 4 * k4); acc[i] += (pv.x * v0 + pv.y * v1) + (pv.z * v2 + pv.w * v3); } }
      __syncthreads();
#pragma unroll
      for (int i = 0; i < 8; ++i) WSP(bf16_t, WS_YMEM)[(size_t)(NP + bs * 8 + i) * 512 + hd * 128 + dv] = (bf16_t)f2bf(acc[i] / Ls[hd * 8 + i]); }
    __syncthreads();
}

__device__ __forceinline__ float silu_(float g) { return g / (1.0f + ex2(-g * LOG2E)); }
__device__ __forceinline__ void unpack8(const u32x4 v, float* f) { f[0] = bflo(v.x); f[1] = bfhi(v.x); f[2] = bflo(v.y); f[3] = bfhi(v.y); f[4] = bflo(v.z); f[5] = bfhi(v.z); f[6] = bflo(v.w); f[7] = bfhi(v.w); }
__device__ __forceinline__ void oprep_rows(Frame& F, const Params& P) {
    int tid = F.tid; asm volatile("" : "+v"(tid));
    const int gw = F.bid * 8 + F.wave, NGW = F.G * 8, lane = tid & 63;
    const float* g_ssm = P.in[33]; const float* g_mla = P.in[34]; const float* g_mem = P.in[35];
    for (int row = gw; row < NR; row += NGW) {
        const bf16_t* gates = WSP(bf16_t, WS_GATES) + (size_t)row * 2048;
        bf16_t* orow = WSP(bf16_t, WS_O) + (size_t)row * 2048;
#pragma unroll
        for (int part = 0; part < 2; ++part) {
            const bf16_t* ysrc = (part == 0 ? WSP(bf16_t, WS_YSSM) : WSP(bf16_t, WS_YMEM)) + (size_t)row * 512 + 8 * lane;
            const float* gn = (part == 0 ? g_ssm : g_mem) + 8 * lane;
            const int oc = (part == 0 ? 0 : 1536) + 8 * lane;
            float y[8], gt[8]; unpack8(*(const u32x4*)ysrc, y); unpack8(*(const u32x4*)(gates + oc), gt);
            float s = 0.f;
#pragma unroll
            for (int e = 0; e < 8; ++e) s += y[e] * y[e];
            const float rinv = 1.0f / sqrtf(wave_sum(s) * (1.f / 512.f) + EPS);
            float o[8];
#pragma unroll
            for (int e = 0; e < 8; ++e) o[e] = y[e] * rinv * gn[e] * silu_(gt[e]);
            u32x4 wv; wv.x = pk2(o[0], o[1]); wv.y = pk2(o[2], o[3]); wv.z = pk2(o[4], o[5]); wv.w = pk2(o[6], o[7]);
            *(u32x4*)(orow + oc) = wv;
        }
        {
            float y[16];
            if (row < NP) { unpack8(*(const u32x4*)(WSP(bf16_t, WS_YMLA) + (size_t)row * 1024 + 16 * lane), &y[0]); unpack8(*(const u32x4*)(WSP(bf16_t, WS_YMLA) + (size_t)row * 1024 + 16 * lane + 8), &y[8]); }
            else { const int sr = row - NP, bs = sr >> 3, qi = sr & 7, h = lane >> 3, dv0 = (lane & 7) * 16;
                const size_t r0 = (size_t)(bs * 2) * 64 + h * 8 + qi, r1 = r0 + 64;
                const float inv = 1.0f / (WSP(float, WS_LPS)[r0] + WSP(float, WS_LPS)[r1]);
                const f32x4* a = (const f32x4*)(WSP(float, WS_YPS) + r0 * 128 + dv0); const f32x4* c = (const f32x4*)(WSP(float, WS_YPS) + r1 * 128 + dv0);
#pragma unroll
                for (int q = 0; q < 4; ++q) { const f32x4 v = (a[q] + c[q]) * inv; y[4 * q] = v.x; y[4 * q + 1] = v.y; y[4 * q + 2] = v.z; y[4 * q + 3] = v.w; } }
            float gt[16]; unpack8(*(const u32x4*)(gates + 512 + 16 * lane), &gt[0]); unpack8(*(const u32x4*)(gates + 512 + 16 * lane + 8), &gt[8]);
            float s = 0.f;
#pragma unroll
            for (int e = 0; e < 16; ++e) s += y[e] * y[e];
            const float rinv = 1.0f / sqrtf(wave_sum(s) * (1.f / 1024.f) + EPS);
            const float* gn = g_mla + 16 * lane;
            float o[16];
#pragma unroll
            for (int e = 0; e < 16; ++e) o[e] = y[e] * rinv * gn[e] * silu_(gt[e]);
            u32x4 w0, w1; w0.x = pk2(o[0], o[1]); w0.y = pk2(o[2], o[3]); w0.z = pk2(o[4], o[5]); w0.w = pk2(o[6], o[7]);
            w1.x = pk2(o[8], o[9]); w1.y = pk2(o[10], o[11]); w1.z = pk2(o[12], o[13]); w1.w = pk2(o[14], o[15]);
            *(u32x4*)(orow + 512 + 16 * lane) = w0; *(u32x4*)(orow + 512 + 16 * lane + 8) = w1;
        }
    }
}

#ifndef PH
#define PH 4095
#endif
__global__ void __launch_bounds__(512, 2) hymba_fwd(Params P) {
    extern __shared__ __attribute__((aligned(16))) unsigned char lds_raw[];
    Frame F;
    F.lds = (LAS unsigned char*)lds_raw; F.ws = P.ws; F.out = P.out;
    F.tid = threadIdx.x; F.lane = F.tid & 63; F.wave = __builtin_amdgcn_readfirstlane(F.tid >> 6); F.G = gridDim.x; F.bid = blockIdx.x;
    volatile LAS unsigned* MISC = (volatile LAS unsigned*)(F.lds + LDS_MISC);
    if (F.tid < 16) MISC[F.tid] = 0u;
    __syncthreads();
    XcdBarrier bar = xcd_barrier_post((unsigned*)(P.ws + WS_CTL), MISC);

#if PH & 1
    p0_prologue(F, P);
#endif
    xcd_barrier(bar);

#if PH & 2
    {
        pg8::Gemm g{WSP(bf16_t, WS_XN), WSP(bf16_t, WS_WIN_T), NR, NIN, 2048}; pg8::StaticOrder S; S.init(NR, NIN, F.G, F.bid);
        EpiInProj E{WSP(float, WS_UF), WSP(bf16_t, WS_CQ), WSP(float, WS_SSQ_CQ), WSP(float, WS_CKVF), WSP(bf16_t, WS_CKVB), WSP(float, WS_SSQ_CKV), WSP(bf16_t, WS_QMR), WSP(float, WS_SSQ_QM), WSP(float, WS_KRF), WSP(bf16_t, WS_GATES)};
        pg8::gemm_phase<EpiInProj, pg8::StaticOrder, false>(F.lds, g, S, E, nullptr);
        __syncthreads();
        pg8::Gemm g2{WSP(bf16_t, WS_MEMN), WSP(bf16_t, WS_MEMKV_T), 512, 1024, 2048}; pg8::StaticOrder S2; S2.init(512, 1024, F.G, F.G - 1 - F.bid);
        EpiMemKV E2{WSP(float, WS_MKRAW), WSP(float, WS_SSQ_MK), F.out + O_MV, WSP(bf16_t, WS_VTM)};
        pg8::gemm_phase<EpiMemKV, pg8::StaticOrder, false>(F.lds, g2, S2, E2, nullptr);
    }
#endif
    xcd_barrier(bar);

    {
#if PH & 4
        pg8::Gemm g{WSP(bf16_t, WS_CQ), WSP(bf16_t, WS_WUQ_T), NR, 2048, 512}; pg8::StaticOrder S; S.init(NR, 2048, F.G, F.bid);
        EpiQ E{WSP(float, WS_SSQ_CQ), WSP(float, WS_QCG), WSP(bf16_t, WS_QG), WSP(float, WS_SSQ_Q)};
        pg8::gemm_phase<EpiQ, pg8::StaticOrder, false>(F.lds, g, S, E, nullptr);
        __syncthreads();
        pg8::Gemm g2{WSP(bf16_t, WS_CKVB), WSP(bf16_t, WS_WKV_TG), NP, 2048, 256}; pg8::StaticOrder S2; S2.init(NP, 2048, F.G, F.G - 1 - F.bid);
        EpiKV E2{WSP(float, WS_SSQ_CKV), WSP(bf16_t, WS_KNB), WSP(float, WS_SSQ_KN), WSP(bf16_t, WS_VT)};
        pg8::gemm_phase<EpiKV, pg8::StaticOrder, false>(F.lds, g2, S2, E2, nullptr);
        __syncthreads();
#endif
#if PH & 8
        p2a_rows(F, P);
#endif
#if PH & 16
        for (int u = F.bid; u < 256; u += F.G) ssm_unit<0>(F, P, u);
#endif
    }
    xcd_barrier(bar);

    {
#if PH & 32
        for (int u = F.bid; u < 256; u += F.G) smla_unit(F, P, u);
#endif
#if PH & 64
        for (int u = F.bid; u < 256; u += F.G) { const int b = u >> 7, h = (u >> 4) & 7, i = u & 15; attn_qblock<true>(F, b, h, 31 - i); attn_qblock<true>(F, b, h, i); }
#endif
#if PH & 128
        for (int u = F.bid; u < 256; u += F.G) attn_qblock<false>(F, u >> 7, (u >> 5) & 3, u & 31);
#endif
#if PH & 256
        for (int u = F.bid; u < 256; u += F.G) ssm_unit<1>(F, P, u);
#endif
#if PH & 512
        for (int u = F.G - 1 - F.bid; u < 128; u += F.G) smem_unit(F, P, u);
#endif
#if PH & 256
        for (int u = F.bid - 128; u < 32; u += F.G) if (u >= 0) ssm_unit<2>(F, P, u);
#endif
    }
    xcd_barrier(bar);

#if PH & 1024
    oprep_rows(F, P);
#endif
    xcd_barrier(bar);

#if PH & 2048
    {
        pg8::Gemm g{WSP(bf16_t, WS_O), WSP(bf16_t, WS_WOUT_T), NR, 2048, 2048}; pg8::StaticOrder S; S.init(NR, 2048, F.G, F.bid);
        EpiMerge E{P.in[0], P.in[1], F.out + O_Y};
        pg8::gemm_phase<EpiMerge, pg8::StaticOrder, false>(F.lds, g, S, E, nullptr);
    }
#endif
}

extern "C" void kernel_launch(void* const* d_in, const int* in_sizes, int n_in, void* d_out, int out_size, void* d_ws, size_t ws_size, hipStream_t stream) {
    static int grid = 0;
    if (grid == 0) {
        if (n_in != 37 || ws_size < WS_END) { fprintf(stderr, "kernel_launch: unexpected problem (n_in %d, ws %zu)\n", n_in, ws_size); grid = -1; return; }
        int dev = 0, cus = 0, per_cu = 0;
        if (hipGetDevice(&dev) != hipSuccess || hipDeviceGetAttribute(&cus, hipDeviceAttributeMultiprocessorCount, dev) != hipSuccess) { grid = -1; return; }
        if (hipFuncSetAttribute((const void*)hymba_fwd, hipFuncAttributeMaxDynamicSharedMemorySize, LDS_TOTAL) != hipSuccess) { fprintf(stderr, "kernel_launch: hipFuncSetAttribute failed\n"); grid = -1; return; }
        if (hipOccupancyMaxActiveBlocksPerMultiprocessor(&per_cu, (const void*)hymba_fwd, 512, LDS_TOTAL) != hipSuccess || per_cu < 1)
            fprintf(stderr, "kernel_launch: note: occupancy query reports %d workgroups per CU\n", per_cu);
        (void)hipGetLastError();
        grid = cus;
    }
    if (grid < 0) return;
    (void)in_sizes; (void)out_size;
    hipMemsetAsync((char*)d_ws + WS_CTL, 0, 16384, stream);
    Params p{};
    for (int i = 0; i < 37; ++i) p.in[i] = (const float*)d_in[i];
    p.out = (float*)d_out; p.ws = (unsigned char*)d_ws;
    hipLaunchKernelGGL(hymba_fwd, dim3(grid), dim3(512), LDS_TOTAL, stream, p);
}
```

```cpp
#include <hip/hip_runtime.h>
#include <cstdio>
#include <cstdint>
namespace pg8 {
#define PG8_LAS __attribute__((address_space(3)))
typedef unsigned short bf16_t;
typedef short bf16x8 __attribute__((ext_vector_type(8)));
typedef float f32x4 __attribute__((ext_vector_type(4)));
typedef unsigned u32x4 __attribute__((ext_vector_type(4)));
constexpr int BM = 256, BK = 64, HALF = 128, HTB = HALF * BK * 2  , STAGE_BYTES = 8 * HTB, NXCD = 8, WGM = 8;

__host__ __device__ __forceinline__ int lds_byte(int r, int c) { const int st = (r >> 4) * 2 + (c >> 5), rr = r & 15, cc = c & 31, ob = rr * 64 + cc * 2; return st * 1024 + (ob ^ (((ob >> 9) & 1) << 5)); }
__host__ __device__ __forceinline__ void stage_rc(int b, int& R, int& C) { const int st = b / 1024, sb = b % 1024, swz = sb ^ (((sb >> 9) & 1) << 5); R = (st >> 1) * 16 + swz / 64; C = (st & 1) * 32 + (swz % 64) / 2; }
__host__ __device__ __forceinline__ int perm32(int rho) { const int n = rho >> 4, i = rho & 15; return 8 * (i >> 2) + 4 * n + (i & 3); }

struct Unit { int pm, pn; };
struct Gemm { const bf16_t* A; const bf16_t* Bt; int M, N, K; int ld = 0; };

struct StaticOrder {
    int nM, nN, nwg, G, c;
    __host__ __device__ void init(int M, int N, int G_, int c_) { nM = M / BM; nN = N / BM; nwg = nM * nN; G = G_; c = c_; }
    __host__ __device__ bool next(int i, Unit& u) const {
        const long L = (long)i * G + c; if (L >= nwg) return false;
        int wgid = (int)L; { const int q = nwg / NXCD, r = nwg % NXCD, xcd = wgid % NXCD, off = wgid / NXCD; wgid = (xcd < r ? xcd * (q + 1) : r * (q + 1) + (xcd - r) * q) + off; }
        const int nig = WGM * nN, gid = wgid / nig, fm = gid * WGM, gsz = (nM - fm) < WGM ? (nM - fm) : WGM;
        u.pm = fm + ((wgid % nig) % gsz); u.pn = (wgid % nig) / gsz; return true;
    }
    __device__ __forceinline__ void a_ready(const Unit&) const {}
    __device__ __forceinline__ void done(const Unit&) const {}
};
__device__ __forceinline__ unsigned cvt_pk_bf16(float lo, float hi) { unsigned r; asm volatile("v_cvt_pk_bf16_f32 %0, %1, %2" : "=v"(r) : "v"(lo), "v"(hi)); return r; }
template <class Epi, class Sched, bool STAMP = false>
__device__ __forceinline__ void gemm_phase(PG8_LAS unsigned char* lds, const Gemm g, const Sched& S, const Epi& E, unsigned long long* stamps) {
    int tid_l = threadIdx.x; asm volatile("" : "+v"(tid_l));
    const int tid = tid_l, wid = __builtin_amdgcn_readfirstlane(tid >> 6), lane = tid & 63, wr = wid >> 2, wc = wid & 3, fr = lane & 15, fq = lane >> 4;
    const int K = g.K, nt = K / BK, LD = g.ld ? g.ld : g.K;
    int ts_lo = 0, ts_hi = 0, nts = 0; const unsigned long long rt_entry = STAMP ? (unsigned long long)wall_clock64() : 0ull;
#define PG8_STAMP() do { if (STAMP && wid == 0 && nts < 64) { const unsigned long long _c = (unsigned long long)clock64(); \
        ts_lo = (lane == nts) ? (int)(unsigned)_c : ts_lo; ts_hi = (lane == nts) ? (int)(unsigned)(_c >> 32) : ts_hi; ++nts; } } while (0)
    PG8_STAMP();
    unsigned voffA[2], voffB[2];
#pragma unroll
    for (int i = 0; i < 2; ++i) { int R, C; stage_rc(tid * 16 + i * 8192, R, C); const int Rb = Epi::PERM ? ((R & ~31) + perm32(R & 31)) : R;
        voffA[i] = (unsigned)(R * LD + C) * 2u; voffB[i] = (unsigned)(Rb * LD + C) * 2u; }
    const size_t kstep = (size_t)(BK * 2);
    const size_t hstep = (size_t)HALF * LD * 2;
    const size_t tstep = 2 * hstep;
    const unsigned ldsw = (unsigned)wid * 1024u;
    const int aoff = lds_byte(wr * 64 + fr, fq * 8), boff = lds_byte(wc * 32 + fr, fq * 8);
#define PG8_SA(b, h) (((b) * 2 + (h)) * HTB)
#define PG8_SB(b, h) ((4 + (b) * 2 + (h)) * HTB)
#define PG8_STAGE(bufoff, gbase, voff) do { _Pragma("unroll") for (int _i = 0; _i < 2; ++_i) \
        __builtin_amdgcn_global_load_lds((const unsigned*)((const char*)(gbase) + (voff)[_i]), (PG8_LAS unsigned*)(lds + (bufoff) + ldsw + _i * 8192), 16, 0, 0); } while (0)
#define PG8_LDA(dst, b, h) do { _Pragma("unroll") for (int m = 0; m < 4; ++m) _Pragma("unroll") for (int k = 0; k < 2; ++k) dst[m][k] = *(const PG8_LAS bf16x8*)(lds + PG8_SA(b, h) + aoff + m * 2048 + k * 1024); } while (0)
#define PG8_LDB(dst, b, h) do { _Pragma("unroll") for (int n = 0; n < 2; ++n) _Pragma("unroll") for (int k = 0; k < 2; ++k) dst[n][k] = *(const PG8_LAS bf16x8*)(lds + PG8_SB(b, h) + boff + n * 2048 + k * 1024); } while (0)
#define PG8_MMA(ai, bj, At, Bt) do { __builtin_amdgcn_s_setprio(1); _Pragma("unroll") for (int m = 0; m < 4; ++m) _Pragma("unroll") for (int n = 0; n < 2; ++n) _Pragma("unroll") for (int k = 0; k < 2; ++k) \
        acc[ai][bj][m][n] = __builtin_amdgcn_mfma_f32_16x16x32_bf16(Bt[n][k], At[m][k], acc[ai][bj][m][n], 0, 0, 0); __builtin_amdgcn_s_setprio(0); } while (0)
#define PG8_WAIT_V(n) asm volatile("s_waitcnt vmcnt(" #n ")" ::: "memory")
#define PG8_WAIT_L(n) asm volatile("s_waitcnt lgkmcnt(" #n ")" ::: "memory")
#define PG8_BAR __builtin_amdgcn_s_barrier()
#define PG8_SCHED __builtin_amdgcn_sched_barrier(0)
    Unit cur, nxt; int ui = 0;
    if (!S.next(0, cur)) return;
    f32x4 acc[2][2][4][2];
#pragma unroll
    for (int a = 0; a < 2; ++a)
#pragma unroll
        for (int b = 0; b < 2; ++b)
#pragma unroll
            for (int m = 0; m < 4; ++m)
#pragma unroll
                for (int n = 0; n < 2; ++n) acc[a][b][m][n] = (f32x4){0.f, 0.f, 0.f, 0.f};
    bf16x8 At[4][2], B0[2][2], B1[2][2];
    const char* cA = (const char*)g.A + (size_t)cur.pm * tstep; const char* cB = (const char*)g.Bt + (size_t)cur.pn * tstep;
    S.a_ready(cur);
    PG8_STAGE(PG8_SB(0, 0), cB, voffB); PG8_STAGE(PG8_SA(0, 0), cA, voffA); PG8_STAGE(PG8_SB(0, 1), cB + hstep, voffB); PG8_STAGE(PG8_SA(0, 1), cA + hstep, voffA);
    if (wr == 1) PG8_BAR;
    PG8_WAIT_V(4); PG8_BAR;
    PG8_STAGE(PG8_SB(1, 0), cB + kstep, voffB); PG8_STAGE(PG8_SA(1, 0), cA + kstep, voffA); PG8_STAGE(PG8_SB(1, 1), cB + hstep + kstep, voffB);
    PG8_WAIT_V(6); PG8_BAR;
    PG8_STAMP();
    for (;;) {
        const bool has_next = S.next(ui + 1, nxt);
        const char* nA = has_next ? (const char*)g.A + (size_t)nxt.pm * tstep : cA; const char* nB = has_next ? (const char*)g.Bt + (size_t)nxt.pn * tstep : cB;
        for (int t = 0; t < nt; t += 2) {
            const bool last = (t == nt - 2);
            const char* a1 = cA + (size_t)(t + 1) * kstep;
            const char* a2 = last ? nA : cA + (size_t)(t + 2) * kstep; const char* b2 = last ? nB : cB + (size_t)(t + 2) * kstep;
            const char* a3 = a2 + kstep; const char* b3 = b2 + kstep;
            if (last && has_next) S.a_ready(nxt);
            PG8_LDB(B0, 0, 0); PG8_SCHED; PG8_LDA(At, 0, 0); PG8_STAGE(PG8_SA(1, 1), a1 + hstep, voffA);
            PG8_WAIT_L(8); PG8_BAR; PG8_WAIT_L(0); PG8_MMA(0, 0, At, B0); PG8_BAR; PG8_SCHED;
            PG8_LDB(B1, 0, 1); PG8_STAGE(PG8_SB(0, 0), b2, voffB);
            PG8_BAR; PG8_WAIT_L(0); PG8_MMA(0, 1, At, B1); PG8_BAR;
            PG8_LDA(At, 0, 1); PG8_STAGE(PG8_SA(0, 0), a2, voffA);
            PG8_BAR; PG8_WAIT_L(0); PG8_MMA(1, 0, At, B0); PG8_BAR; PG8_SCHED;
            PG8_STAGE(PG8_SB(0, 1), b2 + hstep, voffB);
            PG8_WAIT_V(6); PG8_BAR; PG8_MMA(1, 1, At, B1); PG8_BAR;
            PG8_LDB(B0, 1, 0); PG8_SCHED; PG8_LDA(At, 1, 0); PG8_STAGE(PG8_SA(0, 1), a2 + hstep, voffA);
            PG8_WAIT_L(8); PG8_BAR; PG8_WAIT_L(0); PG8_MMA(0, 0, At, B0); PG8_BAR; PG8_SCHED;
            PG8_LDB(B1, 1, 1); PG8_STAGE(PG8_SB(1, 0), b3, voffB);
            PG8_BAR; PG8_WAIT_L(0); PG8_MMA(0, 1, At, B1); PG8_BAR;
            PG8_LDA(At, 1, 1); PG8_STAGE(PG8_SA(1, 0), a3, voffA);
            PG8_BAR; PG8_WAIT_L(0); PG8_MMA(1, 0, At, B0); PG8_BAR; PG8_SCHED;
            PG8_STAGE(PG8_SB(1, 1), b3 + hstep, voffB);
            PG8_WAIT_V(6); PG8_BAR; PG8_MMA(1, 1, At, B1); PG8_BAR;
        }
        PG8_STAMP();
        if constexpr (!Epi::AFTER_DRAIN) { E(acc, cur, wr, wc, fr, fq); S.done(cur); }
        PG8_STAMP();
        if (!has_next) break;
#pragma unroll
        for (int a = 0; a < 2; ++a)
#pragma unroll
            for (int b = 0; b < 2; ++b)
#pragma unroll
                for (int m = 0; m < 4; ++m)
#pragma unroll
                    for (int n = 0; n < 2; ++n) acc[a][b][m][n] = (f32x4){0.f, 0.f, 0.f, 0.f};
        cur = nxt; cA = nA; cB = nB; ++ui;
    }
    PG8_WAIT_V(0);
    if (wr == 0) PG8_BAR;
    PG8_BAR;
    if constexpr (Epi::AFTER_DRAIN) { E.fused(acc, cur, wr, wc, fr, fq, lds, wid, lane); S.done(cur); }
    PG8_STAMP();
    if (STAMP && wid == 0) { stamps[lane] = lane < nts ? (((unsigned long long)(unsigned)ts_hi << 32) | (unsigned)ts_lo) : 0ull;
        if (lane == 62) stamps[62] = rt_entry; if (lane == 63) stamps[63] = (unsigned long long)wall_clock64(); }
#undef PG8_STAMP
#undef PG8_SA
#undef PG8_SB
#undef PG8_STAGE
#undef PG8_LDA
#undef PG8_LDB
#undef PG8_MMA
#undef PG8_WAIT_V
#undef PG8_WAIT_L
#undef PG8_BAR
#undef PG8_SCHED
}
}

#define GAS __attribute__((address_space(1)))
#define LAS __attribute__((address_space(3)))
typedef unsigned short bf16_t;
typedef short bf16x8 __attribute__((ext_vector_type(8)));
typedef short s16x4 __attribute__((ext_vector_type(4)));
typedef float f32x4 __attribute__((ext_vector_type(4)));
typedef float f32x2 __attribute__((ext_vector_type(2)));
typedef float f32x16 __attribute__((ext_vector_type(16)));
typedef unsigned u32x4 __attribute__((ext_vector_type(4)));
typedef unsigned u32x2 __attribute__((ext_vector_type(2)));

constexpr int D = 2048, SEQ = 4096, NB = 2, NP = NB * SEQ  , NSB = 128  , NS = NSB * 8  , NR = NP + NS  ;
constexpr int NIN = 4096;
constexpr int PAST = 8192, PAGE = 128, NPAGES = 64;
constexpr int MEMT = 256;
constexpr float EPS = 1e-6f;
constexpr float LOG2E = 1.4426950408889634f;
constexpr size_t O_Y = 0, O_CKV_P = 18874368, O_KR_P = 20971520, O_CKV_S = 21495808, O_KR_S = 21757952, O_MK = 21823488, O_MV = 22085632,
                 O_SRE_P = 22347776, O_SIM_P = 22351872, O_SRE_S = 22355968, O_SIM_S = 22618112;

constexpr size_t al256(size_t x) { return (x + 255) & ~(size_t)255; }
constexpr size_t WS_CTL = 0, CTL_BYTES = 1u << 20;
constexpr size_t WS_WIN_T   = WS_CTL + CTL_BYTES;
constexpr size_t WS_WUQ_T   = WS_WIN_T + (size_t)4096 * 2048 * 2;
constexpr size_t WS_WKV_TG  = WS_WUQ_T + (size_t)2048 * 512 * 2;
constexpr size_t WS_WKV_T   = WS_WKV_TG + (size_t)2048 * 256 * 2;
constexpr size_t WS_WKV_B   = WS_WKV_T + (size_t)2048 * 256 * 2;
constexpr size_t WS_WF      = WS_WKV_B + (size_t)256 * 2048 * 2;
constexpr size_t WS_W8F     = WS_WF + (size_t)32 * 16 * 1024;
constexpr size_t WS_MEMKV_T = WS_W8F + (size_t)32 * 4 * 2048;
constexpr size_t WS_WOUT_T  = WS_MEMKV_T + (size_t)1024 * 2048 * 2;
constexpr size_t WS_GLUF    = WS_WOUT_T + (size_t)2048 * 2048 * 2;
constexpr size_t WS_ABAR    = WS_GLUF + (size_t)16 * 32 * 1024;
constexpr size_t WS_ABARL   = WS_ABAR + 32 * 64 * 8;
constexpr size_t WS_BBAR    = WS_ABARL + 32 * 64 * 8;
constexpr size_t WS_CSTB    = WS_BBAR + (size_t)32 * 64 * 16 * 8;
constexpr size_t WS_BBST    = WS_CSTB + (size_t)32 * 32 * 128 * 2;
constexpr size_t WS_QCG     = WS_BBST + (size_t)32 * 128 * 16 * 2;
constexpr size_t WS_XN      = WS_QCG + 1024;
constexpr size_t WS_MEMN    = WS_XN + (size_t)NR * 2048 * 2;
constexpr size_t WS_UF      = WS_MEMN + (size_t)512 * 2048 * 2;
constexpr size_t WS_CQ      = WS_UF + (size_t)NR * 512 * 4;
constexpr size_t WS_SSQ_CQ  = WS_CQ + (size_t)NR * 512 * 2;
constexpr size_t WS_CKVF    = WS_SSQ_CQ + (size_t)NR * 8 * 4;
constexpr size_t WS_CKVB    = WS_CKVF + (size_t)NR * 256 * 4;
constexpr size_t WS_SSQ_CKV = WS_CKVB + (size_t)NR * 256 * 2;
constexpr size_t WS_QMR     = WS_SSQ_CKV + (size_t)NR * 4 * 4;
constexpr size_t WS_SSQ_QM  = WS_QMR + (size_t)NR * 512 * 2;
constexpr size_t WS_KRF     = WS_SSQ_QM + (size_t)NR * 16 * 4;
constexpr size_t WS_GATES   = WS_KRF + (size_t)NR * 64 * 4;
constexpr size_t WS_MKRAW   = WS_GATES + (size_t)NR * 2048 * 2;
constexpr size_t WS_SSQ_MK  = WS_MKRAW + (size_t)512 * 512 * 4;
constexpr size_t WS_VTM     = WS_SSQ_MK + (size_t)512 * 16 * 4;
constexpr size_t WS_MKB     = WS_VTM + (size_t)2 * 4 * 128 * 256 * 2;
constexpr size_t WS_CKVS    = WS_MKB + (size_t)2 * 4 * 256 * 128 * 2;
constexpr size_t WS_KRB     = WS_CKVS + (size_t)1024 * 256 * 2;
constexpr size_t WS_SSQ_KR  = WS_KRB + (size_t)NR * 64 * 2;
constexpr size_t WS_QM      = WS_SSQ_KR + (size_t)NR * 4;
constexpr size_t WS_MQM     = WS_QM + (size_t)NR * 512 * 2;
constexpr size_t WS_QG      = WS_MQM + (size_t)NR * 4 * 4;
constexpr size_t WS_SSQ_Q   = WS_QG + (size_t)NR * 1536 * 2;
constexpr size_t WS_KNB     = WS_SSQ_Q + (size_t)NR * 64 * 4;
constexpr size_t WS_SSQ_KN  = WS_KNB + (size_t)2 * 8 * 4096 * 128 * 2;
constexpr size_t WS_VT      = WS_SSQ_KN + (size_t)NP * 32 * 4;
constexpr size_t WS_SCH     = WS_VT + (size_t)2 * 8 * 128 * 4096 * 2;
constexpr size_t WS_YSSM    = WS_SCH + (size_t)2 * 128 * 32 * 64 * 8;
constexpr size_t WS_YMLA    = WS_YSSM + (size_t)NR * 512 * 2;
constexpr size_t WS_YMEM    = WS_YMLA + (size_t)NP * 1024 * 2;
constexpr size_t WS_YPS     = WS_YMEM + (size_t)NR * 512 * 2;
constexpr size_t WS_LPS     = WS_YPS + (size_t)128 * 2 * 64 * 128 * 4;
constexpr size_t WS_O       = WS_LPS + (size_t)128 * 2 * 64 * 4;
constexpr size_t WS_PART    = WS_O + (size_t)NR * 2048 * 2;
constexpr size_t WS_END     = WS_PART + (size_t)8 * 1024 * 2048 * 4;
static_assert(WS_END < ((size_t)1 << 30), "workspace map");

constexpr int LDS_TOTAL = 163840 - 256;
constexpr int LDS_MISC = LDS_TOTAL - 64;

__device__ __forceinline__ unsigned f2bf(float f) { unsigned u = __builtin_bit_cast(unsigned, f); return (u + 0x7fffu + ((u >> 16) & 1u)) >> 16; }
__device__ __forceinline__ unsigned pk2(float lo, float hi) { unsigned r; asm volatile("v_cvt_pk_bf16_f32 %0, %1, %2" : "=v"(r) : "v"(lo), "v"(hi)); return r; }
__device__ __forceinline__ float bf2f(unsigned short b) { return __builtin_bit_cast(float, ((unsigned)b) << 16); }
__device__ __forceinline__ float bflo(unsigned w) { return __builtin_bit_cast(float, w << 16); }
__device__ __forceinline__ float bfhi(unsigned w) { return __builtin_bit_cast(float, w & 0xffff0000u); }
__device__ __forceinline__ float wave_sum(float v) {
#pragma unroll
    for (int o = 1; o < 64; o <<= 1) v += __shfl_xor(v, o);
    return v;
}
__device__ __forceinline__ float ex2(float x) { return __builtin_amdgcn_exp2f(x); }
#define LDS_WAIT() asm volatile("s_waitcnt lgkmcnt(0)" ::: "memory")
__device__ __forceinline__ f32x16 mfma32(bf16x8 a, bf16x8 b, f32x16 c) { return __builtin_amdgcn_mfma_f32_32x32x16_bf16(a, b, c, 0, 0, 0); }
__device__ __forceinline__ f32x16 zero16() { f32x16 z;
#pragma unroll
    for (int i = 0; i < 16; ++i) z[i] = 0.f; return z; }
__device__ __forceinline__ int crow(int r, int hh) { return (r & 3) + 8 * (r >> 2) + 4 * hh; }
__device__ __forceinline__ int perm23(int k) { return (k & ~0xC) | ((k & 4) << 1) | ((k & 8) >> 1); }

__device__ const double ROPE_TURNS[32] = {
    0.15915494309189535, 0.11934937021124886, 0.08949940160889101, 0.06711508300522726, 0.050329212104487035, 0.03774158471741977, 0.0283021958306234, 0.02122365276477766, 0.015915494309189534, 0.011934937021124886, 0.008949940160889102, 0.006711508300522725, 0.005032921210448704, 0.003774158471741977, 0.00283021958306234, 0.0021223652764777662, 0.0015915494309189536, 0.0011934937021124885, 0.0008949940160889102, 0.0006711508300522726, 0.0005032921210448703, 0.00037741584717419774, 0.00028302195830623395, 0.0002122365276477766, 0.00015915494309189535, 0.00011934937021124886, 8.949940160889102e-05, 6.711508300522725e-05, 5.0329212104487035e-05, 3.774158471741978e-05, 2.8302195830623396e-05, 2.122365276477766e-05
};
__device__ __forceinline__ void rope_cs_t(int pos, double turns, float& c, float& s) {
    double a = (double)pos * turns; a -= __builtin_rint(a);
    const float t = (float)a;
    s = __builtin_amdgcn_sinf(t); c = __builtin_amdgcn_cosf(t);
}
__device__ __forceinline__ void rope_cs(int pos, int i, float& c, float& s) {
    double a = (double)pos * ROPE_TURNS[i]; a -= __builtin_rint(a);
    const float t = (float)a;
    s = __builtin_amdgcn_sinf(t); c = __builtin_amdgcn_cosf(t);
}

#define XB_TMO      128
#define XB_XCNT(j)  (256  + 64 * (j))
#define XB_XSUB(j)  (1280 + 64 * (j))
#define XB_XGEN(j)  (2304 + 64 * (j))
#define XB_TOP      3328
#define XB_TOPGEN   3392
#define XCD_BAR_WORDS 3456
#define XB_SPIN_CAP (1u << 18)
__device__ __forceinline__ unsigned xb_ld(unsigned* p)              { return __hip_atomic_load(p, __ATOMIC_RELAXED, __HIP_MEMORY_SCOPE_AGENT); }
__device__ __forceinline__ unsigned xb_add(unsigned* p, unsigned v) { return __hip_atomic_fetch_add(p, v, __ATOMIC_RELAXED, __HIP_MEMORY_SCOPE_AGENT); }
__device__ __forceinline__ unsigned xb_xcc_id() { return (unsigned)__builtin_amdgcn_s_getreg((3 << 11) | 20) & 0xFu; }
#define XB_SPIN(cond, bar) do { unsigned _sp = 0; while (cond) { __builtin_amdgcn_s_sleep(1); \
    if ((++_sp & 255u) == 0u) { if (xb_ld(&(bar)[XB_TMO])) break; if (_sp > XB_SPIN_CAP) { atomicAdd(&(bar)[XB_TMO], 1u); break; } } } } while (0)
struct XcdBarrier { unsigned* bar; unsigned x; volatile LAS unsigned* st; };
__device__ __forceinline__ XcdBarrier xcd_barrier_post(unsigned* bar, volatile LAS unsigned* st) {
    XcdBarrier b; b.bar = bar; b.x = xb_xcc_id(); b.st = st;
    if (threadIdx.x == 0) (void)xb_add(&bar[XB_XCNT(b.x)], 1u);
    return b;
}
__device__ __forceinline__ void xcd_barrier_complete(unsigned* bar, unsigned x, unsigned& nloc, unsigned& nx) {
    const unsigned G = gridDim.x * gridDim.y * gridDim.z;
    unsigned sum, cnt, mine, sp = 0u;
    for (;;) {
        sum = 0u; cnt = 0u; mine = 0u;
#pragma unroll
        for (unsigned j = 0; j < 16; ++j) { const unsigned c = xb_ld(&bar[XB_XCNT(j)]); sum += c; cnt += (c > 0u) ? 1u : 0u; mine = (j == x) ? c : mine; }
        if (sum == G) break;
        __builtin_amdgcn_s_sleep(1);
        if ((++sp & 255u) == 0u) { if (xb_ld(&bar[XB_TMO])) break; if (sp > XB_SPIN_CAP) { atomicAdd(&bar[XB_TMO], 1u); break; } }
    }
    nloc = mine > 0u ? mine : 1u; nx = cnt > 0u ? cnt : 1u;
}
__device__ __forceinline__ void xcd_barrier(const XcdBarrier& b) {
    asm volatile("s_waitcnt vmcnt(0)" ::: "memory");
    __syncthreads();
    if (threadIdx.x == 0) {
        unsigned* bar = b.bar;
        __builtin_amdgcn_s_waitcnt(0);
        unsigned nloc = b.st[0], nx = b.st[1];
        if (nloc == 0u) { xcd_barrier_complete(bar, b.x, nloc, nx); b.st[0] = nloc; b.st[1] = nx; }
        const unsigned old = xb_add(&bar[XB_XSUB(b.x)], 1u);
        const unsigned gen = old / nloc;
        if (old + 1u == (gen + 1u) * nloc) {
            __builtin_amdgcn_fence(__ATOMIC_RELEASE, "agent");
            asm volatile("s_waitcnt vmcnt(0)" ::: "memory");
            const unsigned og = xb_add(&bar[XB_TOP], 1u);
            const unsigned tg = og / nx;
            if (og + 1u == (tg + 1u) * nx) xb_add(&bar[XB_TOPGEN], 1u);
            else XB_SPIN(xb_ld(&bar[XB_TOPGEN]) == tg, bar);
            __builtin_amdgcn_fence(__ATOMIC_ACQUIRE, "agent");
            xb_add(&bar[XB_XGEN(b.x)], 1u);
            asm volatile("s_waitcnt vmcnt(0)" ::: "memory");
        } else {
            XB_SPIN(xb_ld(&bar[XB_XGEN(b.x)]) == gen, bar);
            __builtin_amdgcn_fence(__ATOMIC_ACQUIRE, "agent");
            asm volatile("s_waitcnt vmcnt(0)" ::: "memory");
        }
    }
    __syncthreads();
}

struct Params {
    const float* in[37];
    float* out;
    unsigned char* ws;
};
struct Frame {
    LAS unsigned char* lds;
    unsigned char* ws;
    float* out;
    int tid, lane, wave, G, bid;
};
#define WSP(T, off) ((T*)(F.ws + (off)))

template <class Map>
__device__ __forceinline__ void p0_transpose_item(const float* W, int K, int Nsrc, int Ndst, bf16_t* WT, const float* gain, const Map& map, LAS float* scr, int item, int lane) {
    const int nblk = Ndst / 32, kb = item / nblk, nb = item % nblk, k0 = 64 * kb, n0 = 32 * nb;
    const int sc = map(n0 + (lane & 31));
    const int scc = sc < 0 ? 0 : sc; const float msk = sc < 0 ? 0.f : 1.f;
    const float* wp = W + (size_t)(k0 + (lane >> 5)) * Nsrc + scc;
    float v[32];
#pragma unroll
    for (int i = 0; i < 32; ++i) v[i] = wp[(size_t)(2 * i) * Nsrc];
    if (gain) {
        const float* gp = gain + k0 + (lane >> 5); float g[32];
#pragma unroll
        for (int i = 0; i < 32; ++i) g[i] = gp[2 * i];
#pragma unroll
        for (int i = 0; i < 32; ++i) v[i] *= g[i];
    }
#pragma unroll
    for (int i = 0; i < 32; ++i) scr[(2 * i + (lane >> 5)) * 33 + (lane & 31)] = v[i] * msk;
    LDS_WAIT(); asm volatile("" ::: "memory");
    const int c = lane & 7;
    float tv[4][8];
#pragma unroll
    for (int j = 0; j < 4; ++j) { const LAS float* s = scr + (8 * c) * 33 + (lane >> 3) + 8 * j;
#pragma unroll
        for (int e = 0; e < 8; ++e) tv[j][e] = s[e * 33]; }
#pragma unroll
    for (int j = 0; j < 4; ++j) { const int n = (lane >> 3) + 8 * j;
        u32x4 o; o.x = pk2(tv[j][0], tv[j][1]); o.y = pk2(tv[j][2], tv[j][3]); o.z = pk2(tv[j][4], tv[j][5]); o.w = pk2(tv[j][6], tv[j][7]);
        *(u32x4*)(WT + (size_t)(n0 + n) * K + k0 + 8 * c) = o; }
    LDS_WAIT(); asm volatile("" ::: "memory");
}
struct MapIn { __device__ __forceinline__ int operator()(int n) const {
    if (n < 512) return n;
    if (n < 1024) return 1024 + (n - 512);
    if (n < 1280) return 1536 + (n - 1024);
    if (n < 1792) return 2880 + (n - 1280);
    if (n < 1856) return n;
    if (n < 2048) return -1;
    if (n < 2560) return 512 + (n - 2048);
    if (n < 3584) return 1856 + (n - 2560);
    return 3392 + (n - 3584);
} };
struct MapUq { __device__ __forceinline__ int operator()(int n) const {
    const int h = n >> 8, p = n & 255;
    if (p < 128) return h * 192 + p;
    if (p >= 192) return -1;
    const int pp = p - 128, wc = pp >> 5, nn = (pp >> 4) & 1, rest = pp & 15;
    return h * 192 + 128 + 32 * nn + 16 * wc + rest;
} };
struct MapId { __device__ __forceinline__ int operator()(int n) const { return n; } };
struct MapOff { int off; __device__ __forceinline__ int operator()(int n) const { return n - off; } };

__device__ __forceinline__ void p0_norm_row(const float* xrow, const float* g, bf16_t* orow, int lane) {
    const f32x4* xr = (const f32x4*)xrow + lane; const f32x4* gr = (const f32x4*)g + lane;
    f32x4 v[8], gv[8]; float s = 0.f;
#pragma unroll
    for (int j = 0; j < 8; ++j) { v[j] = xr[64 * j]; gv[j] = gr[64 * j]; }
    __builtin_amdgcn_sched_barrier(0);
#pragma unroll
    for (int j = 0; j < 8; ++j) s += (v[j].x * v[j].x + v[j].y * v[j].y) + (v[j].z * v[j].z + v[j].w * v[j].w);
    const float rinv = 1.0f / sqrtf(wave_sum(s) * (1.f / 2048.f) + EPS);
    u32x2* o8 = (u32x2*)orow + lane;
#pragma unroll
    for (int j = 0; j < 8; ++j) { const f32x4 gg = gv[j]; u32x2 w; w.x = pk2(v[j].x * rinv * gg.x, v[j].y * rinv * gg.y); w.y = pk2(v[j].z * rinv * gg.z, v[j].w * rinv * gg.w); o8[64 * j] = w; }
}

__device__ __forceinline__ void p0_norm_row2(const float* x0, const float* x1, const float* g, bf16_t* o0, bf16_t* o1, int lane) {
    const f32x4* xr0 = (const f32x4*)x0 + lane; const f32x4* xr1 = (const f32x4*)x1 + lane; const f32x4* gr = (const f32x4*)g + lane;
    f32x4 v[8], u[8], gv[8]; float s = 0.f, t = 0.f;
#pragma unroll
    for (int j = 0; j < 8; ++j) { v[j] = xr0[64 * j]; u[j] = xr1[64 * j]; gv[j] = gr[64 * j]; }
    __builtin_amdgcn_sched_barrier(0);
#pragma unroll
    for (int j = 0; j < 8; ++j) { s += (v[j].x * v[j].x + v[j].y * v[j].y) + (v[j].z * v[j].z + v[j].w * v[j].w); t += (u[j].x * u[j].x + u[j].y * u[j].y) + (u[j].z * u[j].z + u[j].w * u[j].w); }
    const float r0 = 1.0f / sqrtf(wave_sum(s) * (1.f / 2048.f) + EPS), r1 = 1.0f / sqrtf(wave_sum(t) * (1.f / 2048.f) + EPS);
    u32x2* p0 = (u32x2*)o0 + lane; u32x2* p1 = (u32x2*)o1 + lane;
#pragma unroll
    for (int j = 0; j < 8; ++j) { const f32x4 gg = gv[j]; u32x2 w;
        w.x = pk2(v[j].x * r0 * gg.x, v[j].y * r0 * gg.y); w.y = pk2(v[j].z * r0 * gg.z, v[j].w * r0 * gg.w); p0[64 * j] = w;
        w.x = pk2(u[j].x * r1 * gg.x, u[j].y * r1 * gg.y); w.y = pk2(u[j].z * r1 * gg.z, u[j].w * r1 * gg.w); p1[64 * j] = w; }
}
__device__ __forceinline__ void p0_prologue(Frame& F, const Params& P) {
    int tid = F.tid; asm volatile("" : "+v"(tid)); const int lane_ = tid & 63;
    LAS float* scr = (LAS float*)(F.lds + F.wave * 16384);
    const int gw = F.bid * 8 + F.wave, NGW = F.G * 8;
    const int gt = F.bid * 512 + tid, NGT = F.G * 512;
    constexpr int I_IN = (2048 / 64) * (4096 / 32), I_UQ = (512 / 64) * (2048 / 32), I_KV = (256 / 64) * (2048 / 32), I_MK = (2048 / 64) * (512 / 32), I_OUT = (2048 / 64) * (2048 / 32);
    constexpr int NITEMS = I_IN + I_UQ + 2 * I_KV + 2 * I_MK + I_OUT;
#ifndef REP_P0T
#define REP_P0T 1
#endif
#ifndef REP_P0X
#define REP_P0X 1
#endif
    for (int rp_ = 0; rp_ < REP_P0T; ++rp_)
    for (int it = gw; it < NITEMS; it += NGW) {
        int r = it;
        if (r < I_IN) { p0_transpose_item(P.in[11], 2048, 3904, 4096, WSP(bf16_t, WS_WIN_T), (const float*)nullptr, MapIn{}, scr, r, lane_); continue; } r -= I_IN;
        if (r < I_UQ) { p0_transpose_item(P.in[23], 512, 1536, 2048, WSP(bf16_t, WS_WUQ_T), P.in[22], MapUq{}, scr, r, lane_); continue; } r -= I_UQ;
        if (r < I_KV) { p0_transpose_item(P.in[25], 256, 2048, 2048, WSP(bf16_t, WS_WKV_TG), P.in[24], MapId{}, scr, r, lane_); continue; } r -= I_KV;
        if (r < I_KV) { p0_transpose_item(P.in[25], 256, 2048, 2048, WSP(bf16_t, WS_WKV_T), (const float*)nullptr, MapId{}, scr, r, lane_); continue; } r -= I_KV;
        if (r < I_MK) { p0_transpose_item(P.in[29], 2048, 512, 512, WSP(bf16_t, WS_MEMKV_T), (const float*)nullptr, MapId{}, scr, r, lane_); continue; } r -= I_MK;
        if (r < I_MK) { p0_transpose_item(P.in[30], 2048, 512, 512, WSP(bf16_t, WS_MEMKV_T) + (size_t)512 * 2048, (const float*)nullptr, MapId{}, scr, r, lane_); continue; } r -= I_MK;
        p0_transpose_item(P.in[36], 2048, 2048, 2048, WSP(bf16_t, WS_WOUT_T), (const float*)nullptr, MapId{}, scr, r, lane_);
    }
#ifndef REP_P0M
#define REP_P0M 1
#endif
    for (int rm_ = 0; rm_ < REP_P0M; ++rm_) {
    { const float* w = P.in[25]; bf16_t* o = WSP(bf16_t, WS_WKV_B);
      for (int i = gt; i < 256 * 2048 / 4; i += NGT) { const f32x4 v = ((const f32x4*)w)[i]; u32x2 q; q.x = pk2(v.x, v.y); q.y = pk2(v.z, v.w); ((u32x2*)o)[i] = q; } }
    { const float* w = P.in[25]; u32x4* o = WSP(u32x4, WS_WF);
      for (int i = gt; i < 32 * 16 * 64; i += NGT) { const int ln = i & 63, ks = (i >> 6) & 15, hn = i >> 10, h = hn >> 2, nb = hn & 3, ii = ln & 31, hh = ln >> 5;
          const float* s = w + (size_t)(16 * ks + 8 * hh) * 2048 + h * 256 + nb * 32 + ii;
          u32x4 q; q.x = pk2(s[0], s[2048]); q.y = pk2(s[2 * 2048], s[3 * 2048]); q.z = pk2(s[4 * 2048], s[5 * 2048]); q.w = pk2(s[6 * 2048], s[7 * 2048]); o[i] = q; } }
    { const float* wsrc = P.in[25]; u32x4* o = WSP(u32x4, WS_W8F);
      for (int i = (gt + NGT - 64 * 512) % NGT; i < 32 * 4 * 64 * 2; i += NGT) { const int hf = i & 1, ln = (i >> 1) & 63, ks = (i >> 7) & 3, hn = i >> 9, h = hn >> 2, nb = hn & 3, ii = ln & 31, hh = ln >> 5;
          const float* s = wsrc + (size_t)(64 * ks + 32 * hh + 16 * hf) * 2048 + h * 256 + nb * 32 + ii;
          unsigned q[4];
#pragma unroll
          for (int d = 0; d < 4; ++d) { int t = __builtin_amdgcn_cvt_pk_fp8_f32(16.f * s[(size_t)(4 * d) * 2048], 16.f * s[(size_t)(4 * d + 1) * 2048], 0, false);
              t = __builtin_amdgcn_cvt_pk_fp8_f32(16.f * s[(size_t)(4 * d + 2) * 2048], 16.f * s[(size_t)(4 * d + 3) * 2048], t, true); q[d] = (unsigned)t; }
          o[i] = (u32x4){q[0], q[1], q[2], q[3]}; } }
    { const float* w = P.in[20]; u32x4* o = WSP(u32x4, WS_GLUF);
      for (int i = (gt + NGT - 96 * 512) % NGT; i < 16 * 32 * 64; i += NGT) { const int ln = i & 63, ks = (i >> 6) & 31, cb = i >> 11, ii = ln & 31, hh = ln >> 5;
          const float* s = w + (size_t)(16 * ks + 8 * hh) * 512 + cb * 32 + ii;
          u32x4 q; q.x = pk2(s[0], s[512]); q.y = pk2(s[2 * 512], s[3 * 512]); q.z = pk2(s[4 * 512], s[5 * 512]); q.w = pk2(s[6 * 512], s[7 * 512]); o[i] = q; } }
    { const float* a_re = P.in[12]; const float* a_im = P.in[13]; const float* ldt = P.in[14]; const float* b_re = P.in[15]; const float* b_im = P.in[16];
      f32x2* abar = WSP(f32x2, WS_ABAR); f32x2* abarl = WSP(f32x2, WS_ABARL); f32x2* bbar = WSP(f32x2, WS_BBAR);
      for (int i = (gt + NGT - 160 * 512) % NGT; i < 32 * 64; i += NGT) { const int g = i >> 6;
          const float dt = expf(ldt[g]), ar = a_re[i], ai = a_im[i];
          const float mag = expf(dt * ar), ph = dt * ai;
          const float abr = mag * cosf(ph), abi = mag * sinf(ph);
          abar[i] = (f32x2){abr, abi};
          const float magl = expf(32.f * dt * ar), phl = 32.f * ph;
          abarl[i] = (f32x2){magl * cosf(phl), magl * sinf(phl)};
          const float den = ar * ar + ai * ai, nr = abr - 1.0f, ni = abi;
          const float fr = (nr * ar + ni * ai) / den, fi = (ni * ar - nr * ai) / den;
          f32x4 brv[4], biv[4];
#pragma unroll
          for (int q = 0; q < 4; ++q) { brv[q] = *(const f32x4*)(b_re + i * 16 + 4 * q); biv[q] = *(const f32x4*)(b_im + i * 16 + 4 * q); }
          __builtin_amdgcn_sched_barrier(0);
#pragma unroll
          for (int p = 0; p < 16; ++p) { const float br = brv[p >> 2][p & 3], bi = biv[p >> 2][p & 3]; const float vr = fr * br - fi * bi, vi = fr * bi + fi * br; bbar[i * 16 + p] = (f32x2){vr, vi};
              WSP(bf16_t, WS_BBST)[((size_t)g * 128 + (i & 63)) * 16 + p] = (bf16_t)f2bf(vr); WSP(bf16_t, WS_BBST)[((size_t)g * 128 + 64 + (i & 63)) * 16 + p] = (bf16_t)f2bf(vi); } } }
    { const float* c_re = P.in[17]; const float* c_im = P.in[18]; bf16_t* o = WSP(bf16_t, WS_CSTB);
      for (int i = gt; i < 32 * 32 * 128; i += NGT) { const int k = i & 127, p = (i >> 7) & 31, g = i >> 12; float v = 0.f;
          if (p < 16) v = (k < 64) ? c_re[(g * 16 + p) * 64 + k] : -c_im[(g * 16 + p) * 64 + (k - 64)];
          o[i] = (bf16_t)f2bf(v); } }
    if (gt < 192) WSP(float, WS_QCG)[gt] = P.in[26][gt] * P.in[27][gt] * (0.07216878364870322f * LOG2E);
    }
    for (int rp_ = 0; rp_ < REP_P0X; ++rp_)
    for (int m = gw; m < NR; m += 2 * NGW) {
        const int m2 = m + NGW; const bool has2 = m2 < NR; const int mb = has2 ? m2 : m;
        const float* s0 = (m < NP) ? P.in[0] + (size_t)m * 2048 : P.in[1] + (size_t)(m - NP) * 2048;
        const float* s1 = (mb < NP) ? P.in[0] + (size_t)mb * 2048 : P.in[1] + (size_t)(mb - NP) * 2048;
        p0_norm_row2(s0, s1, P.in[10], WSP(bf16_t, WS_XN) + (size_t)m * 2048, WSP(bf16_t, WS_XN) + (size_t)mb * 2048, lane_);
    }
    for (int m = gw; m < 512; m += NGW) p0_norm_row(P.in[2] + (size_t)m * 2048, P.in[28], WSP(bf16_t, WS_MEMN) + (size_t)m * 2048, lane_);
}

#define EPI_RELANE() do { int ln_ = (int)__builtin_amdgcn_mbcnt_hi(~0u, __builtin_amdgcn_mbcnt_lo(~0u, 0u)); asm volatile("" : "+v"(ln_)); fr = ln_ & 15; fq = ln_ >> 4; } while (0)
__device__ __forceinline__ float sq4(const f32x4 v) { return (v.x * v.x + v.y * v.y) + (v.z * v.z + v.w * v.w); }
__device__ __forceinline__ void st_bf4(bf16_t* p, const f32x4 v) { u32x2 w; w.x = pk2(v.x, v.y); w.y = pk2(v.z, v.w); *(u32x2*)p = w; }
__device__ __forceinline__ float red_fq_(float s, int hh) {
    s += __builtin_bit_cast(float, __builtin_amdgcn_ds_swizzle(__builtin_bit_cast(int, s), 0x401F));
    const auto rr = __builtin_amdgcn_permlane32_swap(__builtin_bit_cast(unsigned, s), __builtin_bit_cast(unsigned, s), false, false);
    return s + __builtin_bit_cast(float, hh ? rr[0] : rr[1]);
}
#define red_fq(s_) red_fq_((s_), fq >> 1)

struct EpiInProj {
    static constexpr bool PERM = false, AFTER_DRAIN = false;
    float* UF; bf16_t* CQ; float* SSQ_CQ; float* CKVF; bf16_t* CKVB; float* SSQ_CKV; bf16_t* QMR; float* SSQ_QM; float* KRF; bf16_t* GATES;
    __device__ __forceinline__ void operator()(const f32x4 (&acc)[2][2][4][2], const pg8::Unit& u, int wr, int wc, int fr, int fq) const {
        EPI_RELANE();
        const int pn = u.pn;
#pragma unroll
        for (int ai = 0; ai < 2; ++ai)
#pragma unroll
            for (int m = 0; m < 4; ++m) {
                const int row = u.pm * 256 + ai * 128 + wr * 64 + m * 16 + fr;
                const int cl = wc * 32 + 4 * fq;
                if (pn < 2) {
#pragma unroll
                    for (int bj = 0; bj < 2; ++bj)
#pragma unroll
                        for (int n = 0; n < 2; ++n) *(f32x4*)(UF + (size_t)row * 512 + pn * 256 + bj * 128 + cl + 16 * n) = acc[ai][bj][m][n];
                } else if (pn < 4) {
                    float s = 0.f;
#pragma unroll
                    for (int bj = 0; bj < 2; ++bj)
#pragma unroll
                        for (int n = 0; n < 2; ++n) { st_bf4(CQ + (size_t)row * 512 + (pn - 2) * 256 + bj * 128 + cl + 16 * n, acc[ai][bj][m][n]); s += sq4(acc[ai][bj][m][n]); }
                    s = red_fq(s); if (fq == 0) SSQ_CQ[row * 8 + (pn - 2) * 4 + wc] = s;
                } else if (pn == 4) {
                    float s = 0.f;
#pragma unroll
                    for (int bj = 0; bj < 2; ++bj)
#pragma unroll
                        for (int n = 0; n < 2; ++n) { const int c = bj * 128 + cl + 16 * n; *(f32x4*)(CKVF + (size_t)row * 256 + c) = acc[ai][bj][m][n]; st_bf4(CKVB + (size_t)row * 256 + c, acc[ai][bj][m][n]); s += sq4(acc[ai][bj][m][n]); }
                    s = red_fq(s); if (fq == 0) SSQ_CKV[row * 4 + wc] = s;
                } else if (pn < 7) {
#pragma unroll
                    for (int bj = 0; bj < 2; ++bj) { float s = 0.f; const int head = 2 * (pn - 5) + bj;
#pragma unroll
                        for (int n = 0; n < 2; ++n) { st_bf4(QMR + (size_t)row * 512 + head * 128 + cl + 16 * n, acc[ai][bj][m][n]); s += sq4(acc[ai][bj][m][n]); }
                        s = red_fq(s); if (fq == 0) SSQ_QM[row * 16 + head * 4 + wc] = s; }
                } else if (pn == 7) {
                    if (wc < 2) {
#pragma unroll
                        for (int n = 0; n < 2; ++n) *(f32x4*)(KRF + (size_t)row * 64 + cl + 16 * n) = acc[ai][0][m][n];
                    }
                } else {
#pragma unroll
                    for (int bj = 0; bj < 2; ++bj)
#pragma unroll
                        for (int n = 0; n < 2; ++n) st_bf4(GATES + (size_t)row * 2048 + (pn - 8) * 256 + bj * 128 + cl + 16 * n, acc[ai][bj][m][n]);
                }
            }
    }
};

struct EpiMemKV {
    static constexpr bool PERM = false, AFTER_DRAIN = false;
    float* MKRAW; float* SSQ_MK; float* OUTV; bf16_t* VTM;
    __device__ __forceinline__ void operator()(const f32x4 (&acc)[2][2][4][2], const pg8::Unit& u, int wr, int wc, int fr, int fq) const {
        EPI_RELANE();
        const int pn = u.pn;
#pragma unroll
        for (int ai = 0; ai < 2; ++ai)
#pragma unroll
            for (int m = 0; m < 4; ++m) {
                const int row = u.pm * 256 + ai * 128 + wr * 64 + m * 16 + fr;
                const int cl = wc * 32 + 4 * fq;
                if (pn < 2) {
#pragma unroll
                    for (int bj = 0; bj < 2; ++bj) { float s = 0.f; const int head = 2 * pn + bj;
#pragma unroll
                        for (int n = 0; n < 2; ++n) { *(f32x4*)(MKRAW + (size_t)row * 512 + head * 128 + cl + 16 * n) = acc[ai][bj][m][n]; s += sq4(acc[ai][bj][m][n]); }
                        s = red_fq(s); if (fq == 0) SSQ_MK[row * 16 + head * 4 + wc] = s; }
                } else {
                    const int b = row >> 8, key = row & 255, kp = perm23(key);
#pragma unroll
                    for (int bj = 0; bj < 2; ++bj) { const int head = 2 * (pn - 2) + bj;
#pragma unroll
                        for (int n = 0; n < 2; ++n) { const f32x4 v = acc[ai][bj][m][n]; const int dv = cl + 16 * n;
                            *(f32x4*)(OUTV + (size_t)row * 512 + head * 128 + dv) = v;
                            bf16_t* t = VTM + ((size_t)(b * 4 + head) * 128 + dv) * 256 + kp;
                            t[0] = (bf16_t)f2bf(v.x); t[256] = (bf16_t)f2bf(v.y); t[512] = (bf16_t)f2bf(v.z); t[768] = (bf16_t)f2bf(v.w); } }
                }
            }
    }
};

struct EpiQ {
    static constexpr bool PERM = false, AFTER_DRAIN = false;
    const float* SSQ_CQ; const float* QCG; bf16_t* QG; float* SSQ_Q;
    __device__ __forceinline__ void operator()(const f32x4 (&acc)[2][2][4][2], const pg8::Unit& u, int wr, int wc, int fr, int fq) const {
        EPI_RELANE();
        const int h = u.pn;
        const int cl = wc * 32 + 4 * fq;
        const f32x4 g00 = *(const f32x4*)(QCG + cl), g01 = *(const f32x4*)(QCG + cl + 16);
        const int ri = 16 * wc + 4 * fq;
        f32x4 g10 = (f32x4){0.f, 0.f, 0.f, 0.f}, g11 = g10;
        double rtn[4] = {0., 0., 0., 0.};
        if (wc < 2) { g10 = *(const f32x4*)(QCG + 128 + ri); g11 = *(const f32x4*)(QCG + 160 + ri);
#pragma unroll
            for (int e = 0; e < 4; ++e) rtn[e] = ROPE_TURNS[ri + e]; }
        float rinvs[2][4];
#pragma unroll
        for (int ai = 0; ai < 2; ++ai)
#pragma unroll
            for (int m = 0; m < 4; ++m) { const int row = u.pm * 256 + ai * 128 + wr * 64 + m * 16 + fr; const f32x4 s0 = *(const f32x4*)(SSQ_CQ + row * 8), s1 = *(const f32x4*)(SSQ_CQ + row * 8 + 4);
                rinvs[ai][m] = 1.0f / sqrtf(((s0.x + s0.y) + (s0.z + s0.w) + (s1.x + s1.y) + (s1.z + s1.w)) * (1.f / 512.f) + EPS); }
        __builtin_amdgcn_sched_barrier(0);
#pragma unroll
        for (int ai = 0; ai < 2; ++ai)
#pragma unroll
            for (int m = 0; m < 4; ++m) {
                const int row = u.pm * 256 + ai * 128 + wr * 64 + m * 16 + fr;
                const float rinv = rinvs[ai][m];
                const f32x4 a0 = acc[ai][0][m][0] * rinv, a1 = acc[ai][0][m][1] * rinv;
                float sr = sq4(a0) + sq4(a1);
                const f32x4 q0 = a0 * g00, q1 = a1 * g01;
                float sg = sq4(q0) + sq4(q1);
                bf16_t* qrow = QG + (size_t)row * 1536 + h * 192;
                st_bf4(qrow + cl, q0); st_bf4(qrow + cl + 16, q1);
                if (wc < 2) {
                    const int pos = (row < NP) ? (row & (SEQ - 1)) : PAST + ((row - NP) & 7);
                    const f32x4 x1 = acc[ai][1][m][0] * rinv, x2 = acc[ai][1][m][1] * rinv;
                    f32x4 o1, o2;
#pragma unroll
                    for (int e = 0; e < 4; ++e) { float c, s; rope_cs_t(pos, rtn[e], c, s); o1[e] = x1[e] * c - x2[e] * s; o2[e] = x1[e] * s + x2[e] * c; }
                    sr += sq4(o1) + sq4(o2);
                    const f32x4 r1 = o1 * g10, r2 = o2 * g11;
                    sg += sq4(r1) + sq4(r2);
                    st_bf4(qrow + 128 + ri, r1); st_bf4(qrow + 160 + ri, r2);
                }
                sr = red_fq(sr); sg = red_fq(sg);
                if (fq == 0) { float* d = SSQ_Q + ((size_t)row * 8 + h) * 8 + wc * 2; d[0] = sr; d[1] = sg; }
            }
    }
};

struct EpiKV {
    static constexpr bool PERM = false, AFTER_DRAIN = false;
    const float* SSQ_CKV; bf16_t* KNB; float* SSQ_KN; bf16_t* VT;
    __device__ __forceinline__ void operator()(const f32x4 (&acc)[2][2][4][2], const pg8::Unit& u, int wr, int wc, int fr, int fq) const {
        EPI_RELANE();
        const int h = u.pn;
        const int cl = wc * 32 + 4 * fq;
        f32x4 sv[8]; float rinvs[8];
#pragma unroll
        for (int q0 = 0; q0 < 8; q0 += 4) {
#pragma unroll
            for (int q = q0; q < q0 + 4; ++q) sv[q] = *(const f32x4*)(SSQ_CKV + (u.pm * 256 + (q >> 2) * 128 + wr * 64 + (q & 3) * 16 + fr) * 4);
            __builtin_amdgcn_sched_barrier(0);
#pragma unroll
            for (int q = q0; q < q0 + 4; ++q) rinvs[q] = 1.0f / sqrtf(((sv[q].x + sv[q].y) + (sv[q].z + sv[q].w)) * (1.f / 256.f) + EPS);
            __builtin_amdgcn_sched_barrier(0);
        }
#pragma unroll
        for (int ai = 0; ai < 2; ++ai)
#pragma unroll
            for (int m = 0; m < 4; ++m) {
                const int row = u.pm * 256 + ai * 128 + wr * 64 + m * 16 + fr;
                const int b = row >> 12, t = row & (SEQ - 1);
                const float rinv = rinvs[ai * 4 + m];
                const f32x4 k0 = acc[ai][0][m][0] * rinv, k1 = acc[ai][0][m][1] * rinv;
                bf16_t* kr = KNB + ((size_t)(b * 8 + h) * SEQ + t) * 128;
                st_bf4(kr + cl, k0); st_bf4(kr + cl + 16, k1);
                float s = red_fq(sq4(k0) + sq4(k1));
                if (fq == 0) SSQ_KN[((size_t)row * 8 + h) * 4 + wc] = s;
                const int tp = perm23(t);
#pragma unroll
                for (int n = 0; n < 2; ++n) { const f32x4 v = acc[ai][1][m][n] * rinv; const int dv = cl + 16 * n;
                    bf16_t* vp = VT + ((size_t)(b * 8 + h) * 128 + dv) * SEQ + tp;
                    vp[0] = (bf16_t)f2bf(v.x); vp[SEQ] = (bf16_t)f2bf(v.y); vp[2 * SEQ] = (bf16_t)f2bf(v.z); vp[3 * SEQ] = (bf16_t)f2bf(v.w); }
            }
    }
};

struct EpiMerge {
    static constexpr bool PERM = false, AFTER_DRAIN = false;
    const float* XP; const float* XS; float* Y;
    __device__ __forceinline__ void operator()(const f32x4 (&acc)[2][2][4][2], const pg8::Unit& u, int wr, int wc, int fr, int fq) const {
        EPI_RELANE();
        const int c0 = u.pn * 256 + wc * 32 + 4 * fq;
#pragma unroll
        for (int ai = 0; ai < 2; ++ai) {
            f32x4 xv[4][2][2];
#pragma unroll
            for (int m = 0; m < 4; ++m) {
                const int row = u.pm * 256 + ai * 128 + wr * 64 + m * 16 + fr;
                const float* xr = (row < NP) ? XP + (size_t)row * 2048 : XS + (size_t)(row - NP) * 2048;
#pragma unroll
                for (int bj = 0; bj < 2; ++bj)
#pragma unroll
                    for (int n = 0; n < 2; ++n) xv[m][bj][n] = *(const f32x4*)(xr + c0 + bj * 128 + 16 * n);
            }
            __builtin_amdgcn_sched_barrier(0);
#pragma unroll
            for (int m = 0; m < 4; ++m) {
                const int row = u.pm * 256 + ai * 128 + wr * 64 + m * 16 + fr;
#pragma unroll
                for (int bj = 0; bj < 2; ++bj)
#pragma unroll
                    for (int n = 0; n < 2; ++n) *(f32x4*)(Y + (size_t)row * 2048 + c0 + bj * 128 + 16 * n) = acc[ai][bj][m][n] + xv[m][bj][n];
            }
            __builtin_amdgcn_sched_barrier(0);
        }
    }
};

struct EpiPart {
    static constexpr bool PERM = false, AFTER_DRAIN = false;
    float* C;
    __device__ __forceinline__ void operator()(const f32x4 (&acc)[2][2][4][2], const pg8::Unit& u, int wr, int wc, int fr, int fq) const {
        EPI_RELANE();
#pragma unroll
        for (int ai = 0; ai < 2; ++ai)
#pragma unroll
            for (int m = 0; m < 4; ++m) {
                const int row = u.pm * 256 + ai * 128 + wr * 64 + m * 16 + fr;
                const int c0 = u.pn * 256 + wc * 32 + 4 * fq;
#pragma unroll
                for (int bj = 0; bj < 2; ++bj)
#pragma unroll
                    for (int n = 0; n < 2; ++n) *(f32x4*)(C + (size_t)row * 2048 + c0 + bj * 128 + 16 * n) = acc[ai][bj][m][n];
            }
    }
};
struct SchedOne {
    int pm, pn; bool on;
    __device__ bool next(int i, pg8::Unit& u) const { if (i > 0 || !on) return false; u.pm = pm; u.pn = pn; return true; }
    __device__ __forceinline__ void a_ready(const pg8::Unit&) const {}
    __device__ __forceinline__ void done(const pg8::Unit&) const {}
};

struct P2Row { f32x4 sck, ckv, sqm, smk, mk0, mk1; u32x4 qm; float k1, k2; };
__device__ __forceinline__ void p2a_load(Frame& F, P2Row& r, int row, int lane) {
    const f32x4 z4 = (f32x4){0.f, 0.f, 0.f, 0.f}; r.sck = z4; r.ckv = z4; r.sqm = z4; r.smk = z4; r.mk0 = z4; r.mk1 = z4; r.qm = (u32x4){0u, 0u, 0u, 0u}; r.k1 = 0.f; r.k2 = 0.f;
    if (row < NR) {
        r.sck = *(const f32x4*)(WSP(float, WS_SSQ_CKV) + row * 4);
        r.ckv = *((const f32x4*)(WSP(float, WS_CKVF) + (size_t)row * 256) + lane);
        const float* kr = WSP(float, WS_KRF) + (size_t)row * 64; r.k1 = kr[lane & 31]; r.k2 = kr[(lane & 31) + 32];
        r.qm = *((const u32x4*)(WSP(bf16_t, WS_QMR) + (size_t)row * 512) + lane);
        r.sqm = *(const f32x4*)(WSP(float, WS_SSQ_QM) + row * 16 + (lane >> 4) * 4);
    } else {
        const int mr = row - NR;
        const float* src = WSP(float, WS_MKRAW) + (size_t)mr * 512 + 8 * lane;
        r.mk0 = *(const f32x4*)src; r.mk1 = *(const f32x4*)(src + 4);
        r.smk = *(const f32x4*)(WSP(float, WS_SSQ_MK) + mr * 16 + (lane >> 4) * 4);
    }
}
__device__ __forceinline__ void p2a_finish(Frame& F, const P2Row& r, int row, int lane, const f32x4 gkv, const f32x4 gq0, const f32x4 gq1, const f32x4 gk0, const f32x4 gk1, const double rtn) {
    const float gmq[8] = {gq0.x, gq0.y, gq0.z, gq0.w, gq1.x, gq1.y, gq1.z, gq1.w}, gmk[8] = {gk0.x, gk0.y, gk0.z, gk0.w, gk1.x, gk1.y, gk1.z, gk1.w};
    const int head = lane >> 4, j0 = (8 * lane) & 127;
    if (row < NR) {
        const bool prompt = row < NP;
        const int pos = prompt ? (row & (SEQ - 1)) : PAST + ((row - NP) & 7);
        { const float rinv = 1.0f / sqrtf(((r.sck.x + r.sck.y) + (r.sck.z + r.sck.w)) * (1.f / 256.f) + EPS);
          const f32x4 v = r.ckv * rinv * gkv;
          float* o = prompt ? F.out + O_CKV_P + (size_t)row * 256 : F.out + O_CKV_S + (size_t)(row - NP) * 256;
          *((f32x4*)o + lane) = v;
          if (!prompt) st_bf4(WSP(bf16_t, WS_CKVS) + (size_t)(row - NP) * 256 + 4 * lane, v); }
        { float c, s; rope_cs_t(pos, rtn, c, s);
          const float o = (lane < 32) ? (r.k1 * c - r.k2 * s) : (r.k1 * s + r.k2 * c);
          float* op = prompt ? F.out + O_KR_P + (size_t)row * 64 : F.out + O_KR_S + (size_t)(row - NP) * 64;
          op[lane] = o;
          WSP(bf16_t, WS_KRB)[(size_t)row * 64 + lane] = (bf16_t)f2bf(o);
          const float ss = wave_sum(o * o);
          if (lane == 0) WSP(float, WS_SSQ_KR)[row] = ss; }
        { const float rinv = 1.0f / sqrtf(((r.sqm.x + r.sqm.y) + (r.sqm.z + r.sqm.w)) * (1.f / 128.f) + EPS);
          const float sc = rinv * (0.08838834764831845f * LOG2E);
          float q[8] = {bflo(r.qm.x), bfhi(r.qm.x), bflo(r.qm.y), bfhi(r.qm.y), bflo(r.qm.z), bfhi(r.qm.z), bflo(r.qm.w), bfhi(r.qm.w)};
          float sb = 0.f;
#pragma unroll
          for (int e = 0; e < 8; ++e) { q[e] *= sc * gmq[e]; const float t = q[e] * gmk[e]; sb += t * t; }
          u32x4 o; o.x = pk2(q[0], q[1]); o.y = pk2(q[2], q[3]); o.z = pk2(q[4], q[5]); o.w = pk2(q[6], q[7]);
          *((u32x4*)(WSP(bf16_t, WS_QM) + (size_t)row * 512) + lane) = o;
          sb += __shfl_xor(sb, 1); sb += __shfl_xor(sb, 2); sb += __shfl_xor(sb, 4); sb += __shfl_xor(sb, 8);
          if ((lane & 15) == 0) WSP(float, WS_MQM)[row * 4 + head] = sqrtf(sb) * 11.313708498984761f; }
    } else {
        const int mr = row - NR, b = mr >> 8, key = mr & 255;
        const float rinv = 1.0f / sqrtf(((r.smk.x + r.smk.y) + (r.smk.z + r.smk.w)) * (1.f / 128.f) + EPS);
        const f32x4 a = r.mk0 * rinv * gk0, c = r.mk1 * rinv * gk1;
        float* o = F.out + O_MK + (size_t)mr * 512 + 8 * lane;
        *(f32x4*)o = a; *(f32x4*)(o + 4) = c;
        u32x4 w; w.x = pk2(a.x, a.y); w.y = pk2(a.z, a.w); w.z = pk2(c.x, c.y); w.w = pk2(c.z, c.w);
        *(u32x4*)(WSP(bf16_t, WS_MKB) + ((size_t)(b * 4 + head) * 256 + key) * 128 + j0) = w;
    }
}
__device__ __forceinline__ void p2a_rows(Frame& F, const Params& P) {
    int tid = F.tid; asm volatile("" : "+v"(tid));
    const int gw = F.bid * 8 + F.wave, NGW = F.G * 8, lane = tid & 63;
    const f32x4 gkv = *((const f32x4*)P.in[24] + lane);
    const int j0 = (8 * lane) & 127;
    const f32x4 gq0 = *(const f32x4*)(P.in[31] + j0), gq1 = *(const f32x4*)(P.in[31] + j0 + 4), gk0 = *(const f32x4*)(P.in[32] + j0), gk1 = *(const f32x4*)(P.in[32] + j0 + 4);
    const double rtn = ROPE_TURNS[lane & 31];
    for (int row = gw; row < NR + 512; row += 2 * NGW) {
        const int row2 = row + NGW; const bool has2 = row2 < NR + 512;
        P2Row ra, rb;
        p2a_load(F, ra, row, lane);
        if (has2) p2a_load(F, rb, row2, lane);
        __builtin_amdgcn_sched_barrier(0);
        p2a_finish(F, ra, row, lane, gkv, gq0, gq1, gk0, gk1, rtn);
        if (has2) p2a_finish(F, rb, row2, lane, gkv, gq0, gq1, gk0, gk1, rtn);
    }
}

constexpr int SSM_U_OFF = 0, SSM_X_OFF = 16384, SSM_X_BYTES = 32 * 136 * 2, SSM_G_OFF = SSM_X_OFF + 8 * SSM_X_BYTES, SSM_G_PITCH = 520, SSM_C_OFF = SSM_G_OFF + 32 * SSM_G_PITCH * 2;
static_assert(SSM_C_OFF + 16384 <= LDS_MISC, "ssm LDS map");
__device__ __forceinline__ float sigmoidf_(float a) { return __builtin_amdgcn_rcpf(1.0f + ex2(-a * LOG2E)); }
__device__ __forceinline__ float other_half(float x, int hh) {
    const auto rr = __builtin_amdgcn_permlane32_swap(__builtin_bit_cast(unsigned, x), __builtin_bit_cast(unsigned, x), false, false);
    return __builtin_bit_cast(float, hh ? rr[0] : rr[1]);
}
template <int MODE>
__device__ __forceinline__ void ssm_unit(Frame& F, const Params& P, int unit) {
    int tid = F.tid; asm volatile("" : "+v"(tid));
    const int lane = tid & 63, w = F.wave, i32 = lane & 31, hh = lane >> 5;
    const int b = unit >> 7, c = unit & 127;
    const int base = (MODE == 2) ? NP + 32 * unit : b * SEQ + c * 32;
    LAS float* Uw = (LAS float*)(F.lds + SSM_U_OFF + w * 2048);
    LAS bf16_t* Xw = (LAS bf16_t*)(F.lds + SSM_X_OFF + w * SSM_X_BYTES);
    LAS bf16_t* Gt = (LAS bf16_t*)(F.lds + SSM_G_OFF);
    const float* UF = WSP(float, WS_UF);
    LAS f32x2* CR = (LAS f32x2*)(F.lds + SSM_C_OFF + w * 2048);
    if (MODE == 1) {
        const int n = lane;
        float cr[4] = {0.f, 0.f, 0.f, 0.f}, ci[4] = {0.f, 0.f, 0.f, 0.f};
        f32x2 al[4];
#pragma unroll
        for (int gi = 0; gi < 4; ++gi) al[gi] = WSP(f32x2, WS_ABARL)[(4 * w + gi) * 64 + n];
        const f32x2* sch = WSP(f32x2, WS_SCH) + ((size_t)(b * 128) * 32 + 4 * w) * 64 + n;
        const int nbt = (c + 7) >> 3;
#ifdef PROBE_SSM_C
        for (int rc_ = 0; rc_ < 2; ++rc_) { if (rc_) { cr[0] = cr[1] = cr[2] = cr[3] = 0.f; ci[0] = ci[1] = ci[2] = ci[3] = 0.f; }
#else
        {
#endif
        const int nbt2 = (nbt + 1) & ~1;
        f32x2 svA[4][8], svB[4][8];
#define CARRY_LOAD(sv_, bq_) do { const int c0_ = c - (nbt2 - (bq_)) * 8; _Pragma("unroll") for (int k = 0; k < 8; ++k) _Pragma("unroll") for (int gi = 0; gi < 4; ++gi) { \
            const int cc = c0_ + k; sv_[gi][k] = sch[(size_t)(cc >= 0 ? cc : 0) * 2048 + gi * 64]; } } while (0)
#define CARRY_STEP(sv_, bq_) do { const int c0_ = c - (nbt2 - (bq_)) * 8; _Pragma("unroll") for (int k = 0; k < 8; ++k) _Pragma("unroll") for (int gi = 0; gi < 4; ++gi) { \
            const float mk = (c0_ + k >= 0) ? 1.f : 0.f; const float nr = al[gi].x * cr[gi] - al[gi].y * ci[gi] + sv_[gi][k].x * mk, ni = al[gi].x * ci[gi] + al[gi].y * cr[gi] + sv_[gi][k].y * mk; cr[gi] = nr; ci[gi] = ni; } } while (0)
        if (nbt2 > 0) CARRY_LOAD(svA, 0);
        for (int bq = 0; bq < nbt2; bq += 2) {
            CARRY_LOAD(svB, bq + 1);
            __builtin_amdgcn_sched_barrier(0);
            CARRY_STEP(svA, bq);
            __builtin_amdgcn_sched_barrier(0);
            { const int bn = (bq + 2 < nbt2) ? bq + 2 : nbt2 - 1; CARRY_LOAD(svA, bn); }
            __builtin_amdgcn_sched_barrier(0);
            CARRY_STEP(svB, bq + 1);
            __builtin_amdgcn_sched_barrier(0);
        }
#undef CARRY_LOAD
#undef CARRY_STEP
        }
#pragma unroll
        for (int gi = 0; gi < 4; ++gi) CR[gi * 64 + n] = (f32x2){cr[gi], ci[gi]};
        LDS_WAIT();
    }
#ifdef PROBE_SSM_G
    for (int rg_ = 0; rg_ < 2; ++rg_)
#endif
    for (int gi = 0; gi < 4; ++gi) {
        const int g = 4 * w + gi;
        bf16x8 ua;
        { const float* s = UF + (size_t)(base + i32) * 512 + 16 * g + 8 * hh;
          const f32x4 a = *(const f32x4*)s, d = *(const f32x4*)(s + 4);
          *(LAS f32x4*)(Uw + i32 * 16 + 8 * hh) = a; *(LAS f32x4*)(Uw + i32 * 16 + 8 * hh + 4) = d;
          u32x4 o; o.x = pk2(a.x, a.y); o.y = pk2(a.z, a.w); o.z = pk2(d.x, d.y); o.w = pk2(d.z, d.w); ua = __builtin_bit_cast(bf16x8, o); }
        f32x16 bu0, bu1, bu2, bu3;
        { const bf16_t* bs = WSP(bf16_t, WS_BBST) + ((size_t)g * 128 + i32) * 16 + 8 * hh;
          bu0 = mfma32(ua, *(const bf16x8*)(bs), zero16());
          bu1 = mfma32(ua, *(const bf16x8*)(bs + 32 * 16), zero16());
          bu2 = mfma32(ua, *(const bf16x8*)(bs + 64 * 16), zero16());
          bu3 = mfma32(ua, *(const bf16x8*)(bs + 96 * 16), zero16()); }
        const f32x2 a0 = WSP(f32x2, WS_ABAR)[g * 64 + i32], a1 = WSP(f32x2, WS_ABAR)[g * 64 + 32 + i32];
        float dp = 0.f; if (MODE >= 1) dp = P.in[19][16 * g + (i32 & 15)];
        bf16x8 cfr[8]; float h0v[4][4];
        if (MODE >= 1) { const bf16_t* cbp = WSP(bf16_t, WS_CSTB) + (size_t)(g * 32 + i32) * 128 + 8 * hh;
#pragma unroll
            for (int ks = 0; ks < 8; ++ks) cfr[ks] = *(const bf16x8*)(cbp + 16 * ks); }
        if (MODE == 2) {
#pragma unroll
            for (int m = 0; m < 4; ++m) { const size_t so = (size_t)((4 * unit + m) * 32 + g) * 64 + i32;
                h0v[m][0] = P.in[7][so]; h0v[m][1] = P.in[8][so]; h0v[m][2] = P.in[7][so + 32]; h0v[m][3] = P.in[8][so + 32]; } }
        float x0r = 0.f, x0i = 0.f, x1r = 0.f, x1i = 0.f;
        if (MODE == 1) { const f32x2 v0 = CR[gi * 64 + i32], v1 = CR[gi * 64 + 32 + i32]; x0r = v0.x; x0i = v0.y; x1r = v1.x; x1i = v1.y; }
#pragma unroll
        for (int m = 0; m < 4; ++m) {
#pragma unroll
            for (int ps = 0; ps < 2; ++ps) {
                if (MODE == 2 && ps == 0) { x0r = h0v[m][0]; x0i = h0v[m][1]; x1r = h0v[m][2]; x1i = h0v[m][3]; }
#pragma unroll
                for (int e = 0; e < 4; ++e) { const int r = 4 * m + e;
                    const float n0r = a0.x * x0r - a0.y * x0i + bu0[r], n0i = a0.x * x0i + a0.y * x0r + bu2[r];
                    const float n1r = a1.x * x1r - a1.y * x1i + bu1[r], n1i = a1.x * x1i + a1.y * x1r + bu3[r];
                    x0r = n0r; x0i = n0i; x1r = n1r; x1i = n1i;
                    if (MODE >= 1 && hh == ps) { LAS bf16_t* xp = Xw + (8 * m + 4 * ps + e) * 136 + i32;
                        xp[0] = (bf16_t)f2bf(x0r); xp[32] = (bf16_t)f2bf(x1r); xp[64] = (bf16_t)f2bf(x0i); xp[96] = (bf16_t)f2bf(x1i); }
                }
                if (MODE == 2 && ps == 1 && hh == 1) { const int bs = 4 * unit + m; const size_t so = (size_t)(bs * 32 + g) * 64 + i32;
                    F.out[O_SRE_S + so] = x0r; F.out[O_SIM_S + so] = x0i; F.out[O_SRE_S + so + 32] = x1r; F.out[O_SIM_S + so + 32] = x1i; }
                x0r = other_half(x0r, hh); x0i = other_half(x0i, hh); x1r = other_half(x1r, hh); x1i = other_half(x1i, hh);
            }
        }
        if (MODE == 0 && hh == 0) { f32x2* d = WSP(f32x2, WS_SCH) + ((size_t)(b * 128 + c) * 32 + g) * 64 + i32; d[0] = (f32x2){x0r, x0i}; d[32] = (f32x2){x1r, x1i}; }
        if (MODE == 1 && c == 127 && hh == 0) { const size_t so = (size_t)(b * 32 + g) * 64 + i32;
            F.out[O_SRE_P + so] = x0r; F.out[O_SIM_P + so] = x0i; F.out[O_SRE_P + so + 32] = x1r; F.out[O_SIM_P + so + 32] = x1i; }
        if (MODE >= 1) {
            LDS_WAIT();
            f32x16 acc = zero16();
            bf16x8 xa[8]; float uv[16];
#pragma unroll
            for (int ks = 0; ks < 8; ++ks) xa[ks] = *(LAS bf16x8*)(Xw + i32 * 136 + 16 * ks + 8 * hh);
#pragma unroll
            for (int r = 0; r < 16; ++r) uv[r] = Uw[crow(r, hh) * 16 + (i32 & 15)];
            __builtin_amdgcn_sched_barrier(0);
#pragma unroll
            for (int ks = 0; ks < 8; ++ks) acc = mfma32(xa[ks], cfr[ks], acc);
            asm volatile("" : "+v"(dp));
            if (i32 < 16) {
#pragma unroll
                for (int r = 0; r < 16; ++r) { const int t = crow(r, hh); const float y = acc[r] + dp * uv[r];
                    const float gl = y * sigmoidf_(1.5957691216057308f * (y + 0.044715f * y * y * y));
                    Gt[t * SSM_G_PITCH + 16 * g + i32] = (bf16_t)f2bf(gl); } }
        }
        LDS_WAIT();
    }
    if (MODE >= 1) {
        __syncthreads();
        const u32x4* gf = WSP(u32x4, WS_GLUF) + lane;
        u32x4 fa[8], fb[8];
#define GLU_LOAD(dst, cbk_, q8_) do { _Pragma("unroll") for (int k_ = 0; k_ < 8; ++k_) dst[k_] = gf[(size_t)((cbk_) * 32 + (q8_) * 8 + k_) * 64]; __builtin_amdgcn_sched_barrier(0); } while (0)
#define GLU_MMA(src, q8_) do { bf16x8 ga_[8]; _Pragma("unroll") for (int k_ = 0; k_ < 8; ++k_) ga_[k_] = *(LAS bf16x8*)(Gt + i32 * SSM_G_PITCH + 16 * ((q8_) * 8 + k_) + 8 * hh); __builtin_amdgcn_sched_barrier(0); \
        _Pragma("unroll") for (int k_ = 0; k_ < 8; ++k_) acc = mfma32(ga_[k_], __builtin_bit_cast(bf16x8, src[k_]), acc); __builtin_amdgcn_sched_barrier(0); } while (0)
#define GLU_EPI(cbk_, bias) do { const int ch = (cbk_) * 32 + i32; \
            float gvv_[16]; _Pragma("unroll") for (int r = 0; r < 16; ++r) gvv_[r] = bf2f(Gt[crow(r, hh) * SSM_G_PITCH + ch]); \
            _Pragma("unroll") for (int r = 0; r < 16; ++r) { const int t = crow(r, hh); const float gv = gvv_[r]; \
                WSP(bf16_t, WS_YSSM)[(size_t)(base + t) * 512 + ch] = (bf16_t)f2bf(gv * sigmoidf_(acc[r] + bias)); } } while (0)
        f32x16 acc = zero16();
        const float bias0 = P.in[21][(2 * w) * 32 + i32], bias1 = P.in[21][(2 * w + 1) * 32 + i32];
        GLU_LOAD(fa, 2 * w, 0); GLU_LOAD(fb, 2 * w, 1);
        GLU_MMA(fa, 0); GLU_LOAD(fa, 2 * w, 2);
        GLU_MMA(fb, 1); GLU_LOAD(fb, 2 * w, 3);
        GLU_MMA(fa, 2); GLU_LOAD(fa, 2 * w + 1, 0);
        GLU_MMA(fb, 3); GLU_LOAD(fb, 2 * w + 1, 1);
        GLU_EPI(2 * w, bias0);
        acc = zero16();
        GLU_MMA(fa, 0); GLU_LOAD(fa, 2 * w + 1, 2);
        GLU_MMA(fb, 1); GLU_LOAD(fb, 2 * w + 1, 3);
        GLU_MMA(fa, 2);
        GLU_MMA(fb, 3);
        GLU_EPI(2 * w + 1, bias1);
#undef GLU_LOAD
#undef GLU_MMA
#undef GLU_EPI
        __syncthreads();
    }
}

template <bool MLA> struct AttnCfg { static constexpr int DQK = MLA ? 192 : 128, KS = DQK / 16, CK = DQK / 8  , KBYTES = 64 * DQK * 2, VBYTES = 128 * 128,
                                     BUF = KBYTES + VBYTES, NDMA = BUF / (512 * 16), RK_OFF = 3 * BUF; };
template <bool MLA> __device__ __forceinline__ int aswz_k(int row) { return MLA ? ((row >> 1) & 7) : (row & 15); }
__device__ __forceinline__ int aswz_v(int row) { return (row >> 1) & 7; }
template <bool MLA>
__device__ __forceinline__ void attn_qblock(Frame& F, int b, int h, int qb, bool rk_valid = false) {
    typedef AttnCfg<MLA> C;
    int tid = F.tid; asm volatile("" : "+v"(tid));
    const int lane = tid & 63, w = F.wave, i32 = lane & 31, hh = lane >> 5, qs = w & 3, kh = w >> 2;
    const int qrow = qb * 128 + qs * 32 + i32, grow = b * SEQ + qrow;
    LAS unsigned char* lds = F.lds;
    const int ntiles = MLA ? 2 * qb + 2 : 4;
    unsigned goff[C::NDMA], gstr[C::NDMA];
#pragma unroll
    for (int k = 0; k < C::NDMA; ++k) {
        const int L = k * 512 + tid;
        if (L < 64 * C::CK) {
            const int row = L / C::CK, lc = (L % C::CK) ^ aswz_k<MLA>(row);
            if (MLA) {
                if (lc < 16) { goff[k] = (unsigned)(WS_KNB + (((size_t)(b * 8 + h) * SEQ + row) * 128 + lc * 8) * 2); gstr[k] = 64 * 128 * 2; }
                else         { goff[k] = (unsigned)(WS_KRB + (((size_t)b * SEQ + row) * 64 + (lc - 16) * 8) * 2); gstr[k] = 64 * 64 * 2; }
            } else { goff[k] = (unsigned)(WS_MKB + (((size_t)(b * 4 + h) * MEMT + row) * 128 + lc * 8) * 2); gstr[k] = 64 * 128 * 2; }
        } else {
            const int Lv = L - 64 * C::CK, row = Lv >> 3, lc = (Lv & 7) ^ aswz_v(row);
            if (MLA) goff[k] = (unsigned)(WS_VT + (((size_t)(b * 8 + h) * 128 + row) * SEQ + lc * 8) * 2);
            else     goff[k] = (unsigned)(WS_VTM + (((size_t)(b * 4 + h) * 128 + row) * MEMT + lc * 8) * 2);
            gstr[k] = 64 * 2;
        }
    }
#define ATT_ISSUE(j) ATT_ISSUE_AT(j, ((j) % 3) * C::BUF)
#define ATT_ISSUE_AT(j, boff_) do { const int bo_ = (boff_) + w * 1024; _Pragma("unroll") for (int k_ = 0; k_ < C::NDMA; ++k_) \
        __builtin_amdgcn_global_load_lds((const unsigned*)(F.ws + goff[k_] + (size_t)(j) * gstr[k_]), (LAS unsigned*)(lds + bo_ + k_ * 8192), 16, 0, 0); } while (0)
    if (MLA && !rk_valid) {
        LAS float* rk = (LAS float*)(lds + C::RK_OFF);
        const int nk = ntiles * 64;
#pragma unroll 1
        for (int t0 = 0; t0 < nk; t0 += 2048) {
            f32x4 spv[4]; float krv[4];
#pragma unroll
            for (int u = 0; u < 4; ++u) { const int t = t0 + u * 512 + tid, gk = b * SEQ + (t < nk ? t : nk - 1);
                spv[u] = *(const f32x4*)(WSP(float, WS_SSQ_KN) + ((size_t)gk * 8 + h) * 4); krv[u] = WSP(float, WS_SSQ_KR)[gk]; }
            __builtin_amdgcn_sched_barrier(0);
#pragma unroll
            for (int u = 0; u < 4; ++u) { const int t = t0 + u * 512 + tid; const f32x4 sp = spv[u];
                if (t < nk) rk[t] = __builtin_amdgcn_rsqf(((sp.x + sp.y) + (sp.z + sp.w) + krv[u]) * (1.f / 192.f) + EPS); }
        }
    }
    bf16x8 qf[C::KS]; float M2;
    if (MLA) {
        const float* sp = WSP(float, WS_SSQ_Q) + ((size_t)grow * 8 + h) * 8;
        const float sr = (sp[0] + sp[2]) + (sp[4] + sp[6]), sg = (sp[1] + sp[3]) + (sp[5] + sp[7]);
        const float rinv = 1.0f / sqrtf(sr * (1.f / 192.f) + EPS);
        M2 = 13.856406460551018f * rinv * sqrtf(sg);
        const bf16_t* qp = WSP(bf16_t, WS_QG) + (size_t)grow * 1536 + h * 192 + 8 * hh;
        u32x4 qraw[C::KS];
#pragma unroll
        for (int ks = 0; ks < C::KS; ++ks) qraw[ks] = *(const u32x4*)(qp + 16 * ks);
        __builtin_amdgcn_sched_barrier(0);
#pragma unroll
        for (int ks = 0; ks < C::KS; ++ks) { const u32x4 v = qraw[ks]; u32x4 o;
            o.x = pk2(bflo(v.x) * rinv, bfhi(v.x) * rinv); o.y = pk2(bflo(v.y) * rinv, bfhi(v.y) * rinv); o.z = pk2(bflo(v.z) * rinv, bfhi(v.z) * rinv); o.w = pk2(bflo(v.w) * rinv, bfhi(v.w) * rinv);
            qf[ks] = __builtin_bit_cast(bf16x8, o); }
    } else {
        M2 = WSP(float, WS_MQM)[grow * 4 + h];
        const bf16_t* qp = WSP(bf16_t, WS_QM) + (size_t)grow * 512 + h * 128 + 8 * hh;
#pragma unroll
        for (int ks = 0; ks < C::KS; ++ks) qf[ks] = *(const bf16x8*)(qp + 16 * ks);
    }
    asm volatile("s_waitcnt vmcnt(0) lgkmcnt(0)" ::: "memory");
    ATT_ISSUE(0); ATT_ISSUE(1);
    f32x16 o[4]; o[0] = zero16(); o[1] = zero16(); o[2] = zero16(); o[3] = zero16();
    float lsum = 0.f;
    const int kswz = aswz_k<MLA>(kh * 32 + i32), vswz = aswz_v(i32);
    int kx[4];
#pragma unroll
    for (int m = 0; m < 4; ++m) kx[m] = 16 * ((2 * m + hh) ^ kswz);
    int bcur = 0;
    for (int j = 0; j < ntiles; ++j) {
        if (j + 1 < ntiles) { if (C::NDMA == 5) asm volatile("s_waitcnt vmcnt(5)" ::: "memory"); else asm volatile("s_waitcnt vmcnt(4)" ::: "memory"); }
        else asm volatile("s_waitcnt vmcnt(0)" ::: "memory");
        __builtin_amdgcn_s_barrier(); asm volatile("" ::: "memory");
        if (j + 2 < ntiles) { int b2 = bcur + 2 * C::BUF; if (b2 >= 3 * C::BUF) b2 -= 3 * C::BUF; ATT_ISSUE_AT(j + 2, b2); }
        const LAS unsigned char* kt = lds + bcur + (kh * 32 + i32) * (C::CK * 16);
        constexpr int KH = C::KS / 2;
        bf16x8 kf[KH];
#pragma unroll
#define K_ADDR(ks_) (MLA ? kt + kx[(ks_) & 3] + 128 * ((ks_) >> 2) : kt + 16 * ((2 * (ks_) + hh) ^ kswz))
        for (int ks = 0; ks < KH; ++ks) kf[ks] = *(const LAS bf16x8*)K_ADDR(ks);
        __builtin_amdgcn_sched_barrier(0);
        f32x16 s = zero16();
#pragma unroll
        for (int ks = 0; ks < KH; ++ks) { s = mfma32(kf[ks], qf[ks], s); kf[ks] = *(const LAS bf16x8*)K_ADDR(ks + KH); __builtin_amdgcn_sched_barrier(0); }
#undef K_ADDR
#pragma unroll
        for (int ks = 0; ks < KH; ++ks) s = mfma32(kf[ks], qf[ks + KH], s);
        float p[16];
        if (MLA) {
            const LAS float* rk = (const LAS float*)(lds + C::RK_OFF) + j * 64 + kh * 32 + 4 * hh;
#pragma unroll
            for (int g4 = 0; g4 < 4; ++g4) { const f32x4 r4 = *(const LAS f32x4*)(rk + 8 * g4);
#pragma unroll
                for (int e = 0; e < 4; ++e) p[4 * g4 + e] = s[4 * g4 + e] * r4[e] - M2; }
            if (j >= 2 * qb) {
                const int kbase = j * 64 + kh * 32 + 4 * hh;
#pragma unroll
                for (int r = 0; r < 16; ++r) if (kbase + (r & 3) + 8 * (r >> 2) > qrow) p[r] = -__builtin_inff();
            }
        } else {
#pragma unroll
            for (int r = 0; r < 16; ++r) p[r] = s[r] - M2;
        }
#pragma unroll
        for (int r = 0; r < 16; ++r) { p[r] = ex2(p[r]); lsum += p[r]; }
        u32x4 w0, w1; w0.x = pk2(p[0], p[1]); w0.y = pk2(p[2], p[3]); w0.z = pk2(p[4], p[5]); w0.w = pk2(p[6], p[7]);
        w1.x = pk2(p[8], p[9]); w1.y = pk2(p[10], p[11]); w1.z = pk2(p[12], p[13]); w1.w = pk2(p[14], p[15]);
        const bf16x8 pb0 = __builtin_bit_cast(bf16x8, w0), pb1 = __builtin_bit_cast(bf16x8, w1);
        const LAS unsigned char* vt = lds + bcur + C::KBYTES + i32 * 128;
        bf16x8 vf[8];
#pragma unroll
        for (int db = 0; db < 4; ++db) {
            vf[2 * db] = *(const LAS bf16x8*)(vt + db * 32 * 128 + 16 * ((kh * 4 + hh) ^ vswz));
            vf[2 * db + 1] = *(const LAS bf16x8*)(vt + db * 32 * 128 + 16 * ((kh * 4 + 2 + hh) ^ vswz)); }
        __builtin_amdgcn_sched_barrier(0);
#pragma unroll
        for (int db = 0; db < 4; ++db) { o[db] = mfma32(vf[2 * db], pb0, o[db]); o[db] = mfma32(vf[2 * db + 1], pb1, o[db]); }
        bcur += C::BUF; if (bcur == 3 * C::BUF) bcur = 0;
    }
#undef ATT_ISSUE
#undef ATT_ISSUE_AT
    __syncthreads();
    lsum += __shfl_xor(lsum, 32);
    asm volatile("" : "+v"(tid));
    const int lane_e = tid & 63, hh_e = lane_e >> 5;
    const int grow_e = b * SEQ + qb * 128 + qs * 32 + (lane_e & 31);
    LAS float* xo = (LAS float*)lds + qs * 4096;
    LAS float* xl = (LAS float*)lds + 4 * 4096 + qs * 64;
#define lane lane_e
#define hh hh_e
#define grow grow_e
    if (kh == 1) {
#pragma unroll
        for (int db = 0; db < 4; ++db)
#pragma unroll
            for (int r = 0; r < 16; ++r) xo[(db * 16 + r) * 64 + lane] = o[db][r];
        xl[lane] = lsum;
    }
    __syncthreads();
    if (kh == 0) {
        float xv[4][16];
#pragma unroll
        for (int db = 0; db < 4; ++db)
#pragma unroll
            for (int r = 0; r < 16; ++r) xv[db][r] = xo[(db * 16 + r) * 64 + lane];
        const float inv = 1.0f / (lsum + xl[lane]);
        bf16_t* yp = MLA ? WSP(bf16_t, WS_YMLA) + (size_t)grow * 1024 + h * 128 : WSP(bf16_t, WS_YMEM) + (size_t)grow * 512 + h * 128;
#pragma unroll
        for (int db = 0; db < 4; ++db)
#pragma unroll
            for (int g4 = 0; g4 < 4; ++g4) { f32x4 v;
#pragma unroll
                for (int e = 0; e < 4; ++e) v[e] = (o[db][4 * g4 + e] + xv[db][4 * g4 + e]) * inv;
                st_bf4(yp + db * 32 + 8 * g4 + 4 * hh, v); }
    }
        __syncthreads();
#undef lane
#undef hh
#undef grow
}

constexpr int SM_CT = 0, SM_RT = 65536, SM_QA = SM_RT + 128 * 128, SM_QP = 328, SM_C8 = SM_QA + 64 * SM_QP * 2, SM_PT = SM_C8  , SM_PP = 136,
              SM_RINV = SM_C8 + 32768, SM_LX = SM_RINV  , SM_SSQR = SM_RINV + 8 * 128 * 4, SM_M2 = SM_SSQR + 512, SM_END = SM_M2 + 256;
static_assert(SM_END <= LDS_MISC && 64 * SM_PP * 2 <= 32768, "sample-MLA LDS map");
__device__ __forceinline__ int rt_off(int row, int col) { return row * 128 + 16 * ((col >> 3) ^ ((row >> 1) & 7)) + (col & 7) * 2; }
__device__ __forceinline__ int c8_off(int row, int col) { return 256 * row + 16 * ((col >> 4) ^ (((row & 3) << 2) | ((row >> 2) & 3))) + (col & 15); }
__device__ __forceinline__ int ct_off(int row, int col) {
    const int ch = (col & 127) >> 3;
    return ((col >> 7) << 15) + 256 * row + 16 * (ch ^ (((row & 3) << 2) | ((row >> 2) & 3))) + (col & 7) * 2;
}
typedef int i32x8 __attribute__((ext_vector_type(8)));
__device__ __forceinline__ f32x16 mfma8(const u32x4 a0, const u32x4 a1, const u32x4 b0, const u32x4 b1, const f32x16 c) {
    const i32x8 a = {(int)a0.x, (int)a0.y, (int)a0.z, (int)a0.w, (int)a1.x, (int)a1.y, (int)a1.z, (int)a1.w};
    const i32x8 b = {(int)b0.x, (int)b0.y, (int)b0.z, (int)b0.w, (int)b1.x, (int)b1.y, (int)b1.z, (int)b1.w};
    return __builtin_amdgcn_mfma_scale_f32_32x32x64_f8f6f4(a, b, c, 0, 0, 0, 0x7f7f7f7f, 0, 0x7f7f7f7f);
}
template <int W2, bool LOADN>
__device__ __forceinline__ void z_pass(const u32x4 (&cur)[8], u32x4 (&nxt)[8], LAS unsigned char* lds, int tb0, int i32, int hh, float& sa, float& sb, __amdgpu_buffer_rsrc_t rs, int voff, int soff_next) {
    f32x16 acc[W2];
#pragma unroll
    for (int q = 0; q < W2; ++q) acc[q] = zero16();
    u32x4 bc[W2][2], bn[W2][2];
#pragma unroll
    for (int q = 0; q < W2; ++q) { bc[q][0] = *(LAS u32x4*)(lds + SM_C8 + c8_off((tb0 + q) * 32 + i32, 32 * hh)); bc[q][1] = *(LAS u32x4*)(lds + SM_C8 + c8_off((tb0 + q) * 32 + i32, 32 * hh + 16)); }
#pragma unroll
    for (int ks = 0; ks < 4; ++ks) {
        if (ks < 3) {
#pragma unroll
            for (int q = 0; q < W2; ++q) { bn[q][0] = *(LAS u32x4*)(lds + SM_C8 + c8_off((tb0 + q) * 32 + i32, 64 * (ks + 1) + 32 * hh)); bn[q][1] = *(LAS u32x4*)(lds + SM_C8 + c8_off((tb0 + q) * 32 + i32, 64 * (ks + 1) + 32 * hh + 16)); }
        }
        __builtin_amdgcn_s_setprio(1);
#pragma unroll
        for (int q = 0; q < W2; ++q) acc[q] = mfma8(cur[2 * ks], cur[2 * ks + 1], bc[q][0], bc[q][1], acc[q]);
        __builtin_amdgcn_s_setprio(0);
        if (LOADN) { nxt[2 * ks] = __builtin_bit_cast(u32x4, __builtin_amdgcn_raw_buffer_load_b128(rs, voff, soff_next + ks * 2048, 0)); nxt[2 * ks + 1] = __builtin_bit_cast(u32x4, __builtin_amdgcn_raw_buffer_load_b128(rs, voff, soff_next + ks * 2048 + 16, 0)); }
#pragma unroll
        for (int q = 0; q < W2; ++q) { bc[q][0] = bn[q][0]; bc[q][1] = bn[q][1]; }
        __builtin_amdgcn_sched_barrier(0);
    }
#pragma unroll
    for (int q = 0; q < W2; ++q) { f32x2 p2 = (f32x2){0.f, 0.f};
#pragma unroll
        for (int r = 0; r < 16; r += 2) { const f32x2 a2 = (f32x2){acc[q][r], acc[q][r + 1]}; p2 = __builtin_elementwise_fma(a2, a2, p2); }
        float s0 = p2.x + p2.y;
        asm volatile("" : "+v"(s0));
        if (q == 0) sa += s0; else sb += s0; }
    __builtin_amdgcn_sched_barrier(0);
}
__device__ __forceinline__ void z_load(u32x4 (&af)[8], __amdgpu_buffer_rsrc_t rs, int voff, int soff) {
#pragma unroll
    for (int ks = 0; ks < 4; ++ks) { af[2 * ks] = __builtin_bit_cast(u32x4, __builtin_amdgcn_raw_buffer_load_b128(rs, voff, soff + ks * 2048, 0)); af[2 * ks + 1] = __builtin_bit_cast(u32x4, __builtin_amdgcn_raw_buffer_load_b128(rs, voff, soff + ks * 2048 + 16, 0)); }
}
__device__ __forceinline__ u32x2 bf8_to_fp8(const u32x4 v) {
    u32x2 o; int t;
    t = __builtin_amdgcn_cvt_pk_fp8_f32(bflo(v.x), bfhi(v.x), 0, false); t = __builtin_amdgcn_cvt_pk_fp8_f32(bflo(v.y), bfhi(v.y), t, true); o.x = (unsigned)t;
    t = __builtin_amdgcn_cvt_pk_fp8_f32(bflo(v.z), bfhi(v.z), 0, false); t = __builtin_amdgcn_cvt_pk_fp8_f32(bflo(v.w), bfhi(v.w), t, true); o.y = (unsigned)t;
    return o;
}
__device__ __forceinline__ void ct_store(LAS unsigned char* lds, int row, int col, const u32x4 o) {
    *(LAS u32x4*)(lds + SM_CT + ct_off(row, col)) = o;
    *(LAS u32x2*)(lds + SM_C8 + c8_off(row, col)) = bf8_to_fp8(o);
}
struct Pf { u32x4 pk[10]; f32x4 sa0, sa1, sb0, sb1, ta0, ta1, tb0, tb1; float ssr0, ssr1; };
template <int IT> __device__ __forceinline__ void pf_issue1(f32x4& a, f32x4& d, __amdgpu_buffer_rsrc_t rc, __amdgpu_buffer_rsrc_t rr, int tid) {
    const __amdgpu_buffer_rsrc_t r = (IT < 8) ? rc : rr; constexpr int so = (IT < 8 ? IT : IT - 8) * 16384;
    a = __builtin_bit_cast(f32x4, __builtin_amdgcn_raw_buffer_load_b128(r, tid * 32, so, 0)); d = __builtin_bit_cast(f32x4, __builtin_amdgcn_raw_buffer_load_b128(r, tid * 32, so + 16, 0));
}
template <int IT> __device__ __forceinline__ void pf_convert1(Pf& pf, const f32x4 a, const f32x4 d) {
    u32x4 o; o.x = pk2(a.x, a.y); o.y = pk2(a.z, a.w); o.z = pk2(d.x, d.y); o.w = pk2(d.z, d.w); pf.pk[IT] = o;
    if (IT >= 8) { float ss = sq4(a) + sq4(d); ss += __shfl_xor(ss, 1); ss += __shfl_xor(ss, 2); ss += __shfl_xor(ss, 4); if (IT == 8) pf.ssr0 = ss; else pf.ssr1 = ss; }
}
template <int J> __device__ __forceinline__ void pf_slot(Pf& pf, __amdgpu_buffer_rsrc_t rc, __amdgpu_buffer_rsrc_t rr, int tid, bool on) {
    (void)on;
    {
        if (J >= 1) { pf_convert1<(J >= 1 ? 2 * J - 2 : 0)>(pf, pf.sa0, pf.sa1); pf_convert1<(J >= 1 ? 2 * J - 1 : 1)>(pf, pf.sb0, pf.sb1); }
        if (J < 5) { pf_issue1<(J < 5 ? 2 * J : 0)>(pf.sa0, pf.sa1, rc, rr, tid); pf_issue1<(J < 5 ? 2 * J + 1 : 1)>(pf.sb0, pf.sb1, rc, rr, tid); }
    }
    __builtin_amdgcn_sched_barrier(0);
}
template <int G, int SET> __device__ __forceinline__ void pf_issue2(Pf& pf, __amdgpu_buffer_rsrc_t rc, __amdgpu_buffer_rsrc_t rr, int tid) {
    if (SET == 0) { pf_issue1<2 * G>(pf.sa0, pf.sa1, rc, rr, tid); pf_issue1<2 * G + 1>(pf.sb0, pf.sb1, rc, rr, tid); }
    else          { pf_issue1<2 * G>(pf.ta0, pf.ta1, rc, rr, tid); pf_issue1<2 * G + 1>(pf.tb0, pf.tb1, rc, rr, tid); }
}
template <int G, int SET> __device__ __forceinline__ void pf_conv2(Pf& pf) {
    if (SET == 0) { pf_convert1<2 * G>(pf, pf.sa0, pf.sa1); pf_convert1<2 * G + 1>(pf, pf.sb0, pf.sb1); }
    else          { pf_convert1<2 * G>(pf, pf.ta0, pf.ta1); pf_convert1<2 * G + 1>(pf, pf.tb0, pf.tb1); }
}
template <int J> __device__ __forceinline__ void pf_mid(Pf& pf, __amdgpu_buffer_rsrc_t rc, __amdgpu_buffer_rsrc_t rr, int tid) {
    __builtin_amdgcn_sched_barrier(0);
    if (J == 0) pf_issue2<0, 0>(pf, rc, rr, tid);
    if (J == 1) pf_issue2<1, 1>(pf, rc, rr, tid);
    if (J == 2) { pf_conv2<0, 0>(pf); pf_issue2<2, 0>(pf, rc, rr, tid); }
    if (J == 3) { pf_conv2<1, 1>(pf); pf_issue2<3, 1>(pf, rc, rr, tid); }
    if (J == 4) { pf_conv2<2, 0>(pf); pf_issue2<4, 0>(pf, rc, rr, tid); }
    if (J == 5) pf_conv2<3, 1>(pf);
    if (J == 6) pf_conv2<4, 0>(pf);
    __builtin_amdgcn_sched_barrier(0);
}
template <int IT> __device__ __forceinline__ void pf_slot_off(Pf&, __amdgpu_buffer_rsrc_t, __amdgpu_buffer_rsrc_t, int, bool) {}
__device__ __forceinline__ void pf_commit(Pf& pf, LAS unsigned char* lds, int tid) {
    const int r0 = (tid >> 5) & 15, col = (tid & 31) * 8;
    LAS unsigned char* cb = lds + SM_CT + ct_off(r0, col); LAS unsigned char* c8b = lds + SM_C8 + c8_off(r0, col);
#pragma unroll
    for (int it = 0; it < 8; ++it) { *(LAS u32x4*)(cb + 4096 * it) = pf.pk[it]; *(LAS u32x2*)(c8b + 4096 * it) = bf8_to_fp8(pf.pk[it]); }
    const int rr0 = (tid >> 3) & 63;
    LAS unsigned char* rb = lds + SM_RT + rt_off(rr0, (tid & 7) * 8);
#pragma unroll
    for (int it = 0; it < 2; ++it) { *(LAS u32x4*)(rb + 8192 * it) = pf.pk[8 + it];
        if ((tid & 7) == 0) ((LAS float*)(lds + SM_SSQR))[it * 64 + rr0] = it ? pf.ssr1 : pf.ssr0; }
}
__device__ __forceinline__ void smla_load_page(const Params& P, LAS unsigned char* lds, int page, int tid) {
    const float* cs = P.in[3] + (size_t)page * (PAGE * 256); const float* rs = P.in[4] + (size_t)page * (PAGE * 64);
    {
        f32x4 ra[6], rd[6];
#pragma unroll
        for (int it = 0; it < 4; ++it) { const int id = it * 512 + tid; ra[it] = *(const f32x4*)(cs + (size_t)id * 8); rd[it] = *(const f32x4*)(cs + (size_t)id * 8 + 4); }
#pragma unroll
        for (int it = 0; it < 2; ++it) { const int id = it * 512 + tid; ra[4 + it] = *(const f32x4*)(rs + (size_t)id * 8); rd[4 + it] = *(const f32x4*)(rs + (size_t)id * 8 + 4); }
        __builtin_amdgcn_sched_barrier(0);
#pragma unroll
        for (int it = 0; it < 4; ++it) { const int id = it * 512 + tid, row = id >> 5, col = (id & 31) * 8;
            const f32x4 a = ra[it], d = rd[it];
            u32x4 o; o.x = pk2(a.x, a.y); o.y = pk2(a.z, a.w); o.z = pk2(d.x, d.y); o.w = pk2(d.z, d.w);
            ct_store(lds, row, col, o); }
#pragma unroll
        for (int it = 0; it < 2; ++it) { const int id = it * 512 + tid, row = id >> 3, c8 = (id & 7) * 8;
            const f32x4 a = ra[4 + it], d = rd[4 + it];
            u32x4 o; o.x = pk2(a.x, a.y); o.y = pk2(a.z, a.w); o.z = pk2(d.x, d.y); o.w = pk2(d.z, d.w);
            *(LAS u32x4*)(lds + SM_RT + rt_off(row, c8)) = o;
            float ss = sq4(a) + sq4(d); ss += __shfl_xor(ss, 1); ss += __shfl_xor(ss, 2); ss += __shfl_xor(ss, 4);
            if ((id & 7) == 0) ((LAS float*)(lds + SM_SSQR))[row] = ss; }
    }
    __builtin_amdgcn_sched_barrier(0);
    {
        f32x4 ra[4], rd[4];
#pragma unroll
        for (int it = 0; it < 4; ++it) { const int id = (it + 4) * 512 + tid; ra[it] = *(const f32x4*)(cs + (size_t)id * 8); rd[it] = *(const f32x4*)(cs + (size_t)id * 8 + 4); }
        __builtin_amdgcn_sched_barrier(0);
#pragma unroll
        for (int it = 0; it < 4; ++it) { const int id = (it + 4) * 512 + tid, row = id >> 5, col = (id & 31) * 8;
            const f32x4 a = ra[it], d = rd[it];
            u32x4 o; o.x = pk2(a.x, a.y); o.y = pk2(a.z, a.w); o.z = pk2(d.x, d.y); o.w = pk2(d.z, d.w);
            ct_store(lds, row, col, o); }
    }
}
__device__ __forceinline__ void smla_load_fresh(Frame& F, LAS unsigned char* lds, int bs, int tid) {
    asm volatile("" : "+v"(tid));
    const bool v0 = tid < 256, v1 = tid < 64;
    const u32x4 l0 = *(const u32x4*)(WSP(bf16_t, WS_CKVS) + (size_t)(bs * 8 + (v0 ? (tid >> 5) : 0)) * 256 + (tid & 31) * 8);
    const u32x4 l1 = *(const u32x4*)(WSP(bf16_t, WS_KRB) + (size_t)(NP + bs * 8 + (v1 ? (tid >> 3) : 0)) * 64 + (tid & 7) * 8);
    const float l2 = WSP(float, WS_SSQ_KR)[NP + bs * 8 + (tid & 7)];
    __builtin_amdgcn_sched_barrier(0);
    unsigned zz = 0u; asm volatile("" : "+v"(zz)); const u32x4 z = (u32x4){zz, zz, zz, zz};
    ct_store(lds, tid >> 5, (tid & 31) * 8, v0 ? l0 : z);
    ct_store(lds, (tid + 512) >> 5, (tid & 31) * 8, z);
    if (tid < 256) *(LAS u32x4*)(lds + SM_RT + rt_off(tid >> 3, (tid & 7) * 8)) = v1 ? l1 : z;
    if (tid < 32) ((LAS float*)(lds + SM_SSQR))[tid] = (tid < 8) ? l2 : 0.f;
}

template <int PAR, bool FRESH>
__device__ __forceinline__ void smla_tile(Frame& F, const Params& P, int next_page, f32x16 (&oacc)[2], float& lsum, u32x4 (&afX)[8], u32x4 (&afY)[8], __amdgpu_buffer_rsrc_t wrs) {
    int tid = F.tid; asm volatile("" : "+v"(tid));
    const int lane = tid & 63, w = F.wave, i32 = lane & 31, hh = lane >> 5;
    const int wvo = lane * 32, wso = w * 32768;
    LAS unsigned char* lds = F.lds;
    LAS bf16_t* RT = (LAS bf16_t*)(lds + SM_RT); LAS bf16_t* QA = (LAS bf16_t*)(lds + SM_QA); LAS bf16_t* PT = (LAS bf16_t*)(lds + SM_PT);
    LAS float* RINV = (LAS float*)(lds + SM_RINV); LAS float* SSQR = (LAS float*)(lds + SM_SSQR); LAS float* M2S = (LAS float*)(lds + SM_M2);
    const bool pfon = (next_page >= 0);
    const int npg = pfon ? next_page : 0;
    const __amdgpu_buffer_rsrc_t rc = __builtin_amdgcn_make_buffer_rsrc((void*)(P.in[3] + (size_t)npg * (PAGE * 256)), 0, pfon ? PAGE * 256 * 4 : 0, 0x00020000);
    const __amdgpu_buffer_rsrc_t rr = __builtin_amdgcn_make_buffer_rsrc((void*)(P.in[4] + (size_t)npg * (PAGE * 64)), 0, pfon ? PAGE * 64 * 4 : 0, 0x00020000);
    Pf pf;
    {
        float ssq[4] = {0.f, 0.f, 0.f, 0.f};
        constexpr int N1 = PAR ? 2 : 1, N2 = PAR ? 1 : 2, N3 = PAR ? 0 : 3;
        if (FRESH) {
            z_pass<1, true>(afX, afY, lds, 0, i32, hh, ssq[0], ssq[1], wrs, wvo, wso + N1 * 8192);
            z_pass<1, true>(afY, afX, lds, 0, i32, hh, ssq[0], ssq[1], wrs, wvo, wso + N2 * 8192);
            z_pass<1, true>(afX, afY, lds, 0, i32, hh, ssq[0], ssq[1], wrs, wvo, wso + N3 * 8192);
            z_pass<1, false>(afY, afX, lds, 0, i32, hh, ssq[0], ssq[1], wrs, wvo, 0);
        } else if (PAR == 0) {
            z_pass<2, true>(afX, afY, lds, 0, i32, hh, ssq[0], ssq[1], wrs, wvo, wso + N1 * 8192); pf_mid<0>(pf, rc, rr, tid);
            z_pass<2, false>(afX, afY, lds, 2, i32, hh, ssq[2], ssq[3], wrs, wvo, 0);
            z_pass<2, true>(afY, afX, lds, 0, i32, hh, ssq[0], ssq[1], wrs, wvo, wso + N2 * 8192); pf_mid<1>(pf, rc, rr, tid);
            z_pass<2, false>(afY, afX, lds, 2, i32, hh, ssq[2], ssq[3], wrs, wvo, 0);
            z_pass<2, true>(afX, afY, lds, 0, i32, hh, ssq[0], ssq[1], wrs, wvo, wso + N3 * 8192); pf_mid<2>(pf, rc, rr, tid);
            z_pass<2, false>(afX, afY, lds, 2, i32, hh, ssq[2], ssq[3], wrs, wvo, 0);
            z_pass<2, false>(afY, afX, lds, 0, i32, hh, ssq[0], ssq[1], wrs, wvo, 0); pf_mid<3>(pf, rc, rr, tid);
            z_pass<2, false>(afY, afX, lds, 2, i32, hh, ssq[2], ssq[3], wrs, wvo, 0);
            pf_mid<4>(pf, rc, rr, tid);
        } else {
            z_pass<2, true>(afY, afX, lds, 0, i32, hh, ssq[0], ssq[1], wrs, wvo, wso + N1 * 8192); pf_mid<0>(pf, rc, rr, tid);
            z_pass<2, false>(afY, afX, lds, 2, i32, hh, ssq[2], ssq[3], wrs, wvo, 0);
            z_pass<2, true>(afX, afY, lds, 0, i32, hh, ssq[0], ssq[1], wrs, wvo, wso + N2 * 8192); pf_mid<1>(pf, rc, rr, tid);
            z_pass<2, false>(afX, afY, lds, 2, i32, hh, ssq[2], ssq[3], wrs, wvo, 0);
            z_pass<2, true>(afY, afX, lds, 0, i32, hh, ssq[0], ssq[1], wrs, wvo, wso + N3 * 8192); pf_mid<2>(pf, rc, rr, tid);
            z_pass<2, false>(afY, afX, lds, 2, i32, hh, ssq[2], ssq[3], wrs, wvo, 0);
            z_pass<2, false>(afX, afY, lds, 0, i32, hh, ssq[0], ssq[1], wrs, wvo, 0); pf_mid<3>(pf, rc, rr, tid);
            z_pass<2, false>(afX, afY, lds, 2, i32, hh, ssq[2], ssq[3], wrs, wvo, 0);
            pf_mid<4>(pf, rc, rr, tid);
        }
#ifdef PROBE_Z3
        if (!FRESH) {
            for (int rz_ = 0; rz_ < 2; ++rz_) {
                ssq[0] = ssq[1] = ssq[2] = ssq[3] = 0.f;
                const bool fwd = ((PAR == 0) == (rz_ == 1));
                if (fwd) {
                    z_pass<2, true>(afX, afY, lds, 0, i32, hh, ssq[0], ssq[1], wrs, wvo, wso + 1 * 8192); z_pass<2, false>(afX, afY, lds, 2, i32, hh, ssq[2], ssq[3], wrs, wvo, 0);
                    z_pass<2, true>(afY, afX, lds, 0, i32, hh, ssq[0], ssq[1], wrs, wvo, wso + 2 * 8192); z_pass<2, false>(afY, afX, lds, 2, i32, hh, ssq[2], ssq[3], wrs, wvo, 0);
                    z_pass<2, true>(afX, afY, lds, 0, i32, hh, ssq[0], ssq[1], wrs, wvo, wso + 3 * 8192); z_pass<2, false>(afX, afY, lds, 2, i32, hh, ssq[2], ssq[3], wrs, wvo, 0);
                    z_pass<2, false>(afY, afX, lds, 0, i32, hh, ssq[0], ssq[1], wrs, wvo, 0); z_pass<2, false>(afY, afX, lds, 2, i32, hh, ssq[2], ssq[3], wrs, wvo, 0);
                } else {
                    z_pass<2, true>(afY, afX, lds, 0, i32, hh, ssq[0], ssq[1], wrs, wvo, wso + 2 * 8192); z_pass<2, false>(afY, afX, lds, 2, i32, hh, ssq[2], ssq[3], wrs, wvo, 0);
                    z_pass<2, true>(afX, afY, lds, 0, i32, hh, ssq[0], ssq[1], wrs, wvo, wso + 1 * 8192); z_pass<2, false>(afX, afY, lds, 2, i32, hh, ssq[2], ssq[3], wrs, wvo, 0);
                    z_pass<2, true>(afY, afX, lds, 0, i32, hh, ssq[0], ssq[1], wrs, wvo, wso + 0 * 8192); z_pass<2, false>(afY, afX, lds, 2, i32, hh, ssq[2], ssq[3], wrs, wvo, 0);
                    z_pass<2, false>(afX, afY, lds, 0, i32, hh, ssq[0], ssq[1], wrs, wvo, 0); z_pass<2, false>(afX, afY, lds, 2, i32, hh, ssq[2], ssq[3], wrs, wvo, 0);
                }
            }
        }
#endif
        constexpr int ntb = FRESH ? 1 : 4;
        float sqr[ntb];
#pragma unroll
        for (int tb = 0; tb < ntb; ++tb) sqr[tb] = SSQR[tb * 32 + i32];
#pragma unroll
        for (int tb = 0; tb < ntb; ++tb) { float s = ssq[tb]; s += __shfl_xor(s, 32);
            if (hh == 0) RINV[w * 128 + tb * 32 + i32] = __builtin_amdgcn_rsqf((s * (1.f / 256.f) + sqr[tb]) * (1.f / 192.f) + EPS); }
    }
    __syncthreads();
    int tid2 = tid; asm volatile("" : "+v"(tid2));
#ifdef PROBE_SPV2
    for (int rep_ = 0; rep_ < 2; ++rep_) {
    if (rep_) __syncthreads();
#else
    {
#endif
    const int lane = tid2 & 63, i32 = lane & 31, hh = lane >> 5;
    {
        const int tb = w & 3, rb = w >> 2;
        if (!FRESH || tb == 0) {
            f32x16 s = zero16();
            const LAS bf16_t* qa = QA + (rb * 32 + i32) * SM_QP + 8 * hh;
#define S_A(ks_) ((ks_) < 16 ? *(LAS bf16x8*)(lds + SM_CT + ct_off(tb * 32 + i32, 16 * (ks_) + 8 * hh)) : *(LAS bf16x8*)(lds + SM_RT + rt_off(tb * 32 + i32, 16 * ((ks_) - 16) + 8 * hh)))
#define S_B(ks_) (*(const LAS bf16x8*)(qa + ((ks_) < 16 ? 16 * (ks_) : 256 + 16 * ((ks_) - 16))))
            constexpr int SD = 4;
            const int head = rb * 4 + (i32 >> 3), qi = i32 & 7;
            const LAS float* rv = RINV + head * 128 + tb * 32 + 4 * hh;
            f32x4 r4v[4];
#pragma unroll
            for (int g4 = 0; g4 < 4; ++g4) r4v[g4] = *(const LAS f32x4*)(rv + 8 * g4);
            const float m2 = M2S[rb * 32 + i32];
            bf16x8 sa_[SD], sb_[SD];
#pragma unroll
            for (int ks = 0; ks < SD; ++ks) { sa_[ks] = S_A(ks); sb_[ks] = S_B(ks); }
            __builtin_amdgcn_sched_barrier(0);
#pragma unroll
            for (int ks = 0; ks < 20; ++ks) { s = mfma32(sa_[ks % SD], sb_[ks % SD], s);
                if (ks + SD < 20) { sa_[ks % SD] = S_A(ks + SD); sb_[ks % SD] = S_B(ks + SD); }
                __builtin_amdgcn_sched_barrier(0); }
#undef S_A
#undef S_B
#pragma unroll
            for (int g4 = 0; g4 < 4; ++g4) { const f32x4 r4 = r4v[g4]; float p[4];
#pragma unroll
                for (int e = 0; e < 4; ++e) { float x = s[4 * g4 + e] * r4[e] - m2; if (FRESH && (8 * g4 + 4 * hh + e) > qi) x = -__builtin_inff(); p[e] = ex2(x); lsum += p[e]; }
                u32x2 pw; pw.x = pk2(p[0], p[1]); pw.y = pk2(p[2], p[3]);
                *(LAS u32x2*)(PT + (rb * 32 + i32) * SM_PP + tb * 32 + 8 * g4 + 4 * hh) = pw; }
        }
    }
#ifdef PROBE_SPV2
    if (!FRESH && rep_ == 0) pf_mid<5>(pf, rc, rr, tid);
#else
    if (!FRESH) pf_mid<5>(pf, rc, rr, tid);
#endif
    __syncthreads();
    {
        const int rb = w >> 2, lb0 = 2 * (w & 3), nks = FRESH ? 2 : 8;
        const int blk = (lane >> 4) & 1, qq = (lane & 15) >> 2, pp = lane & 3;
        const LAS bf16_t* pt = PT + (rb * 32 + i32) * SM_PP + 8 * hh;
        constexpr int NKS = FRESH ? 2 : 8, PD = 2;
        (void)nks;
        bf16x8 pb_[PD]; s16x4 pt0_[PD][2], pt1_[PD][2];
        LAS unsigned char* pvb[2][2];
#pragma unroll
        for (int q = 0; q < 2; ++q) { const int r0 = 8 * hh + qq, col = (lb0 + q) * 32 + 16 * blk + 4 * pp;
            pvb[q][0] = lds + SM_CT + ct_off(r0, col); pvb[q][1] = lds + SM_CT + ct_off(r0 + 4, col); }
#define PV_FETCH(slot_, ks_) do { pb_[slot_] = *(const LAS bf16x8*)(pt + 16 * (ks_)); _Pragma("unroll") for (int q = 0; q < 2; ++q) { \
            pt0_[slot_][q] = __builtin_amdgcn_ds_read_tr16_b64_v4i16((LAS s16x4*)(pvb[q][0] + 4096 * (ks_))); \
            pt1_[slot_][q] = __builtin_amdgcn_ds_read_tr16_b64_v4i16((LAS s16x4*)(pvb[q][1] + 4096 * (ks_))); } } while (0)
#pragma unroll
        for (int ks = 0; ks < PD; ++ks) PV_FETCH(ks, ks);
        __builtin_amdgcn_sched_barrier(0);
#pragma unroll
        for (int ks = 0; ks < NKS; ++ks) {
#pragma unroll
            for (int q = 0; q < 2; ++q) { const s16x4 t0 = pt0_[ks % PD][q], t1 = pt1_[ks % PD][q];
                const bf16x8 a = {t0[0], t0[1], t0[2], t0[3], t1[0], t1[1], t1[2], t1[3]};
                oacc[q] = mfma32(a, pb_[ks % PD], oacc[q]); }
            if (ks + PD < NKS) PV_FETCH(ks % PD, ks + PD);
            __builtin_amdgcn_sched_barrier(0);
        }
#undef PV_FETCH
    }
    }
    __syncthreads();
    if (!FRESH) {
        if (pfon) { pf_mid<6>(pf, rc, rr, tid); pf_commit(pf, lds, tid);
#ifdef PROBE_COMMIT2
            __syncthreads(); pf_commit(pf, lds, tid);
#endif
        }
        __syncthreads();
    }
}

__device__ __forceinline__ void smla_unit(Frame& F, const Params& P, int unit) {
    int tid = F.tid; asm volatile("" : "+v"(tid));
    const int lane = tid & 63, w = F.wave, i32 = lane & 31, hh = lane >> 5;
    const int bs = unit >> 1, half = unit & 1;
    LAS unsigned char* lds = F.lds;
    LAS bf16_t* QA = (LAS bf16_t*)(lds + SM_QA);
    LAS float* M2S = (LAS float*)(lds + SM_M2); LAS float* LX = (LAS float*)(lds + SM_LX);
    const int* ptab = (const int*)P.in[9] + bs * NPAGES + half * 32;
    const int ptv = (lane < 32) ? ptab[lane] : -1;
#define PTAB(i_) __builtin_amdgcn_readlane(ptv, (i_))
    smla_load_page(P, lds, PTAB(0), tid);
    {
        const int qi = lane & 7, grow = NP + bs * 8 + qi;
        const float* sp = WSP(float, WS_SSQ_Q) + ((size_t)grow * 8 + w) * 8;
        const float sr = (sp[0] + sp[2]) + (sp[4] + sp[6]), sg = (sp[1] + sp[3]) + (sp[5] + sp[7]);
        const float rinv = 1.0f / sqrtf(sr * (1.f / 192.f) + EPS);
        if (lane < 8) M2S[w * 8 + lane] = 13.856406460551018f * rinv * sqrtf(sg);
        const float ra = __shfl(rinv, i32 & 7);
        const bf16_t* qp = WSP(bf16_t, WS_QG) + (size_t)(NP + bs * 8 + (i32 & 7)) * 1536 + w * 192 + 8 * hh;
        bf16x8 aq[8];
        u32x4 qraw[8];
#pragma unroll
        for (int ks = 0; ks < 8; ++ks) qraw[ks] = *(const u32x4*)(qp + 16 * ks);
        __builtin_amdgcn_sched_barrier(0);
#pragma unroll
        for (int ks = 0; ks < 8; ++ks) { const u32x4 v = qraw[ks]; u32x4 o;
            o.x = pk2(bflo(v.x) * ra, bfhi(v.x) * ra); o.y = pk2(bflo(v.y) * ra, bfhi(v.y) * ra); o.z = pk2(bflo(v.z) * ra, bfhi(v.z) * ra); o.w = pk2(bflo(v.w) * ra, bfhi(v.w) * ra);
            aq[ks] = __builtin_bit_cast(bf16x8, o); }
        const bf16_t* wb = WSP(bf16_t, WS_WKV_B) + (size_t)i32 * 2048 + w * 256 + 8 * hh;
        bf16x8 wf0[8], wf1[8];
#pragma unroll
        for (int ks = 0; ks < 8; ++ks) wf0[ks] = *(const bf16x8*)(wb + 16 * ks);
#pragma unroll 1
        for (int lp = 0; lp < 4; ++lp) {
            const int lb1 = 2 * lp + 1, lb2 = (2 * lp + 2) & 7;
#pragma unroll
            for (int ks = 0; ks < 8; ++ks) wf1[ks] = *(const bf16x8*)(wb + (size_t)lb1 * 32 * 2048 + 16 * ks);
            __builtin_amdgcn_sched_barrier(0);
            { f32x16 acc = zero16();
#pragma unroll
              for (int ks = 0; ks < 8; ++ks) acc = mfma32(aq[ks], wf0[ks], acc);
#pragma unroll
              for (int r = 0; r < 4; ++r) QA[(w * 8 + r + 4 * hh) * SM_QP + (2 * lp) * 32 + i32] = (bf16_t)f2bf(acc[r]); }
            __builtin_amdgcn_sched_barrier(0);
#pragma unroll
            for (int ks = 0; ks < 8; ++ks) wf0[ks] = *(const bf16x8*)(wb + (size_t)lb2 * 32 * 2048 + 16 * ks);
            __builtin_amdgcn_sched_barrier(0);
            { f32x16 acc = zero16();
#pragma unroll
              for (int ks = 0; ks < 8; ++ks) acc = mfma32(aq[ks], wf1[ks], acc);
#pragma unroll
              for (int r = 0; r < 4; ++r) QA[(w * 8 + r + 4 * hh) * SM_QP + lb1 * 32 + i32] = (bf16_t)f2bf(acc[r]); }
            __builtin_amdgcn_sched_barrier(0);
        }
        { const int q2 = lane >> 3, c8 = (lane & 7) * 8; const float rq = __shfl(rinv, q2);
          const u32x4 v = *(const u32x4*)(WSP(bf16_t, WS_QG) + (size_t)(NP + bs * 8 + q2) * 1536 + w * 192 + 128 + c8); u32x4 o;
          o.x = pk2(bflo(v.x) * rq, bfhi(v.x) * rq); o.y = pk2(bflo(v.y) * rq, bfhi(v.y) * rq); o.z = pk2(bflo(v.z) * rq, bfhi(v.z) * rq); o.w = pk2(bflo(v.w) * rq, bfhi(v.w) * rq);
          *(LAS u32x4*)(QA + (w * 8 + q2) * SM_QP + 256 + c8) = o; }
    }
    f32x16 oacc[2]; oacc[0] = zero16(); oacc[1] = zero16();
    float lsum = 0.f;
    u32x4 afX[8], afY[8];
    const __amdgpu_buffer_rsrc_t wrs = __builtin_amdgcn_make_buffer_rsrc((void*)(F.ws + WS_W8F), 0, 32 * 4 * 2048, 0x00020000);
    z_load(afX, wrs, lane * 32, w * 32768);
    __syncthreads();
#ifdef NO_PF
    for (int tl = 0; tl < 32; tl += 2) {
        if (tl) { smla_load_page(P, lds, PTAB(tl), tid); __syncthreads(); }
        smla_tile<0, false>(F, P, -1, oacc, lsum, afX, afY, wrs);
        smla_load_page(P, lds, PTAB(tl + 1), tid); __syncthreads();
        smla_tile<1, false>(F, P, -1, oacc, lsum, afX, afY, wrs);
    }
#else
    for (int tl = 0; tl < 32; tl += 2) {
        smla_tile<0, false>(F, P, PTAB(tl + 1), oacc, lsum, afX, afY, wrs);
        smla_tile<1, false>(F, P, PTAB(tl + 2), oacc, lsum, afX, afY, wrs);
    }
#endif
    if (half) { smla_load_fresh(F, lds, bs, tid); __syncthreads(); smla_tile<0, true>(F, P, -1, oacc, lsum, afX, afY, wrs); }
    {
        LAS bf16_t* OL = (LAS bf16_t*)(lds + SM_CT);
        int le = tid; asm volatile("" : "+v"(le)); le &= 63;
        const int i32 = le & 31, hh = le >> 5;
        const int rb = w >> 2, lb0 = 2 * (w & 3);
#pragma unroll
        for (int q = 0; q < 2; ++q)
#pragma unroll
            for (int g4 = 0; g4 < 4; ++g4) { u32x2 pw; pw.x = pk2(oacc[q][4 * g4], oacc[q][4 * g4 + 1]); pw.y = pk2(oacc[q][4 * g4 + 2], oacc[q][4 * g4 + 3]);
                *(LAS u32x2*)(OL + (rb * 32 + i32) * 264 + (lb0 + q) * 32 + 8 * g4 + 4 * hh) = pw; }
        LX[w * 64 + le] = lsum;
        __syncthreads();
        const LAS bf16_t* ar = OL + (w * 8 + (i32 & 7)) * 264 + 8 * hh;
        bf16x8 ao[16];
#pragma unroll
        for (int ks = 0; ks < 16; ++ks) ao[ks] = *(const LAS bf16x8*)(ar + 16 * ks);
        float* yp = WSP(float, WS_YPS) + ((size_t)(bs * 2 + half) * 64 + w * 8) * 128;
        const bf16_t* wt0 = WSP(bf16_t, WS_WKV_T) + (size_t)(w * 256 + 128 + i32) * 256 + 8 * hh;
        bf16x8 vf0[16], vf1[16];
#pragma unroll
        for (int ks = 0; ks < 16; ++ks) vf0[ks] = *(const bf16x8*)(wt0 + 16 * ks);
#pragma unroll 1
        for (int np = 0; np < 2; ++np) {
            const int nb1 = 2 * np + 1, nb2 = (2 * np + 2) & 3;
#pragma unroll
            for (int ks = 0; ks < 16; ++ks) vf1[ks] = *(const bf16x8*)(wt0 + (size_t)nb1 * 32 * 256 + 16 * ks);
            __builtin_amdgcn_sched_barrier(0);
            { f32x16 acc = zero16();
#pragma unroll
              for (int ks = 0; ks < 16; ++ks) acc = mfma32(ao[ks], vf0[ks], acc);
#pragma unroll
              for (int r = 0; r < 4; ++r) yp[(size_t)(r + 4 * hh) * 128 + (2 * np) * 32 + i32] = acc[r]; }
            __builtin_amdgcn_sched_barrier(0);
#pragma unroll
            for (int ks = 0; ks < 16; ++ks) vf0[ks] = *(const bf16x8*)(wt0 + (size_t)nb2 * 32 * 256 + 16 * ks);
            __builtin_amdgcn_sched_barrier(0);
            { f32x16 acc = zero16();
#pragma unroll
              for (int ks = 0; ks < 16; ++ks) acc = mfma32(ao[ks], vf1[ks], acc);
#pragma unroll
              for (int r = 0; r < 4; ++r) yp[(size_t)(r + 4 * hh) * 128 + nb1 * 32 + i32] = acc[r]; }
            __builtin_amdgcn_sched_barrier(0);
        }
        if (le < 8) { const int r32 = (w & 3) * 8 + le; float l = 0.f;
#pragma unroll
            for (int tb = 0; tb < 4; ++tb) l += LX[((w >> 2) * 4 + tb) * 64 + r32] + LX[((w >> 2) * 4 + tb) * 64 + 32 + r32];
            WSP(float, WS_LPS)[(size_t)(bs * 2 + half) * 64 + w * 8 + le] = l; }
        __syncthreads();
    }
}

__device__ __forceinline__ void smem_unit(Frame& F, const Params& P, int unit) {
    int tid = F.tid; asm volatile("" : "+v"(tid));
    const int lane = tid & 63, w = F.wave, bs = unit >> 1, hp = unit & 1;
    LAS float* Qs = (LAS float*)F.lds;
    LAS float* Ps = Qs + 2048;
    LAS float* Ls = Ps + 4096;
    LAS float* Xs = Ls + 64;
    { const int i = tid >> 6, hl = (tid >> 5) & 1, c4 = (tid & 31) * 4;
      const u32x2 v = *(const u32x2*)(WSP(bf16_t, WS_QM) + (size_t)(NP + bs * 8 + i) * 512 + (2 * hp + hl) * 128 + c4);
      *(LAS f32x4*)(Qs + (i * 2 + hl) * 128 + c4) = (f32x4){bflo(v.x), bfhi(v.x), bflo(v.y), bfhi(v.y)}; }
    __syncthreads();
    { const int key = tid & 255, hl = tid >> 8, hd = 2 * hp + hl;
      const f32x4* kp = (const f32x4*)(P.in[5] + ((size_t)(bs * MEMT + key) * 4 + hd) * 128);
      float acc[8] = {0.f, 0.f, 0.f, 0.f, 0.f, 0.f, 0.f, 0.f};
#pragma unroll 8
      for (int j4 = 0; j4 < 32; ++j4) { const f32x4 kv = kp[j4];
#pragma unroll
          for (int i = 0; i < 8; ++i) { const f32x4 qv = *(LAS f32x4*)(Qs + (i * 2 + hl) * 128 + 4 * j4); acc[i] += (kv.x * qv.x + kv.y * qv.y) + (kv.z * qv.z + kv.w * qv.w); } }
#pragma unroll
      for (int i = 0; i < 8; ++i) Ps[(hl * 8 + i) * 256 + key] = ex2(acc[i] - WSP(float, WS_MQM)[(NP + bs * 8 + i) * 4 + hd]); }
    __syncthreads();
#pragma unroll
    for (int q = 0; q < 2; ++q) { const int r = 2 * w + q; const LAS float* p = Ps + r * 256 + lane;
        const float s = wave_sum((p[0] + p[64]) + (p[128] + p[192])); if (lane == 0) Ls[r] = s; }
    { const int dv = tid & 127, hl = (tid >> 7) & 1, kh = tid >> 8, hd = 2 * hp + hl;
      const float* vp = P.in[6] + ((size_t)(bs * MEMT + kh * 128) * 4 + hd) * 128 + dv;
      float acc[8] = {0.f, 0.f, 0.f, 0.f, 0.f, 0.f, 0.f, 0.f};
#pragma unroll 4
      for (int k4 = 0; k4 < 32; ++k4) {
          const float v0 = vp[(size_t)(4 * k4) * 512], v1 = vp[(size_t)(4 * k4 + 1) * 512], v2 = vp[(size_t)(4 * k4 + 2) * 512], v3 = vp[(size_t)(4 * k4 + 3) * 512];
#pragma unroll
          for (int i = 0; i < 8; ++i) { const f32x4 pv = *(LAS f32x4*)(Ps + (hl * 8 + i) * 256 + kh * 128 + 4 * k4); acc[i] += (pv.x * v0 + pv.y * v1) + (pv.z * v2 + pv.w * v3); } }
      if (kh == 1) {
#pragma unroll
          for (int i = 0; i < 8; ++i) Xs[i * 256 + hl * 128 + dv] = acc[i]; }
      __syncthreads();
      if (kh == 0) {
#pragma unroll
          for (int i = 0; i < 8; ++i) WSP(bf16_t, WS_YMEM)[(size_t)(NP + bs * 8 + i) * 512 + hd * 128 + dv] = (bf16_t)f2bf((acc[i] + Xs[i * 256 + hl * 128 + dv]) / Ls[hl * 8 + i]); } }
    __syncthreads();
}

__device__ __forceinline__ float silu_(float g) { return g * __builtin_amdgcn_rcpf(1.0f + ex2(-g * LOG2E)); }
__device__ __forceinline__ void unpack8(const u32x4 v, float* f) { f[0] = bflo(v.x); f[1] = bfhi(v.x); f[2] = bflo(v.y); f[3] = bfhi(v.y); f[4] = bflo(v.z); f[5] = bfhi(v.z); f[6] = bflo(v.w); f[7] = bfhi(v.w); }
struct OpRow { u32x4 ys, ym, gs, gm, gl0, gl1, yl0, yl1; f32x4 pa[4], pc[4]; float l0, l1; };
__device__ __forceinline__ void oprep_load(Frame& F, OpRow& r, int row, int lane) {
    const bf16_t* gates = WSP(bf16_t, WS_GATES) + (size_t)row * 2048;
    r.ys = *(const u32x4*)(WSP(bf16_t, WS_YSSM) + (size_t)row * 512 + 8 * lane); r.ym = *(const u32x4*)(WSP(bf16_t, WS_YMEM) + (size_t)row * 512 + 8 * lane);
    r.gs = *(const u32x4*)(gates + 8 * lane); r.gm = *(const u32x4*)(gates + 1536 + 8 * lane); r.gl0 = *(const u32x4*)(gates + 512 + 16 * lane); r.gl1 = *(const u32x4*)(gates + 512 + 16 * lane + 8);
    if (row < NP) { r.yl0 = *(const u32x4*)(WSP(bf16_t, WS_YMLA) + (size_t)row * 1024 + 16 * lane); r.yl1 = *(const u32x4*)(WSP(bf16_t, WS_YMLA) + (size_t)row * 1024 + 16 * lane + 8); }
    else { const int sr = row - NP, bs = sr >> 3, qi = sr & 7, h = lane >> 3, dv0 = (lane & 7) * 16;
        const size_t r0 = (size_t)(bs * 2) * 64 + h * 8 + qi, r1 = r0 + 64;
        r.l0 = WSP(float, WS_LPS)[r0]; r.l1 = WSP(float, WS_LPS)[r1];
        const f32x4* a = (const f32x4*)(WSP(float, WS_YPS) + r0 * 128 + dv0); const f32x4* c = (const f32x4*)(WSP(float, WS_YPS) + r1 * 128 + dv0);
#pragma unroll
        for (int q = 0; q < 4; ++q) { r.pa[q] = a[q]; r.pc[q] = c[q]; } }
}
__device__ __forceinline__ void oprep_finish(Frame& F, const Params& P, const OpRow& r, int row, int lane) {
    bf16_t* orow = WSP(bf16_t, WS_O) + (size_t)row * 2048;
    const float* g_ssm = P.in[33]; const float* g_mla = P.in[34]; const float* g_mem = P.in[35];
#pragma unroll
    for (int part = 0; part < 2; ++part) {
        const float* gn = (part == 0 ? g_ssm : g_mem) + 8 * lane;
        const int oc = (part == 0 ? 0 : 1536) + 8 * lane;
        float y[8], gt[8]; unpack8(part == 0 ? r.ys : r.ym, y); unpack8(part == 0 ? r.gs : r.gm, gt);
        float s = 0.f;
#pragma unroll
        for (int e = 0; e < 8; ++e) s += y[e] * y[e];
        const float rinv = 1.0f / sqrtf(wave_sum(s) * (1.f / 512.f) + EPS);
        float o[8];
#pragma unroll
        for (int e = 0; e < 8; ++e) o[e] = y[e] * rinv * gn[e] * silu_(gt[e]);
        u32x4 wv; wv.x = pk2(o[0], o[1]); wv.y = pk2(o[2], o[3]); wv.z = pk2(o[4], o[5]); wv.w = pk2(o[6], o[7]);
        *(u32x4*)(orow + oc) = wv;
    }
    {
        float y[16];
        if (row < NP) { unpack8(r.yl0, &y[0]); unpack8(r.yl1, &y[8]); }
        else { const float inv = 1.0f / (r.l0 + r.l1);
#pragma unroll
            for (int q = 0; q < 4; ++q) { const f32x4 v = (r.pa[q] + r.pc[q]) * inv; y[4 * q] = v.x; y[4 * q + 1] = v.y; y[4 * q + 2] = v.z; y[4 * q + 3] = v.w; } }
        float gt[16]; unpack8(r.gl0, &gt[0]); unpack8(r.gl1, &gt[8]);
        float s = 0.f;
#pragma unroll
        for (int e = 0; e < 16; ++e) s += y[e] * y[e];
        const float rinv = 1.0f / sqrtf(wave_sum(s) * (1.f / 1024.f) + EPS);
        const float* gn = g_mla + 16 * lane;
        float o[16];
#pragma unroll
        for (int e = 0; e < 16; ++e) o[e] = y[e] * rinv * gn[e] * silu_(gt[e]);
        u32x4 w0, w1; w0.x = pk2(o[0], o[1]); w0.y = pk2(o[2], o[3]); w0.z = pk2(o[4], o[5]); w0.w = pk2(o[6], o[7]);
        w1.x = pk2(o[8], o[9]); w1.y = pk2(o[10], o[11]); w1.z = pk2(o[12], o[13]); w1.w = pk2(o[14], o[15]);
        *(u32x4*)(orow + 512 + 16 * lane) = w0; *(u32x4*)(orow + 512 + 16 * lane + 8) = w1;
    }
}
__device__ __forceinline__ void oprep_rows(Frame& F, const Params& P) {
    int tid = F.tid; asm volatile("" : "+v"(tid));
    const int gw = F.bid * 8 + F.wave, NGW = F.G * 8, lane = tid & 63;
    for (int row = gw; row < NR; row += 2 * NGW) {
        const int row2 = row + NGW; const bool has2 = row2 < NR;
        OpRow ra, rb;
        oprep_load(F, ra, row, lane);
        if (has2) oprep_load(F, rb, row2, lane);
        __builtin_amdgcn_sched_barrier(0);
        oprep_finish(F, P, ra, row, lane);
        if (has2) oprep_finish(F, P, rb, row2, lane);
    }
}


struct SchedP1 {
    pg8::StaticOrder a, b; int G, c;
    __device__ void init(int G_, int c_) { G = G_; c = c_; a.init(27 * 256, 4096, G_, c_); b.init(9 * 256, 2048, 1 << 20, 0); }
    __device__ bool next(int i, pg8::Unit& u) const {
        const int L = i * G + c;
        if (L < 432) return a.next(i, u);
        if (L >= 504) return false;
        pg8::StaticOrder t = b; t.c = L - 432; const bool ok = t.next(0, u); u.pm += 27; return ok;
    }
    __device__ __forceinline__ void a_ready(const pg8::Unit&) const {}
    __device__ __forceinline__ void done(const pg8::Unit&) const {}
};
struct SchedGates {
    pg8::StaticOrder b;
    __device__ void init(int c_) { b.init(9 * 256, 2048, 1 << 20, c_); }
    __device__ bool next(int i, pg8::Unit& u) const { if (i > 0) return false; const bool ok = b.next(0, u); u.pm += 27; u.pn += 8; return ok; }
    __device__ __forceinline__ void a_ready(const pg8::Unit&) const {}
    __device__ __forceinline__ void done(const pg8::Unit&) const {}
};
#ifndef PH
#define PH 4095
#endif
#ifndef REP_SMLA
#define REP_SMLA 1
#endif
#ifndef REP_ATT
#define REP_ATT 1
#endif
#ifndef REP_P1
#define REP_P1 1
#endif
#ifndef REP_P5
#define REP_P5 1
#endif
#ifndef REP_P0
#define REP_P0 1
#endif
#ifndef REP_P2
#define REP_P2 1
#endif
#ifndef REP_P3R
#define REP_P3R 1
#endif
#ifndef REP_P4
#define REP_P4 1
#endif
#ifndef REP_MEMP
#define REP_MEMP 1
#endif
#ifndef REP_SSM1
#define REP_SSM1 1
#endif
#ifndef REP_SMEM
#define REP_SMEM 1
#endif
__global__ void __launch_bounds__(512, 2) hymba_fwd(Params P) {
    extern __shared__ __attribute__((aligned(16))) unsigned char lds_raw[];
    Frame F;
    F.lds = (LAS unsigned char*)lds_raw; F.ws = P.ws; F.out = P.out;
    F.tid = threadIdx.x; F.lane = F.tid & 63; F.wave = __builtin_amdgcn_readfirstlane(F.tid >> 6); F.G = gridDim.x; F.bid = blockIdx.x;
    volatile LAS unsigned* MISC = (volatile LAS unsigned*)(F.lds + LDS_MISC);
    if (F.tid < 16) MISC[F.tid] = 0u;
    __syncthreads();
    XcdBarrier bar = xcd_barrier_post((unsigned*)(P.ws + WS_CTL), MISC);

#if PH & 1
    for (int rep_ = 0; rep_ < REP_P0; ++rep_) { if (rep_) __syncthreads(); p0_prologue(F, P); }
#endif
    xcd_barrier(bar);

#if PH & 2
    for (int rep_ = 0; rep_ < REP_P1; ++rep_) {
        if (rep_) __syncthreads();
        pg8::Gemm g{WSP(bf16_t, WS_XN), WSP(bf16_t, WS_WIN_T), NR, NIN, 2048}; SchedP1 S; S.init(F.G, F.bid);
        EpiInProj E{WSP(float, WS_UF), WSP(bf16_t, WS_CQ), WSP(float, WS_SSQ_CQ), WSP(float, WS_CKVF), WSP(bf16_t, WS_CKVB), WSP(float, WS_SSQ_CKV), WSP(bf16_t, WS_QMR), WSP(float, WS_SSQ_QM), WSP(float, WS_KRF), WSP(bf16_t, WS_GATES)};
        pg8::gemm_phase<EpiInProj, SchedP1, false>(F.lds, g, S, E, nullptr);
        __syncthreads();
        pg8::Gemm g2{WSP(bf16_t, WS_MEMN), WSP(bf16_t, WS_MEMKV_T), 512, 1024, 2048}; pg8::StaticOrder S2; S2.init(512, 1024, F.G, F.G - 1 - F.bid);
        EpiMemKV E2{WSP(float, WS_MKRAW), WSP(float, WS_SSQ_MK), F.out + O_MV, WSP(bf16_t, WS_VTM)};
        pg8::gemm_phase<EpiMemKV, pg8::StaticOrder, false>(F.lds, g2, S2, E2, nullptr);
    }
#endif
    xcd_barrier(bar);

    for (int rep_ = 0; rep_ < REP_P2; ++rep_) {
        if (rep_) __syncthreads();
#if PH & 4
        const bool gw = (F.bid >= 184);
        {
            pg8::Gemm gg{WSP(bf16_t, WS_XN), WSP(bf16_t, WS_WIN_T), NR, NIN, 2048}; SchedGates SG; SG.init(gw ? F.bid - 184 : (1 << 20));
            EpiInProj EG{WSP(float, WS_UF), WSP(bf16_t, WS_CQ), WSP(float, WS_SSQ_CQ), WSP(float, WS_CKVF), WSP(bf16_t, WS_CKVB), WSP(float, WS_SSQ_CKV), WSP(bf16_t, WS_QMR), WSP(float, WS_SSQ_QM), WSP(float, WS_KRF), WSP(bf16_t, WS_GATES)};
            pg8::gemm_phase<EpiInProj, SchedGates, false>(F.lds, gg, SG, EG, nullptr);
            __syncthreads();
        }
        const bool sw = (F.bid >= 96 && F.bid < 128);
        const int jq = (gw || sw) ? (1 << 20) : (F.bid < 96 ? F.bid : F.bid - 32);
        pg8::Gemm g{WSP(bf16_t, WS_CQ), WSP(bf16_t, WS_WUQ_T), NR, 2048, 512}; pg8::StaticOrder S; S.init(NR, 2048, 152, jq);
        EpiQ E{WSP(float, WS_SSQ_CQ), WSP(float, WS_QCG), WSP(bf16_t, WS_QG), WSP(float, WS_SSQ_Q)};
        pg8::gemm_phase<EpiQ, pg8::StaticOrder, false>(F.lds, g, S, E, nullptr);
        __syncthreads();
        pg8::Gemm g2{WSP(bf16_t, WS_CKVB), WSP(bf16_t, WS_WKV_TG), NP, 2048, 256}; pg8::StaticOrder S2; S2.init(NP, 2048, 152, (gw || sw) ? (1 << 20) : 151 - jq);
        EpiKV E2{WSP(float, WS_SSQ_CKV), WSP(bf16_t, WS_KNB), WSP(float, WS_SSQ_KN), WSP(bf16_t, WS_VT)};
        pg8::gemm_phase<EpiKV, pg8::StaticOrder, false>(F.lds, g2, S2, E2, nullptr);
        __syncthreads();
#endif
#if PH & 8
        p2a_rows(F, P);
#endif
#if PH & 16
        for (int u = F.bid; u < 256; u += F.G) ssm_unit<0>(F, P, u);
#ifndef REP_SSM2
#define REP_SSM2 1
#endif
        for (int r2_ = 0; r2_ < REP_SSM2; ++r2_)
        if (F.bid >= 96 && F.bid < 128) ssm_unit<2>(F, P, F.bid - 96);
#endif
    }
    xcd_barrier(bar);

    {
#if (PH & 96) == 96
#ifndef STG_SH
#define STG_SH 3
#endif
        #ifdef STG_Q
        const bool smf_ = (STG_Q == 1) ? (((F.bid >> 3) & 3) == 0) : (((F.bid >> 3) & 3) != 3);
#else
        const bool smf_ = ((F.bid >> STG_SH) & 1) == 0;
#endif
        if (smf_) { for (int u = F.bid; u < 256; u += F.G) smla_unit(F, P, u); }
        for (int v = F.bid; v < 256; v += F.G) { const int u = (F.G == 256) ? ((v & 7) << 5) | (v >> 3) : v; const int b = u >> 7, h = (u >> 4) & 7, i = u & 15; attn_qblock<true>(F, b, h, 31 - i); attn_qblock<true>(F, b, h, i, true); }
        if (!smf_) { for (int u = F.bid; u < 256; u += F.G) smla_unit(F, P, u); }
#endif
#if PH & 128
        for (int r2_ = 0; r2_ < REP_MEMP; ++r2_) {
            if (F.G == 256) { if ((F.bid & 1) == 0) { for (int q = 0; q < 2; ++q) { const int u = F.bid + q; attn_qblock<false>(F, u >> 7, (u >> 5) & 3, u & 31); } } }
            else for (int u = F.bid; u < 256; u += F.G) attn_qblock<false>(F, u >> 7, (u >> 5) & 3, u & 31);
        }
#endif
#if PH & 256
        for (int r2_ = 0; r2_ < REP_SSM1; ++r2_)
        for (int u = F.bid; u < 256; u += F.G) ssm_unit<1>(F, P, u);
#endif
#if PH & 512
        for (int r2_ = 0; r2_ < REP_SMEM; ++r2_) {
            if (F.G == 256) { const int c = F.bid & 127; if (c < 96) smem_unit(F, P, F.bid); if (c < 32) smem_unit(F, P, F.bid + 96); }
            else for (int u = F.bid; u < 256; u += F.G) smem_unit(F, P, u);
        }
#endif
    }
    xcd_barrier(bar);

#if PH & 1024
    for (int rep_ = 0; rep_ < REP_P4; ++rep_) oprep_rows(F, P);
#endif
    xcd_barrier(bar);

#if PH & 2048
    {
        pg8::Gemm g{WSP(bf16_t, WS_O), WSP(bf16_t, WS_WOUT_T), NP, 2048, 2048}; pg8::StaticOrder S; S.init(NP, 2048, F.G, F.bid);
        EpiMerge E{P.in[0], P.in[1], F.out + O_Y};
        pg8::gemm_phase<EpiMerge, pg8::StaticOrder, false>(F.lds, g, S, E, nullptr);
        __syncthreads();
        const int tile = F.bid & 31, sl = F.bid >> 5;
        pg8::Gemm g2{WSP(bf16_t, WS_O) + (size_t)NP * 2048 + sl * 256, WSP(bf16_t, WS_WOUT_T) + sl * 256, NS, 2048, 256, 2048}; SchedOne S2{tile >> 3, tile & 7, F.bid < 256};
        EpiPart E2{WSP(float, WS_PART) + (size_t)(sl & 7) * NS * 2048};
        pg8::gemm_phase<EpiPart, SchedOne, false>(F.lds, g2, S2, E2, nullptr);
    }
    xcd_barrier(bar);
    {
        int tid = F.tid; asm volatile("" : "+v"(tid));
        const f32x4* xs = (const f32x4*)P.in[1]; f32x4* ys = (f32x4*)(F.out + O_Y + (size_t)NP * 2048); const f32x4* pt = WSP(f32x4, WS_PART);
        for (int i = F.bid * 512 + tid; i < NS * 2048 / 4; i += F.G * 512) {
            f32x4 v[8];
#pragma unroll
            for (int s = 0; s < 8; ++s) v[s] = pt[(size_t)s * (NS * 2048 / 4) + i];
            ys[i] = xs[i] + ((v[0] + v[1]) + (v[2] + v[3])) + ((v[4] + v[5]) + (v[6] + v[7]));
        }
    }
#endif
}

extern "C" void kernel_launch(void* const* d_in, const int* in_sizes, int n_in, void* d_out, int out_size, void* d_ws, size_t ws_size, hipStream_t stream) {
    static int grid = 0;
    if (grid == 0) {
        if (n_in != 37 || ws_size < WS_END) { fprintf(stderr, "kernel_launch: unexpected problem (n_in %d, ws %zu)\n", n_in, ws_size); grid = -1; return; }
        int dev = 0, cus = 0, per_cu = 0;
        if (hipGetDevice(&dev) != hipSuccess || hipDeviceGetAttribute(&cus, hipDeviceAttributeMultiprocessorCount, dev) != hipSuccess) { grid = -1; return; }
        if (hipFuncSetAttribute((const void*)hymba_fwd, hipFuncAttributeMaxDynamicSharedMemorySize, LDS_TOTAL) != hipSuccess) { fprintf(stderr, "kernel_launch: hipFuncSetAttribute failed\n"); grid = -1; return; }
        if (hipOccupancyMaxActiveBlocksPerMultiprocessor(&per_cu, (const void*)hymba_fwd, 512, LDS_TOTAL) != hipSuccess || per_cu < 1)
            fprintf(stderr, "kernel_launch: note: occupancy query reports %d workgroups per CU\n", per_cu);
        (void)hipGetLastError();
        grid = cus;
    }
    if (grid < 0) return;
    (void)in_sizes; (void)out_size;
    hipMemsetAsync((char*)d_ws + WS_CTL, 0, 16384, stream);
    Params p{};
    for (int i = 0; i < 37; ++i) p.in[i] = (const float*)d_in[i];
    p.out = (float*)d_out; p.ws = (unsigned char*)d_ws;
    hipLaunchKernelGGL(hymba_fwd, dim3(grid), dim3(512), LDS_TOTAL, stream, p);
}
```

```cpp
#include <hip/hip_runtime.h>
#include <cstdio>
#include <cstdint>
namespace pg8 {
#define PG8_LAS __attribute__((address_space(3)))
typedef unsigned short bf16_t;
typedef short bf16x8 __attribute__((ext_vector_type(8)));
typedef float f32x4 __attribute__((ext_vector_type(4)));
typedef unsigned u32x4 __attribute__((ext_vector_type(4)));
constexpr int BM = 256, BK = 64, HALF = 128, HTB = HALF * BK * 2  , STAGE_BYTES = 8 * HTB, NXCD = 8, WGM = 8;

__host__ __device__ __forceinline__ int lds_byte(int r, int c) { const int st = (r >> 4) * 2 + (c >> 5), rr = r & 15, cc = c & 31, ob = rr * 64 + cc * 2; return st * 1024 + (ob ^ (((ob >> 9) & 1) << 5)); }
__host__ __device__ __forceinline__ void stage_rc(int b, int& R, int& C) { const int st = b / 1024, sb = b % 1024, swz = sb ^ (((sb >> 9) & 1) << 5); R = (st >> 1) * 16 + swz / 64; C = (st & 1) * 32 + (swz % 64) / 2; }
__host__ __device__ __forceinline__ int perm32(int rho) { const int n = rho >> 4, i = rho & 15; return 8 * (i >> 2) + 4 * n + (i & 3); }

struct Unit { int pm, pn; };
struct Gemm { const bf16_t* A; const bf16_t* Bt; int M, N, K; int ld = 0; };

struct StaticOrder {
    int nM, nN, nwg, G, c;
    __host__ __device__ void init(int M, int N, int G_, int c_) { nM = M / BM; nN = N / BM; nwg = nM * nN; G = G_; c = c_; }
    __host__ __device__ bool next(int i, Unit& u) const {
        const long L = (long)i * G + c; if (L >= nwg) return false;
        int wgid = (int)L; { const int q = nwg / NXCD, r = nwg % NXCD, xcd = wgid % NXCD, off = wgid / NXCD; wgid = (xcd < r ? xcd * (q + 1) : r * (q + 1) + (xcd - r) * q) + off; }
        const int nig = WGM * nN, gid = wgid / nig, fm = gid * WGM, gsz = (nM - fm) < WGM ? (nM - fm) : WGM;
        u.pm = fm + ((wgid % nig) % gsz); u.pn = (wgid % nig) / gsz; return true;
    }
    __device__ __forceinline__ void a_ready(const Unit&) const {}
    __device__ __forceinline__ void done(const Unit&) const {}
};
__device__ __forceinline__ unsigned cvt_pk_bf16(float lo, float hi) { unsigned r; asm volatile("v_cvt_pk_bf16_f32 %0, %1, %2" : "=v"(r) : "v"(lo), "v"(hi)); return r; }
template <class Epi, class Sched, bool STAMP = false>
__device__ __forceinline__ void gemm_phase(PG8_LAS unsigned char* lds, const Gemm g, const Sched& S, const Epi& E, unsigned long long* stamps) {
    int tid_l = threadIdx.x; asm volatile("" : "+v"(tid_l));
    const int tid = tid_l, wid = __builtin_amdgcn_readfirstlane(tid >> 6), lane = tid & 63, wr = wid >> 2, wc = wid & 3, fr = lane & 15, fq = lane >> 4;
    const int K = g.K, nt = K / BK, LD = g.ld ? g.ld : g.K;
    int ts_lo = 0, ts_hi = 0, nts = 0; const unsigned long long rt_entry = STAMP ? (unsigned long long)wall_clock64() : 0ull;
#define PG8_STAMP() do { if (STAMP && wid == 0 && nts < 64) { const unsigned long long _c = (unsigned long long)clock64(); \
        ts_lo = (lane == nts) ? (int)(unsigned)_c : ts_lo; ts_hi = (lane == nts) ? (int)(unsigned)(_c >> 32) : ts_hi; ++nts; } } while (0)
    PG8_STAMP();
    unsigned voffA[2], voffB[2];
#pragma unroll
    for (int i = 0; i < 2; ++i) { int R, C; stage_rc(tid * 16 + i * 8192, R, C); const int Rb = Epi::PERM ? ((R & ~31) + perm32(R & 31)) : R;
        voffA[i] = (unsigned)(R * LD + C) * 2u; voffB[i] = (unsigned)(Rb * LD + C) * 2u; }
    const size_t kstep = (size_t)(BK * 2);
    const size_t hstep = (size_t)HALF * LD * 2;
    const size_t tstep = 2 * hstep;
    const unsigned ldsw = (unsigned)wid * 1024u;
    const int aoff = lds_byte(wr * 64 + fr, fq * 8), boff = lds_byte(wc * 32 + fr, fq * 8);
#define PG8_SA(b, h) (((b) * 2 + (h)) * HTB)
#define PG8_SB(b, h) ((4 + (b) * 2 + (h)) * HTB)
#define PG8_STAGE(bufoff, gbase, voff) do { _Pragma("unroll") for (int _i = 0; _i < 2; ++_i) \
        __builtin_amdgcn_global_load_lds((const unsigned*)((const char*)(gbase) + (voff)[_i]), (PG8_LAS unsigned*)(lds + (bufoff) + ldsw + _i * 8192), 16, 0, 0); } while (0)
#define PG8_LDA(dst, b, h) do { _Pragma("unroll") for (int m = 0; m < 4; ++m) _Pragma("unroll") for (int k = 0; k < 2; ++k) dst[m][k] = *(const PG8_LAS bf16x8*)(lds + PG8_SA(b, h) + aoff + m * 2048 + k * 1024); } while (0)
#define PG8_LDB(dst, b, h) do { _Pragma("unroll") for (int n = 0; n < 2; ++n) _Pragma("unroll") for (int k = 0; k < 2; ++k) dst[n][k] = *(const PG8_LAS bf16x8*)(lds + PG8_SB(b, h) + boff + n * 2048 + k * 1024); } while (0)
#define PG8_MMA(ai, bj, At, Bt) do { __builtin_amdgcn_s_setprio(1); _Pragma("unroll") for (int m = 0; m < 4; ++m) _Pragma("unroll") for (int n = 0; n < 2; ++n) _Pragma("unroll") for (int k = 0; k < 2; ++k) \
        acc[ai][bj][m][n] = __builtin_amdgcn_mfma_f32_16x16x32_bf16(Bt[n][k], At[m][k], acc[ai][bj][m][n], 0, 0, 0); __builtin_amdgcn_s_setprio(0); } while (0)
#define PG8_WAIT_V(n) asm volatile("s_waitcnt vmcnt(" #n ")" ::: "memory")
#define PG8_WAIT_L(n) asm volatile("s_waitcnt lgkmcnt(" #n ")" ::: "memory")
#define PG8_BAR __builtin_amdgcn_s_barrier()
#define PG8_SCHED __builtin_amdgcn_sched_barrier(0)
    Unit cur, nxt; int ui = 0;
    if (!S.next(0, cur)) return;
    f32x4 acc[2][2][4][2];
#pragma unroll
    for (int a = 0; a < 2; ++a)
#pragma unroll
        for (int b = 0; b < 2; ++b)
#pragma unroll
            for (int m = 0; m < 4; ++m)
#pragma unroll
                for (int n = 0; n < 2; ++n) acc[a][b][m][n] = (f32x4){0.f, 0.f, 0.f, 0.f};
    bf16x8 At[4][2], B0[2][2], B1[2][2];
    const char* cA = (const char*)g.A + (size_t)cur.pm * tstep; const char* cB = (const char*)g.Bt + (size_t)cur.pn * tstep;
    S.a_ready(cur);
    PG8_STAGE(PG8_SB(0, 0), cB, voffB); PG8_STAGE(PG8_SA(0, 0), cA, voffA); PG8_STAGE(PG8_SB(0, 1), cB + hstep, voffB); PG8_STAGE(PG8_SA(0, 1), cA + hstep, voffA);
    if (wr == 1) PG8_BAR;
    PG8_WAIT_V(4); PG8_BAR;
    PG8_STAGE(PG8_SB(1, 0), cB + kstep, voffB); PG8_STAGE(PG8_SA(1, 0), cA + kstep, voffA); PG8_STAGE(PG8_SB(1, 1), cB + hstep + kstep, voffB);
    PG8_WAIT_V(6); PG8_BAR;
    PG8_STAMP();
    for (;;) {
        const bool has_next = S.next(ui + 1, nxt);
        const char* nA = has_next ? (const char*)g.A + (size_t)nxt.pm * tstep : cA; const char* nB = has_next ? (const char*)g.Bt + (size_t)nxt.pn * tstep : cB;
        for (int t = 0; t < nt; t += 2) {
            const bool last = (t == nt - 2);
            const char* a1 = cA + (size_t)(t + 1) * kstep;
            const char* a2 = last ? nA : cA + (size_t)(t + 2) * kstep; const char* b2 = last ? nB : cB + (size_t)(t + 2) * kstep;
            const char* a3 = a2 + kstep; const char* b3 = b2 + kstep;
            if (last && has_next) S.a_ready(nxt);
            PG8_LDB(B0, 0, 0); PG8_SCHED; PG8_LDA(At, 0, 0); PG8_STAGE(PG8_SA(1, 1), a1 + hstep, voffA);
            PG8_WAIT_L(8); PG8_BAR; PG8_WAIT_L(0); PG8_MMA(0, 0, At, B0); PG8_BAR; PG8_SCHED;
            PG8_LDB(B1, 0, 1); PG8_STAGE(PG8_SB(0, 0), b2, voffB);
            PG8_BAR; PG8_WAIT_L(0); PG8_MMA(0, 1, At, B1); PG8_BAR;
            PG8_LDA(At, 0, 1); PG8_STAGE(PG8_SA(0, 0), a2, voffA);
            PG8_BAR; PG8_WAIT_L(0); PG8_MMA(1, 0, At, B0); PG8_BAR; PG8_SCHED;
            PG8_STAGE(PG8_SB(0, 1), b2 + hstep, voffB);
            PG8_WAIT_V(6); PG8_BAR; PG8_MMA(1, 1, At, B1); PG8_BAR;
            PG8_LDB(B0, 1, 0); PG8_SCHED; PG8_LDA(At, 1, 0); PG8_STAGE(PG8_SA(0, 1), a2 + hstep, voffA);
            PG8_WAIT_L(8); PG8_BAR; PG8_WAIT_L(0); PG8_MMA(0, 0, At, B0); PG8_BAR; PG8_SCHED;
            PG8_LDB(B1, 1, 1); PG8_STAGE(PG8_SB(1, 0), b3, voffB);
            PG8_BAR; PG8_WAIT_L(0); PG8_MMA(0, 1, At, B1); PG8_BAR;
            PG8_LDA(At, 1, 1); PG8_STAGE(PG8_SA(1, 0), a3, voffA);
            PG8_BAR; PG8_WAIT_L(0); PG8_MMA(1, 0, At, B0); PG8_BAR; PG8_SCHED;
            PG8_STAGE(PG8_SB(1, 1), b3 + hstep, voffB);
            PG8_WAIT_V(6); PG8_BAR; PG8_MMA(1, 1, At, B1); PG8_BAR;
        }
        PG8_STAMP();
        if constexpr (!Epi::AFTER_DRAIN) { E(acc, cur, wr, wc, fr, fq); S.done(cur); }
        PG8_STAMP();
        if (!has_next) break;
#pragma unroll
        for (int a = 0; a < 2; ++a)
#pragma unroll
            for (int b = 0; b < 2; ++b)
#pragma unroll
                for (int m = 0; m < 4; ++m)
#pragma unroll
                    for (int n = 0; n < 2; ++n) acc[a][b][m][n] = (f32x4){0.f, 0.f, 0.f, 0.f};
        cur = nxt; cA = nA; cB = nB; ++ui;
    }
    PG8_WAIT_V(0);
    if (wr == 0) PG8_BAR;
    PG8_BAR;
    if constexpr (Epi::AFTER_DRAIN) { E.fused(acc, cur, wr, wc, fr, fq, lds, wid, lane); S.done(cur); }
    PG8_STAMP();
    if (STAMP && wid == 0) { stamps[lane] = lane < nts ? (((unsigned long long)(unsigned)ts_hi << 32) | (unsigned)ts_lo) : 0ull;
        if (lane == 62) stamps[62] = rt_entry; if (lane == 63) stamps[63] = (unsigned long long)wall_clock64(); }
#undef PG8_STAMP
#undef PG8_SA
#undef PG8_SB
#undef PG8_STAGE
#undef PG8_LDA
#undef PG8_LDB
#undef PG8_MMA
#undef PG8_WAIT_V
#undef PG8_WAIT_L
#undef PG8_BAR
#undef PG8_SCHED
}
}

#define GAS __attribute__((address_space(1)))
#define LAS __attribute__((address_space(3)))
typedef unsigned short bf16_t;
typedef short bf16x8 __attribute__((ext_vector_type(8)));
typedef short s16x4 __attribute__((ext_vector_type(4)));
typedef float f32x4 __attribute__((ext_vector_type(4)));
typedef float f32x2 __attribute__((ext_vector_type(2)));
typedef float f32x16 __attribute__((ext_vector_type(16)));
typedef unsigned u32x4 __attribute__((ext_vector_type(4)));
typedef unsigned u32x2 __attribute__((ext_vector_type(2)));

constexpr int D = 2048, SEQ = 4096, NB = 2, NP = NB * SEQ  , NSB = 128  , NS = NSB * 8  , NR = NP + NS  ;
constexpr int NIN = 4096;
constexpr int PAST = 8192, PAGE = 128, NPAGES = 64;
constexpr int MEMT = 256;
constexpr float EPS = 1e-6f;
constexpr float LOG2E = 1.4426950408889634f;
constexpr size_t O_Y = 0, O_CKV_P = 18874368, O_KR_P = 20971520, O_CKV_S = 21495808, O_KR_S = 21757952, O_MK = 21823488, O_MV = 22085632,
                 O_SRE_P = 22347776, O_SIM_P = 22351872, O_SRE_S = 22355968, O_SIM_S = 22618112;

constexpr size_t al256(size_t x) { return (x + 255) & ~(size_t)255; }
constexpr size_t WS_CTL = 0, CTL_BYTES = 1u << 20;
constexpr size_t WS_WIN_T   = WS_CTL + CTL_BYTES;
constexpr size_t WS_WUQ_T   = WS_WIN_T + (size_t)4096 * 2048 * 2;
constexpr size_t WS_WKV_TG  = WS_WUQ_T + (size_t)2048 * 512 * 2;
constexpr size_t WS_WKV_T   = WS_WKV_TG + (size_t)2048 * 256 * 2;
constexpr size_t WS_WKV_B   = WS_WKV_T + (size_t)2048 * 256 * 2;
constexpr size_t WS_WF      = WS_WKV_B + (size_t)256 * 2048 * 2;
constexpr size_t WS_W8F     = WS_WF + (size_t)32 * 16 * 1024;
constexpr size_t WS_MEMKV_T = WS_W8F + (size_t)32 * 4 * 2048;
constexpr size_t WS_WOUT_T  = WS_MEMKV_T + (size_t)1024 * 2048 * 2;
constexpr size_t WS_GLUF    = WS_WOUT_T + (size_t)2048 * 2048 * 2;
constexpr size_t WS_ABAR    = WS_GLUF + (size_t)16 * 32 * 1024;
constexpr size_t WS_ABARL   = WS_ABAR + 32 * 64 * 8;
constexpr size_t WS_BBAR    = WS_ABARL + 32 * 64 * 8;
constexpr size_t WS_CSTB    = WS_BBAR + (size_t)32 * 64 * 16 * 8;
constexpr size_t WS_BBST    = WS_CSTB + (size_t)32 * 32 * 128 * 2;
constexpr size_t WS_QCG     = WS_BBST + (size_t)32 * 128 * 16 * 2;
constexpr size_t WS_XN      = WS_QCG + 1024;
constexpr size_t WS_MEMN    = WS_XN + (size_t)NR * 2048 * 2;
constexpr size_t WS_UF      = WS_MEMN + (size_t)512 * 2048 * 2;
constexpr size_t WS_CQ      = WS_UF + (size_t)NR * 512 * 4;
constexpr size_t WS_SSQ_CQ  = WS_CQ + (size_t)NR * 512 * 2;
constexpr size_t WS_CKVF    = WS_SSQ_CQ + (size_t)NR * 8 * 4;
constexpr size_t WS_CKVB    = WS_CKVF + (size_t)NR * 256 * 4;
constexpr size_t WS_SSQ_CKV = WS_CKVB + (size_t)NR * 256 * 2;
constexpr size_t WS_QMR     = WS_SSQ_CKV + (size_t)NR * 4 * 4;
constexpr size_t WS_SSQ_QM  = WS_QMR + (size_t)NR * 512 * 2;
constexpr size_t WS_KRF     = WS_SSQ_QM + (size_t)NR * 16 * 4;
constexpr size_t WS_GATES   = WS_KRF + (size_t)NR * 64 * 4;
constexpr size_t WS_MKRAW   = WS_GATES + (size_t)NR * 2048 * 2;
constexpr size_t WS_SSQ_MK  = WS_MKRAW + (size_t)512 * 512 * 4;
constexpr size_t WS_VTM     = WS_SSQ_MK + (size_t)512 * 16 * 4;
constexpr size_t WS_MKB     = WS_VTM + (size_t)2 * 4 * 128 * 256 * 2;
constexpr size_t WS_CKVS    = WS_MKB + (size_t)2 * 4 * 256 * 128 * 2;
constexpr size_t WS_KRB     = WS_CKVS + (size_t)1024 * 256 * 2;
constexpr size_t WS_SSQ_KR  = WS_KRB + (size_t)NR * 64 * 2;
constexpr size_t WS_QM      = WS_SSQ_KR + (size_t)NR * 4;
constexpr size_t WS_MQM     = WS_QM + (size_t)NR * 512 * 2;
constexpr size_t WS_QG      = WS_MQM + (size_t)NR * 4 * 4;
constexpr size_t WS_SSQ_Q   = WS_QG + (size_t)NR * 1536 * 2;
constexpr size_t WS_KNB     = WS_SSQ_Q + (size_t)NR * 64 * 4;
constexpr size_t WS_SSQ_KN  = WS_KNB + (size_t)2 * 8 * 4096 * 128 * 2;
constexpr size_t WS_VT      = WS_SSQ_KN + (size_t)NP * 32 * 4;
constexpr size_t WS_SCH     = WS_VT + (size_t)2 * 8 * 128 * 4096 * 2;
constexpr size_t WS_YSSM    = WS_SCH + (size_t)2 * 128 * 32 * 64 * 8;
constexpr size_t WS_YMLA    = WS_YSSM + (size_t)NR * 512 * 2;
constexpr size_t WS_YMEM    = WS_YMLA + (size_t)NP * 1024 * 2;
constexpr size_t WS_YPS     = WS_YMEM + (size_t)NR * 512 * 2;
constexpr size_t WS_LPS     = WS_YPS + (size_t)128 * 2 * 64 * 128 * 4;
constexpr size_t WS_O       = WS_LPS + (size_t)128 * 2 * 64 * 4;
constexpr size_t WS_PART    = WS_O + (size_t)NR * 2048 * 2;
constexpr size_t WS_END     = WS_PART + (size_t)8 * 1024 * 2048 * 4;
static_assert(WS_END < ((size_t)1 << 30), "workspace map");

constexpr int LDS_TOTAL = 163840 - 256;
constexpr int LDS_MISC = LDS_TOTAL - 64;

__device__ __forceinline__ unsigned f2bf(float f) { unsigned u = __builtin_bit_cast(unsigned, f); return (u + 0x7fffu + ((u >> 16) & 1u)) >> 16; }
__device__ __forceinline__ unsigned pk2(float lo, float hi) { unsigned r; asm volatile("v_cvt_pk_bf16_f32 %0, %1, %2" : "=v"(r) : "v"(lo), "v"(hi)); return r; }
__device__ __forceinline__ float bf2f(unsigned short b) { return __builtin_bit_cast(float, ((unsigned)b) << 16); }
__device__ __forceinline__ float bflo(unsigned w) { return __builtin_bit_cast(float, w << 16); }
__device__ __forceinline__ float bfhi(unsigned w) { return __builtin_bit_cast(float, w & 0xffff0000u); }
__device__ __forceinline__ float wave_sum(float v) {
#pragma unroll
    for (int o = 1; o < 64; o <<= 1) v += __shfl_xor(v, o);
    return v;
}
__device__ __forceinline__ float ex2(float x) { return __builtin_amdgcn_exp2f(x); }
#define LDS_WAIT() asm volatile("s_waitcnt lgkmcnt(0)" ::: "memory")
__device__ __forceinline__ f32x16 mfma32(bf16x8 a, bf16x8 b, f32x16 c) { return __builtin_amdgcn_mfma_f32_32x32x16_bf16(a, b, c, 0, 0, 0); }
__device__ __forceinline__ f32x16 zero16() { f32x16 z;
#pragma unroll
    for (int i = 0; i < 16; ++i) z[i] = 0.f; return z; }
__device__ __forceinline__ int crow(int r, int hh) { return (r & 3) + 8 * (r >> 2) + 4 * hh; }
__device__ __forceinline__ int perm23(int k) { return (k & ~0xC) | ((k & 4) << 1) | ((k & 8) >> 1); }

__device__ const double ROPE_TURNS[32] = {
    0.15915494309189535, 0.11934937021124886, 0.08949940160889101, 0.06711508300522726, 0.050329212104487035, 0.03774158471741977, 0.0283021958306234, 0.02122365276477766, 0.015915494309189534, 0.011934937021124886, 0.008949940160889102, 0.006711508300522725, 0.005032921210448704, 0.003774158471741977, 0.00283021958306234, 0.0021223652764777662, 0.0015915494309189536, 0.0011934937021124885, 0.0008949940160889102, 0.0006711508300522726, 0.0005032921210448703, 0.00037741584717419774, 0.00028302195830623395, 0.0002122365276477766, 0.00015915494309189535, 0.00011934937021124886, 8.949940160889102e-05, 6.711508300522725e-05, 5.0329212104487035e-05, 3.774158471741978e-05, 2.8302195830623396e-05, 2.122365276477766e-05
};
__device__ __forceinline__ void rope_cs_t(int pos, double turns, float& c, float& s) {
    double a = (double)pos * turns; a -= __builtin_rint(a);
    const float t = (float)a;
    s = __builtin_amdgcn_sinf(t); c = __builtin_amdgcn_cosf(t);
}
__device__ __forceinline__ void rope_cs(int pos, int i, float& c, float& s) {
    double a = (double)pos * ROPE_TURNS[i]; a -= __builtin_rint(a);
    const float t = (float)a;
    s = __builtin_amdgcn_sinf(t); c = __builtin_amdgcn_cosf(t);
}

#define XB_TMO      128
#define XB_XCNT(j)  (256  + 64 * (j))
#define XB_XSUB(j)  (1280 + 64 * (j))
#define XB_XGEN(j)  (2304 + 64 * (j))
#define XB_TOP      3328
#define XB_TOPGEN   3392
#define XCD_BAR_WORDS 3456
#define XB_SPIN_CAP (1u << 18)
__device__ __forceinline__ unsigned xb_ld(unsigned* p)              { return __hip_atomic_load(p, __ATOMIC_RELAXED, __HIP_MEMORY_SCOPE_AGENT); }
__device__ __forceinline__ unsigned xb_add(unsigned* p, unsigned v) { return __hip_atomic_fetch_add(p, v, __ATOMIC_RELAXED, __HIP_MEMORY_SCOPE_AGENT); }
__device__ __forceinline__ unsigned xb_xcc_id() { return (unsigned)__builtin_amdgcn_s_getreg((3 << 11) | 20) & 0xFu; }
#define XB_SPIN(cond, bar) do { unsigned _sp = 0; while (cond) { __builtin_amdgcn_s_sleep(1); \
    if ((++_sp & 255u) == 0u) { if (xb_ld(&(bar)[XB_TMO])) break; if (_sp > XB_SPIN_CAP) { atomicAdd(&(bar)[XB_TMO], 1u); break; } } } } while (0)
struct XcdBarrier { unsigned* bar; unsigned x; volatile LAS unsigned* st; };
__device__ __forceinline__ XcdBarrier xcd_barrier_post(unsigned* bar, volatile LAS unsigned* st) {
    XcdBarrier b; b.bar = bar; b.x = xb_xcc_id(); b.st = st;
    if (threadIdx.x == 0) (void)xb_add(&bar[XB_XCNT(b.x)], 1u);
    return b;
}
__device__ __forceinline__ void xcd_barrier_complete(unsigned* bar, unsigned x, unsigned& nloc, unsigned& nx) {
    const unsigned G = gridDim.x * gridDim.y * gridDim.z;
    unsigned sum, cnt, mine, sp = 0u;
    for (;;) {
        sum = 0u; cnt = 0u; mine = 0u;
#pragma unroll
        for (unsigned j = 0; j < 16; ++j) { const unsigned c = xb_ld(&bar[XB_XCNT(j)]); sum += c; cnt += (c > 0u) ? 1u : 0u; mine = (j == x) ? c : mine; }
        if (sum == G) break;
        __builtin_amdgcn_s_sleep(1);
        if ((++sp & 255u) == 0u) { if (xb_ld(&bar[XB_TMO])) break; if (sp > XB_SPIN_CAP) { atomicAdd(&bar[XB_TMO], 1u); break; } }
    }
    nloc = mine > 0u ? mine : 1u; nx = cnt > 0u ? cnt : 1u;
}
__device__ __forceinline__ void xcd_barrier(const XcdBarrier& b) {
    asm volatile("s_waitcnt vmcnt(0)" ::: "memory");
    __syncthreads();
    if (threadIdx.x == 0) {
        unsigned* bar = b.bar;
        __builtin_amdgcn_s_waitcnt(0);
        unsigned nloc = b.st[0], nx = b.st[1];
        if (nloc == 0u) { xcd_barrier_complete(bar, b.x, nloc, nx); b.st[0] = nloc; b.st[1] = nx; }
        const unsigned old = xb_add(&bar[XB_XSUB(b.x)], 1u);
        const unsigned gen = old / nloc;
        if (old + 1u == (gen + 1u) * nloc) {
            __builtin_amdgcn_fence(__ATOMIC_RELEASE, "agent");
            asm volatile("s_waitcnt vmcnt(0)" ::: "memory");
            const unsigned og = xb_add(&bar[XB_TOP], 1u);
            const unsigned tg = og / nx;
            if (og + 1u == (tg + 1u) * nx) xb_add(&bar[XB_TOPGEN], 1u);
            else XB_SPIN(xb_ld(&bar[XB_TOPGEN]) == tg, bar);
            __builtin_amdgcn_fence(__ATOMIC_ACQUIRE, "agent");
            xb_add(&bar[XB_XGEN(b.x)], 1u);
            asm volatile("s_waitcnt vmcnt(0)" ::: "memory");
        } else {
            XB_SPIN(xb_ld(&bar[XB_XGEN(b.x)]) == gen, bar);
            __builtin_amdgcn_fence(__ATOMIC_ACQUIRE, "agent");
            asm volatile("s_waitcnt vmcnt(0)" ::: "memory");
        }
    }
    __syncthreads();
}

struct Params {
    const float* in[37];
    float* out;
    unsigned char* ws;
};
struct Frame {
    LAS unsigned char* lds;
    unsigned char* ws;
    float* out;
    int tid, lane, wave, G, bid;
};
#define WSP(T, off) ((T*)(F.ws + (off)))

template <class Map>
__device__ __forceinline__ void p0_transpose_item(const float* W, int K, int Nsrc, int Ndst, bf16_t* WT, const float* gain, const Map& map, LAS float* scr, int item, int lane) {
    const int nblk = Ndst / 32, kb = item / nblk, nb = item % nblk, k0 = 64 * kb, n0 = 32 * nb;
    const int sc = map(n0 + (lane & 31));
    const int scc = sc < 0 ? 0 : sc; const float msk = sc < 0 ? 0.f : 1.f;
    const float* wp = W + (size_t)(k0 + (lane >> 5)) * Nsrc + scc;
    float v[32];
#pragma unroll
    for (int i = 0; i < 32; ++i) v[i] = wp[(size_t)(2 * i) * Nsrc];
    if (gain) {
        const float* gp = gain + k0 + (lane >> 5); float g[32];
#pragma unroll
        for (int i = 0; i < 32; ++i) g[i] = gp[2 * i];
#pragma unroll
        for (int i = 0; i < 32; ++i) v[i] *= g[i];
    }
#pragma unroll
    for (int i = 0; i < 32; ++i) scr[(2 * i + (lane >> 5)) * 33 + (lane & 31)] = v[i] * msk;
    LDS_WAIT(); asm volatile("" ::: "memory");
    const int c = lane & 7;
    float tv[4][8];
#pragma unroll
    for (int j = 0; j < 4; ++j) { const LAS float* s = scr + (8 * c) * 33 + (lane >> 3) + 8 * j;
#pragma unroll
        for (int e = 0; e < 8; ++e) tv[j][e] = s[e * 33]; }
#pragma unroll
    for (int j = 0; j < 4; ++j) { const int n = (lane >> 3) + 8 * j;
        u32x4 o; o.x = pk2(tv[j][0], tv[j][1]); o.y = pk2(tv[j][2], tv[j][3]); o.z = pk2(tv[j][4], tv[j][5]); o.w = pk2(tv[j][6], tv[j][7]);
        *(u32x4*)(WT + (size_t)(n0 + n) * K + k0 + 8 * c) = o; }
    LDS_WAIT(); asm volatile("" ::: "memory");
}
struct MapIn { __device__ __forceinline__ int operator()(int n) const {
    if (n < 512) return n;
    if (n < 1024) return 1024 + (n - 512);
    if (n < 1280) return 1536 + (n - 1024);
    if (n < 1792) return 2880 + (n - 1280);
    if (n < 1856) return n;
    if (n < 2048) return -1;
    if (n < 2560) return 512 + (n - 2048);
    if (n < 3584) return 1856 + (n - 2560);
    return 3392 + (n - 3584);
} };
struct MapUq { __device__ __forceinline__ int operator()(int n) const {
    const int h = n >> 8, p = n & 255;
    if (p < 128) return h * 192 + p;
    if (p >= 192) return -1;
    const int pp = p - 128, wc = pp >> 5, nn = (pp >> 4) & 1, rest = pp & 15;
    return h * 192 + 128 + 32 * nn + 16 * wc + rest;
} };
struct MapId { __device__ __forceinline__ int operator()(int n) const { return n; } };
struct MapOff { int off; __device__ __forceinline__ int operator()(int n) const { return n - off; } };

__device__ __forceinline__ void p0_norm_row(const float* xrow, const float* g, bf16_t* orow, int lane) {
    const f32x4* xr = (const f32x4*)xrow + lane; const f32x4* gr = (const f32x4*)g + lane;
    f32x4 v[8], gv[8]; float s = 0.f;
#pragma unroll
    for (int j = 0; j < 8; ++j) { v[j] = xr[64 * j]; gv[j] = gr[64 * j]; }
    __builtin_amdgcn_sched_barrier(0);
#pragma unroll
    for (int j = 0; j < 8; ++j) s += (v[j].x * v[j].x + v[j].y * v[j].y) + (v[j].z * v[j].z + v[j].w * v[j].w);
    const float rinv = 1.0f / sqrtf(wave_sum(s) * (1.f / 2048.f) + EPS);
    u32x2* o8 = (u32x2*)orow + lane;
#pragma unroll
    for (int j = 0; j < 8; ++j) { const f32x4 gg = gv[j]; u32x2 w; w.x = pk2(v[j].x * rinv * gg.x, v[j].y * rinv * gg.y); w.y = pk2(v[j].z * rinv * gg.z, v[j].w * rinv * gg.w); o8[64 * j] = w; }
}

__device__ __forceinline__ void p0_norm_row2(const float* x0, const float* x1, const float* g, bf16_t* o0, bf16_t* o1, int lane) {
    const f32x4* xr0 = (const f32x4*)x0 + lane; const f32x4* xr1 = (const f32x4*)x1 + lane; const f32x4* gr = (const f32x4*)g + lane;
    f32x4 v[8], u[8], gv[8]; float s = 0.f, t = 0.f;
#pragma unroll
    for (int j = 0; j < 8; ++j) { v[j] = xr0[64 * j]; u[j] = xr1[64 * j]; gv[j] = gr[64 * j]; }
    __builtin_amdgcn_sched_barrier(0);
#pragma unroll
    for (int j = 0; j < 8; ++j) { s += (v[j].x * v[j].x + v[j].y * v[j].y) + (v[j].z * v[j].z + v[j].w * v[j].w); t += (u[j].x * u[j].x + u[j].y * u[j].y) + (u[j].z * u[j].z + u[j].w * u[j].w); }
    const float r0 = 1.0f / sqrtf(wave_sum(s) * (1.f / 2048.f) + EPS), r1 = 1.0f / sqrtf(wave_sum(t) * (1.f / 2048.f) + EPS);
    u32x2* p0 = (u32x2*)o0 + lane; u32x2* p1 = (u32x2*)o1 + lane;
#pragma unroll
    for (int j = 0; j < 8; ++j) { const f32x4 gg = gv[j]; u32x2 w;
        w.x = pk2(v[j].x * r0 * gg.x, v[j].y * r0 * gg.y); w.y = pk2(v[j].z * r0 * gg.z, v[j].w * r0 * gg.w); p0[64 * j] = w;
        w.x = pk2(u[j].x * r1 * gg.x, u[j].y * r1 * gg.y); w.y = pk2(u[j].z * r1 * gg.z, u[j].w * r1 * gg.w); p1[64 * j] = w; }
}
__device__ __forceinline__ void p0_prologue(Frame& F, const Params& P) {
    int tid = F.tid; asm volatile("" : "+v"(tid)); const int lane_ = tid & 63;
    LAS float* scr = (LAS float*)(F.lds + F.wave * 16384);
    const int gw = F.bid * 8 + F.wave, NGW = F.G * 8;
    const int gt = F.bid * 512 + tid, NGT = F.G * 512;
    constexpr int I_IN = (2048 / 64) * (4096 / 32), I_UQ = (512 / 64) * (2048 / 32), I_KV = (256 / 64) * (2048 / 32), I_MK = (2048 / 64) * (512 / 32), I_OUT = (2048 / 64) * (2048 / 32);
    constexpr int NITEMS = I_IN + I_UQ + 2 * I_KV + 2 * I_MK + I_OUT;
#ifndef REP_P0T
#define REP_P0T 1
#endif
#ifndef REP_P0X
#define REP_P0X 1
#endif
    for (int rp_ = 0; rp_ < REP_P0T; ++rp_)
    for (int it = gw; it < NITEMS; it += NGW) {
        int r = it;
        if (r < I_IN) { p0_transpose_item(P.in[11], 2048, 3904, 4096, WSP(bf16_t, WS_WIN_T), (const float*)nullptr, MapIn{}, scr, r, lane_); continue; } r -= I_IN;
        if (r < I_UQ) { p0_transpose_item(P.in[23], 512, 1536, 2048, WSP(bf16_t, WS_WUQ_T), P.in[22], MapUq{}, scr, r, lane_); continue; } r -= I_UQ;
        if (r < I_KV) { p0_transpose_item(P.in[25], 256, 2048, 2048, WSP(bf16_t, WS_WKV_TG), P.in[24], MapId{}, scr, r, lane_); continue; } r -= I_KV;
        if (r < I_KV) { p0_transpose_item(P.in[25], 256, 2048, 2048, WSP(bf16_t, WS_WKV_T), (const float*)nullptr, MapId{}, scr, r, lane_); continue; } r -= I_KV;
        if (r < I_MK) { p0_transpose_item(P.in[29], 2048, 512, 512, WSP(bf16_t, WS_MEMKV_T), (const float*)nullptr, MapId{}, scr, r, lane_); continue; } r -= I_MK;
        if (r < I_MK) { p0_transpose_item(P.in[30], 2048, 512, 512, WSP(bf16_t, WS_MEMKV_T) + (size_t)512 * 2048, (const float*)nullptr, MapId{}, scr, r, lane_); continue; } r -= I_MK;
        p0_transpose_item(P.in[36], 2048, 2048, 2048, WSP(bf16_t, WS_WOUT_T), (const float*)nullptr, MapId{}, scr, r, lane_);
    }
#ifndef REP_P0M
#define REP_P0M 1
#endif
    for (int rm_ = 0; rm_ < REP_P0M; ++rm_) {
    { const float* w = P.in[25]; bf16_t* o = WSP(bf16_t, WS_WKV_B);
      for (int i = gt; i < 256 * 2048 / 4; i += NGT) { const f32x4 v = ((const f32x4*)w)[i]; u32x2 q; q.x = pk2(v.x, v.y); q.y = pk2(v.z, v.w); ((u32x2*)o)[i] = q; } }
    { const float* w = P.in[25]; u32x4* o = WSP(u32x4, WS_WF);
      for (int i = gt; i < 32 * 16 * 64; i += NGT) { const int ln = i & 63, ks = (i >> 6) & 15, hn = i >> 10, h = hn >> 2, nb = hn & 3, ii = ln & 31, hh = ln >> 5;
          const float* s = w + (size_t)(16 * ks + 8 * hh) * 2048 + h * 256 + nb * 32 + ii;
          u32x4 q; q.x = pk2(s[0], s[2048]); q.y = pk2(s[2 * 2048], s[3 * 2048]); q.z = pk2(s[4 * 2048], s[5 * 2048]); q.w = pk2(s[6 * 2048], s[7 * 2048]); o[i] = q; } }
    { const float* wsrc = P.in[25]; u32x4* o = WSP(u32x4, WS_W8F);
      for (int i = (gt + NGT - 64 * 512) % NGT; i < 32 * 4 * 64 * 2; i += NGT) { const int hf = i & 1, ln = (i >> 1) & 63, ks = (i >> 7) & 3, hn = i >> 9, h = hn >> 2, nb = hn & 3, ii = ln & 31, hh = ln >> 5;
          const float* s = wsrc + (size_t)(64 * ks + 32 * hh + 16 * hf) * 2048 + h * 256 + nb * 32 + ii;
          unsigned q[4];
#pragma unroll
          for (int d = 0; d < 4; ++d) { int t = __builtin_amdgcn_cvt_pk_fp8_f32(16.f * s[(size_t)(4 * d) * 2048], 16.f * s[(size_t)(4 * d + 1) * 2048], 0, false);
              t = __builtin_amdgcn_cvt_pk_fp8_f32(16.f * s[(size_t)(4 * d + 2) * 2048], 16.f * s[(size_t)(4 * d + 3) * 2048], t, true); q[d] = (unsigned)t; }
          o[i] = (u32x4){q[0], q[1], q[2], q[3]}; } }
    { const float* w = P.in[20]; u32x4* o = WSP(u32x4, WS_GLUF);
      for (int i = (gt + NGT - 96 * 512) % NGT; i < 16 * 32 * 64; i += NGT) { const int ln = i & 63, ks = (i >> 6) & 31, cb = i >> 11, ii = ln & 31, hh = ln >> 5;
          const float* s = w + (size_t)(16 * ks + 8 * hh) * 512 + cb * 32 + ii;
          u32x4 q; q.x = pk2(s[0], s[512]); q.y = pk2(s[2 * 512], s[3 * 512]); q.z = pk2(s[4 * 512], s[5 * 512]); q.w = pk2(s[6 * 512], s[7 * 512]); o[i] = q; } }
    { const float* a_re = P.in[12]; const float* a_im = P.in[13]; const float* ldt = P.in[14]; const float* b_re = P.in[15]; const float* b_im = P.in[16];
      f32x2* abar = WSP(f32x2, WS_ABAR); f32x2* abarl = WSP(f32x2, WS_ABARL); f32x2* bbar = WSP(f32x2, WS_BBAR);
      for (int i = (gt + NGT - 160 * 512) % NGT; i < 32 * 64; i += NGT) { const int g = i >> 6;
          const float dt = expf(ldt[g]), ar = a_re[i], ai = a_im[i];
          const float mag = expf(dt * ar), ph = dt * ai;
          const float abr = mag * cosf(ph), abi = mag * sinf(ph);
          abar[i] = (f32x2){abr, abi};
          const float magl = expf(32.f * dt * ar), phl = 32.f * ph;
          abarl[i] = (f32x2){magl * cosf(phl), magl * sinf(phl)};
          const float den = ar * ar + ai * ai, nr = abr - 1.0f, ni = abi;
          const float fr = (nr * ar + ni * ai) / den, fi = (ni * ar - nr * ai) / den;
          f32x4 brv[4], biv[4];
#pragma unroll
          for (int q = 0; q < 4; ++q) { brv[q] = *(const f32x4*)(b_re + i * 16 + 4 * q); biv[q] = *(const f32x4*)(b_im + i * 16 + 4 * q); }
          __builtin_amdgcn_sched_barrier(0);
#pragma unroll
          for (int p = 0; p < 16; ++p) { const float br = brv[p >> 2][p & 3], bi = biv[p >> 2][p & 3]; const float vr = fr * br - fi * bi, vi = fr * bi + fi * br; bbar[i * 16 + p] = (f32x2){vr, vi};
              WSP(bf16_t, WS_BBST)[((size_t)g * 128 + (i & 63)) * 16 + p] = (bf16_t)f2bf(vr); WSP(bf16_t, WS_BBST)[((size_t)g * 128 + 64 + (i & 63)) * 16 + p] = (bf16_t)f2bf(vi); } } }
    { const float* c_re = P.in[17]; const float* c_im = P.in[18]; bf16_t* o = WSP(bf16_t, WS_CSTB);
      for (int i = gt; i < 32 * 32 * 128; i += NGT) { const int k = i & 127, p = (i >> 7) & 31, g = i >> 12; float v = 0.f;
          if (p < 16) v = (k < 64) ? c_re[(g * 16 + p) * 64 + k] : -c_im[(g * 16 + p) * 64 + (k - 64)];
          o[i] = (bf16_t)f2bf(v); } }
    if (gt < 192) WSP(float, WS_QCG)[gt] = P.in[26][gt] * P.in[27][gt] * (0.07216878364870322f * LOG2E);
    }
    for (int rp_ = 0; rp_ < REP_P0X; ++rp_)
    for (int m = gw; m < NR; m += 2 * NGW) {
        const int m2 = m + NGW; const bool has2 = m2 < NR; const int mb = has2 ? m2 : m;
        const float* s0 = (m < NP) ? P.in[0] + (size_t)m * 2048 : P.in[1] + (size_t)(m - NP) * 2048;
        const float* s1 = (mb < NP) ? P.in[0] + (size_t)mb * 2048 : P.in[1] + (size_t)(mb - NP) * 2048;
        p0_norm_row2(s0, s1, P.in[10], WSP(bf16_t, WS_XN) + (size_t)m * 2048, WSP(bf16_t, WS_XN) + (size_t)mb * 2048, lane_);
    }
    for (int m = gw; m < 512; m += NGW) p0_norm_row(P.in[2] + (size_t)m * 2048, P.in[28], WSP(bf16_t, WS_MEMN) + (size_t)m * 2048, lane_);
}

#define EPI_RELANE() do { int ln_ = (int)__builtin_amdgcn_mbcnt_hi(~0u, __builtin_amdgcn_mbcnt_lo(~0u, 0u)); asm volatile("" : "+v"(ln_)); fr = ln_ & 15; fq = ln_ >> 4; } while (0)
__device__ __forceinline__ float sq4(const f32x4 v) { return (v.x * v.x + v.y * v.y) + (v.z * v.z + v.w * v.w); }
__device__ __forceinline__ void st_bf4(bf16_t* p, const f32x4 v) { u32x2 w; w.x = pk2(v.x, v.y); w.y = pk2(v.z, v.w); *(u32x2*)p = w; }
__device__ __forceinline__ float red_fq_(float s, int hh) {
    s += __builtin_bit_cast(float, __builtin_amdgcn_ds_swizzle(__builtin_bit_cast(int, s), 0x401F));
    const auto rr = __builtin_amdgcn_permlane32_swap(__builtin_bit_cast(unsigned, s), __builtin_bit_cast(unsigned, s), false, false);
    return s + __builtin_bit_cast(float, hh ? rr[0] : rr[1]);
}
#define red_fq(s_) red_fq_((s_), fq >> 1)

struct EpiInProj {
    static constexpr bool PERM = false, AFTER_DRAIN = false;
    float* UF; bf16_t* CQ; float* SSQ_CQ; float* CKVF; bf16_t* CKVB; float* SSQ_CKV; bf16_t* QMR; float* SSQ_QM; float* KRF; bf16_t* GATES;
    __device__ __forceinline__ void operator()(const f32x4 (&acc)[2][2][4][2], const pg8::Unit& u, int wr, int wc, int fr, int fq) const {
        EPI_RELANE();
        const int pn = u.pn;
#pragma unroll
        for (int ai = 0; ai < 2; ++ai)
#pragma unroll
            for (int m = 0; m < 4; ++m) {
                const int row = u.pm * 256 + ai * 128 + wr * 64 + m * 16 + fr;
                const int cl = wc * 32 + 4 * fq;
                if (pn < 2) {
#pragma unroll
                    for (int bj = 0; bj < 2; ++bj)
#pragma unroll
                        for (int n = 0; n < 2; ++n) *(f32x4*)(UF + (size_t)row * 512 + pn * 256 + bj * 128 + cl + 16 * n) = acc[ai][bj][m][n];
                } else if (pn < 4) {
                    float s = 0.f;
#pragma unroll
                    for (int bj = 0; bj < 2; ++bj)
#pragma unroll
                        for (int n = 0; n < 2; ++n) { st_bf4(CQ + (size_t)row * 512 + (pn - 2) * 256 + bj * 128 + cl + 16 * n, acc[ai][bj][m][n]); s += sq4(acc[ai][bj][m][n]); }
                    s = red_fq(s); if (fq == 0) SSQ_CQ[row * 8 + (pn - 2) * 4 + wc] = s;
                } else if (pn == 4) {
                    float s = 0.f;
#pragma unroll
                    for (int bj = 0; bj < 2; ++bj)
#pragma unroll
                        for (int n = 0; n < 2; ++n) { const int c = bj * 128 + cl + 16 * n; *(f32x4*)(CKVF + (size_t)row * 256 + c) = acc[ai][bj][m][n]; st_bf4(CKVB + (size_t)row * 256 + c, acc[ai][bj][m][n]); s += sq4(acc[ai][bj][m][n]); }
                    s = red_fq(s); if (fq == 0) SSQ_CKV[row * 4 + wc] = s;
                } else if (pn < 7) {
#pragma unroll
                    for (int bj = 0; bj < 2; ++bj) { float s = 0.f; const int head = 2 * (pn - 5) + bj;
#pragma unroll
                        for (int n = 0; n < 2; ++n) { st_bf4(QMR + (size_t)row * 512 + head * 128 + cl + 16 * n, acc[ai][bj][m][n]); s += sq4(acc[ai][bj][m][n]); }
                        s = red_fq(s); if (fq == 0) SSQ_QM[row * 16 + head * 4 + wc] = s; }
                } else if (pn == 7) {
                    if (wc < 2) {
#pragma unroll
                        for (int n = 0; n < 2; ++n) *(f32x4*)(KRF + (size_t)row * 64 + cl + 16 * n) = acc[ai][0][m][n];
                    }
                } else {
#pragma unroll
                    for (int bj = 0; bj < 2; ++bj)
#pragma unroll
                        for (int n = 0; n < 2; ++n) st_bf4(GATES + (size_t)row * 2048 + (pn - 8) * 256 + bj * 128 + cl + 16 * n, acc[ai][bj][m][n]);
                }
            }
    }
};

struct EpiMemKV {
    static constexpr bool PERM = false, AFTER_DRAIN = false;
    float* MKRAW; float* SSQ_MK; float* OUTV; bf16_t* VTM;
    __device__ __forceinline__ void operator()(const f32x4 (&acc)[2][2][4][2], const pg8::Unit& u, int wr, int wc, int fr, int fq) const {
        EPI_RELANE();
        const int pn = u.pn;
#pragma unroll
        for (int ai = 0; ai < 2; ++ai)
#pragma unroll
            for (int m = 0; m < 4; ++m) {
                const int row = u.pm * 256 + ai * 128 + wr * 64 + m * 16 + fr;
                const int cl = wc * 32 + 4 * fq;
                if (pn < 2) {
#pragma unroll
                    for (int bj = 0; bj < 2; ++bj) { float s = 0.f; const int head = 2 * pn + bj;
#pragma unroll
                        for (int n = 0; n < 2; ++n) { *(f32x4*)(MKRAW + (size_t)row * 512 + head * 128 + cl + 16 * n) = acc[ai][bj][m][n]; s += sq4(acc[ai][bj][m][n]); }
                        s = red_fq(s); if (fq == 0) SSQ_MK[row * 16 + head * 4 + wc] = s; }
                } else {
                    const int b = row >> 8, key = row & 255, kp = perm23(key);
#pragma unroll
                    for (int bj = 0; bj < 2; ++bj) { const int head = 2 * (pn - 2) + bj;
#pragma unroll
                        for (int n = 0; n < 2; ++n) { const f32x4 v = acc[ai][bj][m][n]; const int dv = cl + 16 * n;
                            *(f32x4*)(OUTV + (size_t)row * 512 + head * 128 + dv) = v;
                            bf16_t* t = VTM + ((size_t)(b * 4 + head) * 128 + dv) * 256 + kp;
                            t[0] = (bf16_t)f2bf(v.x); t[256] = (bf16_t)f2bf(v.y); t[512] = (bf16_t)f2bf(v.z); t[768] = (bf16_t)f2bf(v.w); } }
                }
            }
    }
};

struct EpiQ {
    static constexpr bool PERM = false, AFTER_DRAIN = false;
    const float* SSQ_CQ; const float* QCG; bf16_t* QG; float* SSQ_Q;
    __device__ __forceinline__ void operator()(const f32x4 (&acc)[2][2][4][2], const pg8::Unit& u, int wr, int wc, int fr, int fq) const {
        EPI_RELANE();
        const int h = u.pn;
        const int cl = wc * 32 + 4 * fq;
        const f32x4 g00 = *(const f32x4*)(QCG + cl), g01 = *(const f32x4*)(QCG + cl + 16);
        const int ri = 16 * wc + 4 * fq;
        f32x4 g10 = (f32x4){0.f, 0.f, 0.f, 0.f}, g11 = g10;
        double rtn[4] = {0., 0., 0., 0.};
        if (wc < 2) { g10 = *(const f32x4*)(QCG + 128 + ri); g11 = *(const f32x4*)(QCG + 160 + ri);
#pragma unroll
            for (int e = 0; e < 4; ++e) rtn[e] = ROPE_TURNS[ri + e]; }
        float rinvs[2][4];
#pragma unroll
        for (int ai = 0; ai < 2; ++ai)
#pragma unroll
            for (int m = 0; m < 4; ++m) { const int row = u.pm * 256 + ai * 128 + wr * 64 + m * 16 + fr; const f32x4 s0 = *(const f32x4*)(SSQ_CQ + row * 8), s1 = *(const f32x4*)(SSQ_CQ + row * 8 + 4);
                rinvs[ai][m] = 1.0f / sqrtf(((s0.x + s0.y) + (s0.z + s0.w) + (s1.x + s1.y) + (s1.z + s1.w)) * (1.f / 512.f) + EPS); }
        __builtin_amdgcn_sched_barrier(0);
#pragma unroll
        for (int ai = 0; ai < 2; ++ai)
#pragma unroll
            for (int m = 0; m < 4; ++m) {
                const int row = u.pm * 256 + ai * 128 + wr * 64 + m * 16 + fr;
                const float rinv = rinvs[ai][m];
                const f32x4 a0 = acc[ai][0][m][0] * rinv, a1 = acc[ai][0][m][1] * rinv;
                float sr = sq4(a0) + sq4(a1);
                const f32x4 q0 = a0 * g00, q1 = a1 * g01;
                float sg = sq4(q0) + sq4(q1);
                bf16_t* qrow = QG + (size_t)row * 1536 + h * 192;
                st_bf4(qrow + cl, q0); st_bf4(qrow + cl + 16, q1);
                if (wc < 2) {
                    const int pos = (row < NP) ? (row & (SEQ - 1)) : PAST + ((row - NP) & 7);
                    const f32x4 x1 = acc[ai][1][m][0] * rinv, x2 = acc[ai][1][m][1] * rinv;
                    f32x4 o1, o2;
#pragma unroll
                    for (int e = 0; e < 4; ++e) { float c, s; rope_cs_t(pos, rtn[e], c, s); o1[e] = x1[e] * c - x2[e] * s; o2[e] = x1[e] * s + x2[e] * c; }
                    sr += sq4(o1) + sq4(o2);
                    const f32x4 r1 = o1 * g10, r2 = o2 * g11;
                    sg += sq4(r1) + sq4(r2);
                    st_bf4(qrow + 128 + ri, r1); st_bf4(qrow + 160 + ri, r2);
                }
                sr = red_fq(sr); sg = red_fq(sg);
                if (fq == 0) { float* d = SSQ_Q + ((size_t)row * 8 + h) * 8 + wc * 2; d[0] = sr; d[1] = sg; }
            }
    }
};

struct EpiKV {
    static constexpr bool PERM = false, AFTER_DRAIN = false;
    const float* SSQ_CKV; bf16_t* KNB; float* SSQ_KN; bf16_t* VT;
    __device__ __forceinline__ void operator()(const f32x4 (&acc)[2][2][4][2], const pg8::Unit& u, int wr, int wc, int fr, int fq) const {
        EPI_RELANE();
        const int h = u.pn;
        const int cl = wc * 32 + 4 * fq;
        f32x4 sv[8]; float rinvs[8];
#pragma unroll
        for (int q0 = 0; q0 < 8; q0 += 4) {
#pragma unroll
            for (int q = q0; q < q0 + 4; ++q) sv[q] = *(const f32x4*)(SSQ_CKV + (u.pm * 256 + (q >> 2) * 128 + wr * 64 + (q & 3) * 16 + fr) * 4);
            __builtin_amdgcn_sched_barrier(0);
#pragma unroll
            for (int q = q0; q < q0 + 4; ++q) rinvs[q] = 1.0f / sqrtf(((sv[q].x + sv[q].y) + (sv[q].z + sv[q].w)) * (1.f / 256.f) + EPS);
            __builtin_amdgcn_sched_barrier(0);
        }
#pragma unroll
        for (int ai = 0; ai < 2; ++ai)
#pragma unroll
            for (int m = 0; m < 4; ++m) {
                const int row = u.pm * 256 + ai * 128 + wr * 64 + m * 16 + fr;
                const int b = row >> 12, t = row & (SEQ - 1);
                const float rinv = rinvs[ai * 4 + m];
                const f32x4 k0 = acc[ai][0][m][0] * rinv, k1 = acc[ai][0][m][1] * rinv;
                bf16_t* kr = KNB + ((size_t)(b * 8 + h) * SEQ + t) * 128;
                st_bf4(kr + cl, k0); st_bf4(kr + cl + 16, k1);
                float s = red_fq(sq4(k0) + sq4(k1));
                if (fq == 0) SSQ_KN[((size_t)row * 8 + h) * 4 + wc] = s;
                const int tp = perm23(t);
#pragma unroll
                for (int n = 0; n < 2; ++n) { const f32x4 v = acc[ai][1][m][n] * rinv; const int dv = cl + 16 * n;
                    bf16_t* vp = VT + ((size_t)(b * 8 + h) * 128 + dv) * SEQ + tp;
                    vp[0] = (bf16_t)f2bf(v.x); vp[SEQ] = (bf16_t)f2bf(v.y); vp[2 * SEQ] = (bf16_t)f2bf(v.z); vp[3 * SEQ] = (bf16_t)f2bf(v.w); }
            }
    }
};

struct EpiMerge {
    static constexpr bool PERM = false, AFTER_DRAIN = false;
    const float* XP; const float* XS; float* Y;
    __device__ __forceinline__ void operator()(const f32x4 (&acc)[2][2][4][2], const pg8::Unit& u, int wr, int wc, int fr, int fq) const {
        EPI_RELANE();
        const int c0 = u.pn * 256 + wc * 32 + 4 * fq;
#pragma unroll
        for (int ai = 0; ai < 2; ++ai) {
            f32x4 xv[4][2][2];
#pragma unroll
            for (int m = 0; m < 4; ++m) {
                const int row = u.pm * 256 + ai * 128 + wr * 64 + m * 16 + fr;
                const float* xr = (row < NP) ? XP + (size_t)row * 2048 : XS + (size_t)(row - NP) * 2048;
#pragma unroll
                for (int bj = 0; bj < 2; ++bj)
#pragma unroll
                    for (int n = 0; n < 2; ++n) xv[m][bj][n] = *(const f32x4*)(xr + c0 + bj * 128 + 16 * n);
            }
            __builtin_amdgcn_sched_barrier(0);
#pragma unroll
            for (int m = 0; m < 4; ++m) {
                const int row = u.pm * 256 + ai * 128 + wr * 64 + m * 16 + fr;
#pragma unroll
                for (int bj = 0; bj < 2; ++bj)
#pragma unroll
                    for (int n = 0; n < 2; ++n) *(f32x4*)(Y + (size_t)row * 2048 + c0 + bj * 128 + 16 * n) = acc[ai][bj][m][n] + xv[m][bj][n];
            }
            __builtin_amdgcn_sched_barrier(0);
        }
    }
};

struct EpiPart {
    static constexpr bool PERM = false, AFTER_DRAIN = false;
    float* C;
    __device__ __forceinline__ void operator()(const f32x4 (&acc)[2][2][4][2], const pg8::Unit& u, int wr, int wc, int fr, int fq) const {
        EPI_RELANE();
#pragma unroll
        for (int ai = 0; ai < 2; ++ai)
#pragma unroll
            for (int m = 0; m < 4; ++m) {
                const int row = u.pm * 256 + ai * 128 + wr * 64 + m * 16 + fr;
                const int c0 = u.pn * 256 + wc * 32 + 4 * fq;
#pragma unroll
                for (int bj = 0; bj < 2; ++bj)
#pragma unroll
                    for (int n = 0; n < 2; ++n) *(f32x4*)(C + (size_t)row * 2048 + c0 + bj * 128 + 16 * n) = acc[ai][bj][m][n];
            }
    }
};
struct SchedOne {
    int pm, pn; bool on;
    __device__ bool next(int i, pg8::Unit& u) const { if (i > 0 || !on) return false; u.pm = pm; u.pn = pn; return true; }
    __device__ __forceinline__ void a_ready(const pg8::Unit&) const {}
    __device__ __forceinline__ void done(const pg8::Unit&) const {}
};

struct P2Row { f32x4 sck, ckv, sqm, smk, mk0, mk1; u32x4 qm; float k1, k2; };
__device__ __forceinline__ void p2a_load(Frame& F, P2Row& r, int row, int lane) {
    const f32x4 z4 = (f32x4){0.f, 0.f, 0.f, 0.f}; r.sck = z4; r.ckv = z4; r.sqm = z4; r.smk = z4; r.mk0 = z4; r.mk1 = z4; r.qm = (u32x4){0u, 0u, 0u, 0u}; r.k1 = 0.f; r.k2 = 0.f;
    if (row < NR) {
        r.sck = *(const f32x4*)(WSP(float, WS_SSQ_CKV) + row * 4);
        r.ckv = *((const f32x4*)(WSP(float, WS_CKVF) + (size_t)row * 256) + lane);
        const float* kr = WSP(float, WS_KRF) + (size_t)row * 64; r.k1 = kr[lane & 31]; r.k2 = kr[(lane & 31) + 32];
        r.qm = *((const u32x4*)(WSP(bf16_t, WS_QMR) + (size_t)row * 512) + lane);
        r.sqm = *(const f32x4*)(WSP(float, WS_SSQ_QM) + row * 16 + (lane >> 4) * 4);
    } else {
        const int mr = row - NR;
        const float* src = WSP(float, WS_MKRAW) + (size_t)mr * 512 + 8 * lane;
        r.mk0 = *(const f32x4*)src; r.mk1 = *(const f32x4*)(src + 4);
        r.smk = *(const f32x4*)(WSP(float, WS_SSQ_MK) + mr * 16 + (lane >> 4) * 4);
    }
}
__device__ __forceinline__ void p2a_finish(Frame& F, const P2Row& r, int row, int lane, const f32x4 gkv, const f32x4 gq0, const f32x4 gq1, const f32x4 gk0, const f32x4 gk1, const double rtn) {
    const float gmq[8] = {gq0.x, gq0.y, gq0.z, gq0.w, gq1.x, gq1.y, gq1.z, gq1.w}, gmk[8] = {gk0.x, gk0.y, gk0.z, gk0.w, gk1.x, gk1.y, gk1.z, gk1.w};
    const int head = lane >> 4, j0 = (8 * lane) & 127;
    if (row < NR) {
        const bool prompt = row < NP;
        const int pos = prompt ? (row & (SEQ - 1)) : PAST + ((row - NP) & 7);
        { const float rinv = 1.0f / sqrtf(((r.sck.x + r.sck.y) + (r.sck.z + r.sck.w)) * (1.f / 256.f) + EPS);
          const f32x4 v = r.ckv * rinv * gkv;
          float* o = prompt ? F.out + O_CKV_P + (size_t)row * 256 : F.out + O_CKV_S + (size_t)(row - NP) * 256;
          *((f32x4*)o + lane) = v;
          if (!prompt) st_bf4(WSP(bf16_t, WS_CKVS) + (size_t)(row - NP) * 256 + 4 * lane, v); }
        { float c, s; rope_cs_t(pos, rtn, c, s);
          const float o = (lane < 32) ? (r.k1 * c - r.k2 * s) : (r.k1 * s + r.k2 * c);
          float* op = prompt ? F.out + O_KR_P + (size_t)row * 64 : F.out + O_KR_S + (size_t)(row - NP) * 64;
          op[lane] = o;
          WSP(bf16_t, WS_KRB)[(size_t)row * 64 + lane] = (bf16_t)f2bf(o);
          const float ss = wave_sum(o * o);
          if (lane == 0) WSP(float, WS_SSQ_KR)[row] = ss; }
        { const float rinv = 1.0f / sqrtf(((r.sqm.x + r.sqm.y) + (r.sqm.z + r.sqm.w)) * (1.f / 128.f) + EPS);
          const float sc = rinv * (0.08838834764831845f * LOG2E);
          float q[8] = {bflo(r.qm.x), bfhi(r.qm.x), bflo(r.qm.y), bfhi(r.qm.y), bflo(r.qm.z), bfhi(r.qm.z), bflo(r.qm.w), bfhi(r.qm.w)};
          float sb = 0.f;
#pragma unroll
          for (int e = 0; e < 8; ++e) { q[e] *= sc * gmq[e]; const float t = q[e] * gmk[e]; sb += t * t; }
          u32x4 o; o.x = pk2(q[0], q[1]); o.y = pk2(q[2], q[3]); o.z = pk2(q[4], q[5]); o.w = pk2(q[6], q[7]);
          *((u32x4*)(WSP(bf16_t, WS_QM) + (size_t)row * 512) + lane) = o;
          sb += __shfl_xor(sb, 1); sb += __shfl_xor(sb, 2); sb += __shfl_xor(sb, 4); sb += __shfl_xor(sb, 8);
          if ((lane & 15) == 0) WSP(float, WS_MQM)[row * 4 + head] = sqrtf(sb) * 11.313708498984761f; }
    } else {
        const int mr = row - NR, b = mr >> 8, key = mr & 255;
        const float rinv = 1.0f / sqrtf(((r.smk.x + r.smk.y) + (r.smk.z + r.smk.w)) * (1.f / 128.f) + EPS);
        const f32x4 a = r.mk0 * rinv * gk0, c = r.mk1 * rinv * gk1;
        float* o = F.out + O_MK + (size_t)mr * 512 + 8 * lane;
        *(f32x4*)o = a; *(f32x4*)(o + 4) = c;
        u32x4 w; w.x = pk2(a.x, a.y); w.y = pk2(a.z, a.w); w.z = pk2(c.x, c.y); w.w = pk2(c.z, c.w);
        *(u32x4*)(WSP(bf16_t, WS_MKB) + ((size_t)(b * 4 + head) * 256 + key) * 128 + j0) = w;
    }
}
__device__ __forceinline__ void p2a_rows(Frame& F, const Params& P) {
    int tid = F.tid; asm volatile("" : "+v"(tid));
    const int gw = F.bid * 8 + F.wave, NGW = F.G * 8, lane = tid & 63;
    const f32x4 gkv = *((const f32x4*)P.in[24] + lane);
    const int j0 = (8 * lane) & 127;
    const f32x4 gq0 = *(const f32x4*)(P.in[31] + j0), gq1 = *(const f32x4*)(P.in[31] + j0 + 4), gk0 = *(const f32x4*)(P.in[32] + j0), gk1 = *(const f32x4*)(P.in[32] + j0 + 4);
    const double rtn = ROPE_TURNS[lane & 31];
    for (int row = gw; row < NR + 512; row += 2 * NGW) {
        const int row2 = row + NGW; const bool has2 = row2 < NR + 512;
        P2Row ra, rb;
        p2a_load(F, ra, row, lane);
        if (has2) p2a_load(F, rb, row2, lane);
        __builtin_amdgcn_sched_barrier(0);
        p2a_finish(F, ra, row, lane, gkv, gq0, gq1, gk0, gk1, rtn);
        if (has2) p2a_finish(F, rb, row2, lane, gkv, gq0, gq1, gk0, gk1, rtn);
    }
}

constexpr int SSM_U_OFF = 0, SSM_X_OFF = 16384, SSM_X_BYTES = 32 * 136 * 2, SSM_G_OFF = SSM_X_OFF + 8 * SSM_X_BYTES, SSM_G_PITCH = 520, SSM_C_OFF = SSM_G_OFF + 32 * SSM_G_PITCH * 2;
static_assert(SSM_C_OFF + 16384 <= LDS_MISC, "ssm LDS map");
__device__ __forceinline__ float sigmoidf_(float a) { return __builtin_amdgcn_rcpf(1.0f + ex2(-a * LOG2E)); }
__device__ __forceinline__ float other_half(float x, int hh) {
    const auto rr = __builtin_amdgcn_permlane32_swap(__builtin_bit_cast(unsigned, x), __builtin_bit_cast(unsigned, x), false, false);
    return __builtin_bit_cast(float, hh ? rr[0] : rr[1]);
}
template <int MODE>
__device__ __forceinline__ void ssm_unit(Frame& F, const Params& P, int unit) {
    int tid = F.tid; asm volatile("" : "+v"(tid));
    const int lane = tid & 63, w = F.wave, i32 = lane & 31, hh = lane >> 5;
    const int b = unit >> 7, c = unit & 127;
    const int base = (MODE == 2) ? NP + 32 * unit : b * SEQ + c * 32;
    LAS float* Uw = (LAS float*)(F.lds + SSM_U_OFF + w * 2048);
    LAS bf16_t* Xw = (LAS bf16_t*)(F.lds + SSM_X_OFF + w * SSM_X_BYTES);
    LAS bf16_t* Gt = (LAS bf16_t*)(F.lds + SSM_G_OFF);
    const float* UF = WSP(float, WS_UF);
    LAS f32x2* CR = (LAS f32x2*)(F.lds + SSM_C_OFF + w * 2048);
    if (MODE == 1) {
        const int n = lane;
        float cr[4] = {0.f, 0.f, 0.f, 0.f}, ci[4] = {0.f, 0.f, 0.f, 0.f};
        f32x2 al[4];
#pragma unroll
        for (int gi = 0; gi < 4; ++gi) al[gi] = WSP(f32x2, WS_ABARL)[(4 * w + gi) * 64 + n];
        const f32x2* sch = WSP(f32x2, WS_SCH) + ((size_t)(b * 128) * 32 + 4 * w) * 64 + n;
        const int nbt = (c + 7) >> 3;
#ifdef PROBE_SSM_C
        for (int rc_ = 0; rc_ < 2; ++rc_) { if (rc_) { cr[0] = cr[1] = cr[2] = cr[3] = 0.f; ci[0] = ci[1] = ci[2] = ci[3] = 0.f; }
#else
        {
#endif
        const int nbt2 = (nbt + 1) & ~1;
        f32x2 svA[4][8], svB[4][8];
#define CARRY_LOAD(sv_, bq_) do { const int c0_ = c - (nbt2 - (bq_)) * 8; _Pragma("unroll") for (int k = 0; k < 8; ++k) _Pragma("unroll") for (int gi = 0; gi < 4; ++gi) { \
            const int cc = c0_ + k; sv_[gi][k] = sch[(size_t)(cc >= 0 ? cc : 0) * 2048 + gi * 64]; } } while (0)
#define CARRY_STEP(sv_, bq_) do { const int c0_ = c - (nbt2 - (bq_)) * 8; _Pragma("unroll") for (int k = 0; k < 8; ++k) _Pragma("unroll") for (int gi = 0; gi < 4; ++gi) { \
            const float mk = (c0_ + k >= 0) ? 1.f : 0.f; const float nr = al[gi].x * cr[gi] - al[gi].y * ci[gi] + sv_[gi][k].x * mk, ni = al[gi].x * ci[gi] + al[gi].y * cr[gi] + sv_[gi][k].y * mk; cr[gi] = nr; ci[gi] = ni; } } while (0)
        if (nbt2 > 0) CARRY_LOAD(svA, 0);
        for (int bq = 0; bq < nbt2; bq += 2) {
            CARRY_LOAD(svB, bq + 1);
            __builtin_amdgcn_sched_barrier(0);
            CARRY_STEP(svA, bq);
            __builtin_amdgcn_sched_barrier(0);
            { const int bn = (bq + 2 < nbt2) ? bq + 2 : nbt2 - 1; CARRY_LOAD(svA, bn); }
            __builtin_amdgcn_sched_barrier(0);
            CARRY_STEP(svB, bq + 1);
            __builtin_amdgcn_sched_barrier(0);
        }
#undef CARRY_LOAD
#undef CARRY_STEP
        }
#pragma unroll
        for (int gi = 0; gi < 4; ++gi) CR[gi * 64 + n] = (f32x2){cr[gi], ci[gi]};
        LDS_WAIT();
    }
#ifdef PROBE_SSM_G
    for (int rg_ = 0; rg_ < 2; ++rg_)
#endif
    for (int gi = 0; gi < 4; ++gi) {
        const int g = 4 * w + gi;
        bf16x8 ua;
        { const float* s = UF + (size_t)(base + i32) * 512 + 16 * g + 8 * hh;
          const f32x4 a = *(const f32x4*)s, d = *(const f32x4*)(s + 4);
          *(LAS f32x4*)(Uw + i32 * 16 + 8 * hh) = a; *(LAS f32x4*)(Uw + i32 * 16 + 8 * hh + 4) = d;
          u32x4 o; o.x = pk2(a.x, a.y); o.y = pk2(a.z, a.w); o.z = pk2(d.x, d.y); o.w = pk2(d.z, d.w); ua = __builtin_bit_cast(bf16x8, o); }
        f32x16 bu0, bu1, bu2, bu3;
        { const bf16_t* bs = WSP(bf16_t, WS_BBST) + ((size_t)g * 128 + i32) * 16 + 8 * hh;
          bu0 = mfma32(ua, *(const bf16x8*)(bs), zero16());
          bu1 = mfma32(ua, *(const bf16x8*)(bs + 32 * 16), zero16());
          bu2 = mfma32(ua, *(const bf16x8*)(bs + 64 * 16), zero16());
          bu3 = mfma32(ua, *(const bf16x8*)(bs + 96 * 16), zero16()); }
        const f32x2 a0 = WSP(f32x2, WS_ABAR)[g * 64 + i32], a1 = WSP(f32x2, WS_ABAR)[g * 64 + 32 + i32];
        float dp = 0.f; if (MODE >= 1) dp = P.in[19][16 * g + (i32 & 15)];
        bf16x8 cfr[8]; float h0v[4][4];
        if (MODE >= 1) { const bf16_t* cbp = WSP(bf16_t, WS_CSTB) + (size_t)(g * 32 + i32) * 128 + 8 * hh;
#pragma unroll
            for (int ks = 0; ks < 8; ++ks) cfr[ks] = *(const bf16x8*)(cbp + 16 * ks); }
        if (MODE == 2) {
#pragma unroll
            for (int m = 0; m < 4; ++m) { const size_t so = (size_t)((4 * unit + m) * 32 + g) * 64 + i32;
                h0v[m][0] = P.in[7][so]; h0v[m][1] = P.in[8][so]; h0v[m][2] = P.in[7][so + 32]; h0v[m][3] = P.in[8][so + 32]; } }
        float x0r = 0.f, x0i = 0.f, x1r = 0.f, x1i = 0.f;
        if (MODE == 1) { const f32x2 v0 = CR[gi * 64 + i32], v1 = CR[gi * 64 + 32 + i32]; x0r = v0.x; x0i = v0.y; x1r = v1.x; x1i = v1.y; }
#pragma unroll
        for (int m = 0; m < 4; ++m) {
#pragma unroll
            for (int ps = 0; ps < 2; ++ps) {
                if (MODE == 2 && ps == 0) { x0r = h0v[m][0]; x0i = h0v[m][1]; x1r = h0v[m][2]; x1i = h0v[m][3]; }
#pragma unroll
                for (int e = 0; e < 4; ++e) { const int r = 4 * m + e;
                    const float n0r = a0.x * x0r - a0.y * x0i + bu0[r], n0i = a0.x * x0i + a0.y * x0r + bu2[r];
                    const float n1r = a1.x * x1r - a1.y * x1i + bu1[r], n1i = a1.x * x1i + a1.y * x1r + bu3[r];
                    x0r = n0r; x0i = n0i; x1r = n1r; x1i = n1i;
                    if (MODE >= 1 && hh == ps) { LAS bf16_t* xp = Xw + (8 * m + 4 * ps + e) * 136 + i32;
                        xp[0] = (bf16_t)f2bf(x0r); xp[32] = (bf16_t)f2bf(x1r); xp[64] = (bf16_t)f2bf(x0i); xp[96] = (bf16_t)f2bf(x1i); }
                }
                if (MODE == 2 && ps == 1 && hh == 1) { const int bs = 4 * unit + m; const size_t so = (size_t)(bs * 32 + g) * 64 + i32;
                    F.out[O_SRE_S + so] = x0r; F.out[O_SIM_S + so] = x0i; F.out[O_SRE_S + so + 32] = x1r; F.out[O_SIM_S + so + 32] = x1i; }
                x0r = other_half(x0r, hh); x0i = other_half(x0i, hh); x1r = other_half(x1r, hh); x1i = other_half(x1i, hh);
            }
        }
        if (MODE == 0 && hh == 0) { f32x2* d = WSP(f32x2, WS_SCH) + ((size_t)(b * 128 + c) * 32 + g) * 64 + i32; d[0] = (f32x2){x0r, x0i}; d[32] = (f32x2){x1r, x1i}; }
        if (MODE == 1 && c == 127 && hh == 0) { const size_t so = (size_t)(b * 32 + g) * 64 + i32;
            F.out[O_SRE_P + so] = x0r; F.out[O_SIM_P + so] = x0i; F.out[O_SRE_P + so + 32] = x1r; F.out[O_SIM_P + so + 32] = x1i; }
        if (MODE >= 1) {
            LDS_WAIT();
            f32x16 acc = zero16();
            bf16x8 xa[8]; float uv[16];
#pragma unroll
            for (int ks = 0; ks < 8; ++ks) xa[ks] = *(LAS bf16x8*)(Xw + i32 * 136 + 16 * ks + 8 * hh);
#pragma unroll
            for (int r = 0; r < 16; ++r) uv[r] = Uw[crow(r, hh) * 16 + (i32 & 15)];
            __builtin_amdgcn_sched_barrier(0);
#pragma unroll
            for (int ks = 0; ks < 8; ++ks) acc = mfma32(xa[ks], cfr[ks], acc);
            asm volatile("" : "+v"(dp));
            if (i32 < 16) {
#pragma unroll
                for (int r = 0; r < 16; ++r) { const int t = crow(r, hh); const float y = acc[r] + dp * uv[r];
                    const float gl = y * sigmoidf_(1.5957691216057308f * (y + 0.044715f * y * y * y));
                    Gt[t * SSM_G_PITCH + 16 * g + i32] = (bf16_t)f2bf(gl); } }
        }
        LDS_WAIT();
    }
    if (MODE >= 1) {
        __syncthreads();
        const u32x4* gf = WSP(u32x4, WS_GLUF) + lane;
        u32x4 fa[8], fb[8];
#define GLU_LOAD(dst, cbk_, q8_) do { _Pragma("unroll") for (int k_ = 0; k_ < 8; ++k_) dst[k_] = gf[(size_t)((cbk_) * 32 + (q8_) * 8 + k_) * 64]; __builtin_amdgcn_sched_barrier(0); } while (0)
#define GLU_MMA(src, q8_) do { bf16x8 ga_[8]; _Pragma("unroll") for (int k_ = 0; k_ < 8; ++k_) ga_[k_] = *(LAS bf16x8*)(Gt + i32 * SSM_G_PITCH + 16 * ((q8_) * 8 + k_) + 8 * hh); __builtin_amdgcn_sched_barrier(0); \
        _Pragma("unroll") for (int k_ = 0; k_ < 8; ++k_) acc = mfma32(ga_[k_], __builtin_bit_cast(bf16x8, src[k_]), acc); __builtin_amdgcn_sched_barrier(0); } while (0)
#define GLU_EPI(cbk_, bias) do { const int ch = (cbk_) * 32 + i32; \
            float gvv_[16]; _Pragma("unroll") for (int r = 0; r < 16; ++r) gvv_[r] = bf2f(Gt[crow(r, hh) * SSM_G_PITCH + ch]); \
            _Pragma("unroll") for (int r = 0; r < 16; ++r) { const int t = crow(r, hh); const float gv = gvv_[r]; \
                WSP(bf16_t, WS_YSSM)[(size_t)(base + t) * 512 + ch] = (bf16_t)f2bf(gv * sigmoidf_(acc[r] + bias)); } } while (0)
        f32x16 acc = zero16();
        const float bias0 = P.in[21][(2 * w) * 32 + i32], bias1 = P.in[21][(2 * w + 1) * 32 + i32];
        GLU_LOAD(fa, 2 * w, 0); GLU_LOAD(fb, 2 * w, 1);
        GLU_MMA(fa, 0); GLU_LOAD(fa, 2 * w, 2);
        GLU_MMA(fb, 1); GLU_LOAD(fb, 2 * w, 3);
        GLU_MMA(fa, 2); GLU_LOAD(fa, 2 * w + 1, 0);
        GLU_MMA(fb, 3); GLU_LOAD(fb, 2 * w + 1, 1);
        GLU_EPI(2 * w, bias0);
        acc = zero16();
        GLU_MMA(fa, 0); GLU_LOAD(fa, 2 * w + 1, 2);
        GLU_MMA(fb, 1); GLU_LOAD(fb, 2 * w + 1, 3);
        GLU_MMA(fa, 2);
        GLU_MMA(fb, 3);
        GLU_EPI(2 * w + 1, bias1);
#undef GLU_LOAD
#undef GLU_MMA
#undef GLU_EPI
        __syncthreads();
    }
}

template <bool MLA> struct AttnCfg { static constexpr int DQK = MLA ? 192 : 128, KS = DQK / 16, CK = DQK / 8  , KBYTES = 64 * DQK * 2, VBYTES = 128 * 128,
                                     BUF = KBYTES + VBYTES, NDMA = BUF / (512 * 16), RK_OFF = 3 * BUF; };
template <bool MLA> __device__ __forceinline__ int aswz_k(int row) { return MLA ? ((row >> 1) & 7) : (row & 15); }
__device__ __forceinline__ int aswz_v(int row) { return (row >> 1) & 7; }
template <bool MLA>
__device__ __forceinline__ void attn_qblock(Frame& F, int b, int h, int qb, bool rk_valid = false) {
    typedef AttnCfg<MLA> C;
    int tid = F.tid; asm volatile("" : "+v"(tid));
    const int lane = tid & 63, w = F.wave, i32 = lane & 31, hh = lane >> 5, qs = w & 3, kh = w >> 2;
    const int qrow = qb * 128 + qs * 32 + i32, grow = b * SEQ + qrow;
    LAS unsigned char* lds = F.lds;
    const int ntiles = MLA ? 2 * qb + 2 : 4;
    unsigned goff[C::NDMA], gstr[C::NDMA];
#pragma unroll
    for (int k = 0; k < C::NDMA; ++k) {
        const int L = k * 512 + tid;
        if (L < 64 * C::CK) {
            const int row = L / C::CK, lc = (L % C::CK) ^ aswz_k<MLA>(row);
            if (MLA) {
                if (lc < 16) { goff[k] = (unsigned)(WS_KNB + (((size_t)(b * 8 + h) * SEQ + row) * 128 + lc * 8) * 2); gstr[k] = 64 * 128 * 2; }
                else         { goff[k] = (unsigned)(WS_KRB + (((size_t)b * SEQ + row) * 64 + (lc - 16) * 8) * 2); gstr[k] = 64 * 64 * 2; }
            } else { goff[k] = (unsigned)(WS_MKB + (((size_t)(b * 4 + h) * MEMT + row) * 128 + lc * 8) * 2); gstr[k] = 64 * 128 * 2; }
        } else {
            const int Lv = L - 64 * C::CK, row = Lv >> 3, lc = (Lv & 7) ^ aswz_v(row);
            if (MLA) goff[k] = (unsigned)(WS_VT + (((size_t)(b * 8 + h) * 128 + row) * SEQ + lc * 8) * 2);
            else     goff[k] = (unsigned)(WS_VTM + (((size_t)(b * 4 + h) * 128 + row) * MEMT + lc * 8) * 2);
            gstr[k] = 64 * 2;
        }
    }
#define ATT_ISSUE(j) ATT_ISSUE_AT(j, ((j) % 3) * C::BUF)
#define ATT_ISSUE_AT(j, boff_) do { const int bo_ = (boff_) + w * 1024; _Pragma("unroll") for (int k_ = 0; k_ < C::NDMA; ++k_) \
        __builtin_amdgcn_global_load_lds((const unsigned*)(F.ws + goff[k_] + (size_t)(j) * gstr[k_]), (LAS unsigned*)(lds + bo_ + k_ * 8192), 16, 0, 0); } while (0)
    if (MLA && !rk_valid) {
        LAS float* rk = (LAS float*)(lds + C::RK_OFF);
        const int nk = ntiles * 64;
#pragma unroll 1
        for (int t0 = 0; t0 < nk; t0 += 2048) {
            f32x4 spv[4]; float krv[4];
#pragma unroll
            for (int u = 0; u < 4; ++u) { const int t = t0 + u * 512 + tid, gk = b * SEQ + (t < nk ? t : nk - 1);
                spv[u] = *(const f32x4*)(WSP(float, WS_SSQ_KN) + ((size_t)gk * 8 + h) * 4); krv[u] = WSP(float, WS_SSQ_KR)[gk]; }
            __builtin_amdgcn_sched_barrier(0);
#pragma unroll
            for (int u = 0; u < 4; ++u) { const int t = t0 + u * 512 + tid; const f32x4 sp = spv[u];
                if (t < nk) rk[t] = __builtin_amdgcn_rsqf(((sp.x + sp.y) + (sp.z + sp.w) + krv[u]) * (1.f / 192.f) + EPS); }
        }
    }
    bf16x8 qf[C::KS]; float M2;
    if (MLA) {
        const float* sp = WSP(float, WS_SSQ_Q) + ((size_t)grow * 8 + h) * 8;
        const float sr = (sp[0] + sp[2]) + (sp[4] + sp[6]), sg = (sp[1] + sp[3]) + (sp[5] + sp[7]);
        const float rinv = 1.0f / sqrtf(sr * (1.f / 192.f) + EPS);
        M2 = 13.856406460551018f * rinv * sqrtf(sg);
        const bf16_t* qp = WSP(bf16_t, WS_QG) + (size_t)grow * 1536 + h * 192 + 8 * hh;
        u32x4 qraw[C::KS];
#pragma unroll
        for (int ks = 0; ks < C::KS; ++ks) qraw[ks] = *(const u32x4*)(qp + 16 * ks);
        __builtin_amdgcn_sched_barrier(0);
#pragma unroll
        for (int ks = 0; ks < C::KS; ++ks) { const u32x4 v = qraw[ks]; u32x4 o;
            o.x = pk2(bflo(v.x) * rinv, bfhi(v.x) * rinv); o.y = pk2(bflo(v.y) * rinv, bfhi(v.y) * rinv); o.z = pk2(bflo(v.z) * rinv, bfhi(v.z) * rinv); o.w = pk2(bflo(v.w) * rinv, bfhi(v.w) * rinv);
            qf[ks] = __builtin_bit_cast(bf16x8, o); }
    } else {
        M2 = WSP(float, WS_MQM)[grow * 4 + h];
        const bf16_t* qp = WSP(bf16_t, WS_QM) + (size_t)grow * 512 + h * 128 + 8 * hh;
#pragma unroll
        for (int ks = 0; ks < C::KS; ++ks) qf[ks] = *(const bf16x8*)(qp + 16 * ks);
    }
    asm volatile("s_waitcnt vmcnt(0) lgkmcnt(0)" ::: "memory");
    ATT_ISSUE(0); ATT_ISSUE(1);
    f32x16 o[4]; o[0] = zero16(); o[1] = zero16(); o[2] = zero16(); o[3] = zero16();
    float lsum = 0.f;
    const int kswz = aswz_k<MLA>(kh * 32 + i32), vswz = aswz_v(i32);
    int kx[4];
#pragma unroll
    for (int m = 0; m < 4; ++m) kx[m] = 16 * ((2 * m + hh) ^ kswz);
    int bcur = 0;
    for (int j = 0; j < ntiles; ++j) {
        if (j + 1 < ntiles) { if (C::NDMA == 5) asm volatile("s_waitcnt vmcnt(5)" ::: "memory"); else asm volatile("s_waitcnt vmcnt(4)" ::: "memory"); }
        else asm volatile("s_waitcnt vmcnt(0)" ::: "memory");
        __builtin_amdgcn_s_barrier(); asm volatile("" ::: "memory");
        if (j + 2 < ntiles) { int b2 = bcur + 2 * C::BUF; if (b2 >= 3 * C::BUF) b2 -= 3 * C::BUF; ATT_ISSUE_AT(j + 2, b2); }
        const LAS unsigned char* kt = lds + bcur + (kh * 32 + i32) * (C::CK * 16);
        constexpr int KH = C::KS / 2;
        bf16x8 kf[KH];
#pragma unroll
#define K_ADDR(ks_) (MLA ? kt + kx[(ks_) & 3] + 128 * ((ks_) >> 2) : kt + 16 * ((2 * (ks_) + hh) ^ kswz))
        for (int ks = 0; ks < KH; ++ks) kf[ks] = *(const LAS bf16x8*)K_ADDR(ks);
        __builtin_amdgcn_sched_barrier(0);
        f32x16 s = zero16();
#pragma unroll
        for (int ks = 0; ks < KH; ++ks) { s = mfma32(kf[ks], qf[ks], s); kf[ks] = *(const LAS bf16x8*)K_ADDR(ks + KH); __builtin_amdgcn_sched_barrier(0); }
#undef K_ADDR
#pragma unroll
        for (int ks = 0; ks < KH; ++ks) s = mfma32(kf[ks], qf[ks + KH], s);
        float p[16];
        if (MLA) {
            const LAS float* rk = (const LAS float*)(lds + C::RK_OFF) + j * 64 + kh * 32 + 4 * hh;
#pragma unroll
            for (int g4 = 0; g4 < 4; ++g4) { const f32x4 r4 = *(const LAS f32x4*)(rk + 8 * g4);
#pragma unroll
                for (int e = 0; e < 4; ++e) p[4 * g4 + e] = s[4 * g4 + e] * r4[e] - M2; }
            if (j >= 2 * qb) {
                const int kbase = j * 64 + kh * 32 + 4 * hh;
#pragma unroll
                for (int r = 0; r < 16; ++r) if (kbase + (r & 3) + 8 * (r >> 2) > qrow) p[r] = -__builtin_inff();
            }
        } else {
#pragma unroll
            for (int r = 0; r < 16; ++r) p[r] = s[r] - M2;
        }
#pragma unroll
        for (int r = 0; r < 16; ++r) { p[r] = ex2(p[r]); lsum += p[r]; }
        u32x4 w0, w1; w0.x = pk2(p[0], p[1]); w0.y = pk2(p[2], p[3]); w0.z = pk2(p[4], p[5]); w0.w = pk2(p[6], p[7]);
        w1.x = pk2(p[8], p[9]); w1.y = pk2(p[10], p[11]); w1.z = pk2(p[12], p[13]); w1.w = pk2(p[14], p[15]);
        const bf16x8 pb0 = __builtin_bit_cast(bf16x8, w0), pb1 = __builtin_bit_cast(bf16x8, w1);
        const LAS unsigned char* vt = lds + bcur + C::KBYTES + i32 * 128;
        bf16x8 vf[8];
#pragma unroll
        for (int db = 0; db < 4; ++db) {
            vf[2 * db] = *(const LAS bf16x8*)(vt + db * 32 * 128 + 16 * ((kh * 4 + hh) ^ vswz));
            vf[2 * db + 1] = *(const LAS bf16x8*)(vt + db * 32 * 128 + 16 * ((kh * 4 + 2 + hh) ^ vswz)); }
        __builtin_amdgcn_sched_barrier(0);
#pragma unroll
        for (int db = 0; db < 4; ++db) { o[db] = mfma32(vf[2 * db], pb0, o[db]); o[db] = mfma32(vf[2 * db + 1], pb1, o[db]); }
        bcur += C::BUF; if (bcur == 3 * C::BUF) bcur = 0;
    }
#undef ATT_ISSUE
#undef ATT_ISSUE_AT
    __syncthreads();
    lsum += __shfl_xor(lsum, 32);
    asm volatile("" : "+v"(tid));
    const int lane_e = tid & 63, hh_e = lane_e >> 5;
    const int grow_e = b * SEQ + qb * 128 + qs * 32 + (lane_e & 31);
    LAS float* xo = (LAS float*)lds + qs * 4096;
    LAS float* xl = (LAS float*)lds + 4 * 4096 + qs * 64;
#define lane lane_e
#define hh hh_e
#define grow grow_e
    if (kh == 1) {
#pragma unroll
        for (int db = 0; db < 4; ++db)
#pragma unroll
            for (int r = 0; r < 16; ++r) xo[(db * 16 + r) * 64 + lane] = o[db][r];
        xl[lane] = lsum;
    }
    __syncthreads();
    if (kh == 0) {
        float xv[4][16];
#pragma unroll
        for (int db = 0; db < 4; ++db)
#pragma unroll
            for (int r = 0; r < 16; ++r) xv[db][r] = xo[(db * 16 + r) * 64 + lane];
        const float inv = 1.0f / (lsum + xl[lane]);
        bf16_t* yp = MLA ? WSP(bf16_t, WS_YMLA) + (size_t)grow * 1024 + h * 128 : WSP(bf16_t, WS_YMEM) + (size_t)grow * 512 + h * 128;
#pragma unroll
        for (int db = 0; db < 4; ++db)
#pragma unroll
            for (int g4 = 0; g4 < 4; ++g4) { f32x4 v;
#pragma unroll
                for (int e = 0; e < 4; ++e) v[e] = (o[db][4 * g4 + e] + xv[db][4 * g4 + e]) * inv;
                st_bf4(yp + db * 32 + 8 * g4 + 4 * hh, v); }
    }
        __syncthreads();
#undef lane
#undef hh
#undef grow
}

constexpr int SM_CT = 0, SM_RT = 65536, SM_QA = SM_RT + 128 * 128, SM_QP = 328, SM_C8 = SM_QA + 64 * SM_QP * 2, SM_PT = SM_C8  , SM_PP = 136,
              SM_RINV = SM_C8 + 32768, SM_LX = SM_RINV  , SM_SSQR = SM_RINV + 8 * 128 * 4, SM_M2 = SM_SSQR + 512, SM_END = SM_M2 + 256;
static_assert(SM_END <= LDS_MISC && 64 * SM_PP * 2 <= 32768, "sample-MLA LDS map");
__device__ __forceinline__ int rt_off(int row, int col) { return row * 128 + 16 * ((col >> 3) ^ ((row >> 1) & 7)) + (col & 7) * 2; }
__device__ __forceinline__ int c8_off(int row, int col) { return 256 * row + 16 * ((col >> 4) ^ (((row & 3) << 2) | ((row >> 2) & 3))) + (col & 15); }
__device__ __forceinline__ int ct_off(int row, int col) {
    const int ch = (col & 127) >> 3;
    return ((col >> 7) << 15) + 256 * row + 16 * (ch ^ (((row & 3) << 2) | ((row >> 2) & 3))) + (col & 7) * 2;
}
typedef int i32x8 __attribute__((ext_vector_type(8)));
__device__ __forceinline__ f32x16 mfma8(const u32x4 a0, const u32x4 a1, const u32x4 b0, const u32x4 b1, const f32x16 c) {
    const i32x8 a = {(int)a0.x, (int)a0.y, (int)a0.z, (int)a0.w, (int)a1.x, (int)a1.y, (int)a1.z, (int)a1.w};
    const i32x8 b = {(int)b0.x, (int)b0.y, (int)b0.z, (int)b0.w, (int)b1.x, (int)b1.y, (int)b1.z, (int)b1.w};
    return __builtin_amdgcn_mfma_scale_f32_32x32x64_f8f6f4(a, b, c, 0, 0, 0, 0x7f7f7f7f, 0, 0x7f7f7f7f);
}
template <int W2, bool LOADN>
__device__ __forceinline__ void z_pass(const u32x4 (&cur)[8], u32x4 (&nxt)[8], LAS unsigned char* lds, int tb0, int i32, int hh, float& sa, float& sb, __amdgpu_buffer_rsrc_t rs, int voff, int soff_next) {
    f32x16 acc[W2];
#pragma unroll
    for (int q = 0; q < W2; ++q) acc[q] = zero16();
    u32x4 bc[W2][2], bn[W2][2];
#pragma unroll
    for (int q = 0; q < W2; ++q) { bc[q][0] = *(LAS u32x4*)(lds + SM_C8 + c8_off((tb0 + q) * 32 + i32, 32 * hh)); bc[q][1] = *(LAS u32x4*)(lds + SM_C8 + c8_off((tb0 + q) * 32 + i32, 32 * hh + 16)); }
#pragma unroll
    for (int ks = 0; ks < 4; ++ks) {
        if (ks < 3) {
#pragma unroll
            for (int q = 0; q < W2; ++q) { bn[q][0] = *(LAS u32x4*)(lds + SM_C8 + c8_off((tb0 + q) * 32 + i32, 64 * (ks + 1) + 32 * hh)); bn[q][1] = *(LAS u32x4*)(lds + SM_C8 + c8_off((tb0 + q) * 32 + i32, 64 * (ks + 1) + 32 * hh + 16)); }
        }
        __builtin_amdgcn_s_setprio(1);
#pragma unroll
        for (int q = 0; q < W2; ++q) acc[q] = mfma8(cur[2 * ks], cur[2 * ks + 1], bc[q][0], bc[q][1], acc[q]);
        __builtin_amdgcn_s_setprio(0);
        if (LOADN) { nxt[2 * ks] = __builtin_bit_cast(u32x4, __builtin_amdgcn_raw_buffer_load_b128(rs, voff, soff_next + ks * 2048, 0)); nxt[2 * ks + 1] = __builtin_bit_cast(u32x4, __builtin_amdgcn_raw_buffer_load_b128(rs, voff, soff_next + ks * 2048 + 16, 0)); }
#pragma unroll
        for (int q = 0; q < W2; ++q) { bc[q][0] = bn[q][0]; bc[q][1] = bn[q][1]; }
        __builtin_amdgcn_sched_barrier(0);
    }
#pragma unroll
    for (int q = 0; q < W2; ++q) { f32x2 p2 = (f32x2){0.f, 0.f};
#pragma unroll
        for (int r = 0; r < 16; r += 2) { const f32x2 a2 = (f32x2){acc[q][r], acc[q][r + 1]}; p2 = __builtin_elementwise_fma(a2, a2, p2); }
        float s0 = p2.x + p2.y;
        asm volatile("" : "+v"(s0));
        if (q == 0) sa += s0; else sb += s0; }
    __builtin_amdgcn_sched_barrier(0);
}
__device__ __forceinline__ void z_load(u32x4 (&af)[8], __amdgpu_buffer_rsrc_t rs, int voff, int soff) {
#pragma unroll
    for (int ks = 0; ks < 4; ++ks) { af[2 * ks] = __builtin_bit_cast(u32x4, __builtin_amdgcn_raw_buffer_load_b128(rs, voff, soff + ks * 2048, 0)); af[2 * ks + 1] = __builtin_bit_cast(u32x4, __builtin_amdgcn_raw_buffer_load_b128(rs, voff, soff + ks * 2048 + 16, 0)); }
}
__device__ __forceinline__ u32x2 bf8_to_fp8(const u32x4 v) {
    u32x2 o; int t;
    t = __builtin_amdgcn_cvt_pk_fp8_f32(bflo(v.x), bfhi(v.x), 0, false); t = __builtin_amdgcn_cvt_pk_fp8_f32(bflo(v.y), bfhi(v.y), t, true); o.x = (unsigned)t;
    t = __builtin_amdgcn_cvt_pk_fp8_f32(bflo(v.z), bfhi(v.z), 0, false); t = __builtin_amdgcn_cvt_pk_fp8_f32(bflo(v.w), bfhi(v.w), t, true); o.y = (unsigned)t;
    return o;
}
__device__ __forceinline__ void ct_store(LAS unsigned char* lds, int row, int col, const u32x4 o) {
    *(LAS u32x4*)(lds + SM_CT + ct_off(row, col)) = o;
    *(LAS u32x2*)(lds + SM_C8 + c8_off(row, col)) = bf8_to_fp8(o);
}
struct Pf { u32x4 pk[10]; f32x4 sa0, sa1, sb0, sb1, ta0, ta1, tb0, tb1; float ssr0, ssr1; };
template <int IT> __device__ __forceinline__ void pf_issue1(f32x4& a, f32x4& d, __amdgpu_buffer_rsrc_t rc, __amdgpu_buffer_rsrc_t rr, int tid) {
    const __amdgpu_buffer_rsrc_t r = (IT < 8) ? rc : rr; constexpr int so = (IT < 8 ? IT : IT - 8) * 16384;
    a = __builtin_bit_cast(f32x4, __builtin_amdgcn_raw_buffer_load_b128(r, tid * 32, so, 0)); d = __builtin_bit_cast(f32x4, __builtin_amdgcn_raw_buffer_load_b128(r, tid * 32, so + 16, 0));
}
template <int IT> __device__ __forceinline__ void pf_convert1(Pf& pf, const f32x4 a, const f32x4 d) {
    u32x4 o; o.x = pk2(a.x, a.y); o.y = pk2(a.z, a.w); o.z = pk2(d.x, d.y); o.w = pk2(d.z, d.w); pf.pk[IT] = o;
    if (IT >= 8) { float ss = sq4(a) + sq4(d); ss += __shfl_xor(ss, 1); ss += __shfl_xor(ss, 2); ss += __shfl_xor(ss, 4); if (IT == 8) pf.ssr0 = ss; else pf.ssr1 = ss; }
}
template <int J> __device__ __forceinline__ void pf_slot(Pf& pf, __amdgpu_buffer_rsrc_t rc, __amdgpu_buffer_rsrc_t rr, int tid, bool on) {
    (void)on;
    {
        if (J >= 1) { pf_convert1<(J >= 1 ? 2 * J - 2 : 0)>(pf, pf.sa0, pf.sa1); pf_convert1<(J >= 1 ? 2 * J - 1 : 1)>(pf, pf.sb0, pf.sb1); }
        if (J < 5) { pf_issue1<(J < 5 ? 2 * J : 0)>(pf.sa0, pf.sa1, rc, rr, tid); pf_issue1<(J < 5 ? 2 * J + 1 : 1)>(pf.sb0, pf.sb1, rc, rr, tid); }
    }
    __builtin_amdgcn_sched_barrier(0);
}
template <int G, int SET> __device__ __forceinline__ void pf_issue2(Pf& pf, __amdgpu_buffer_rsrc_t rc, __amdgpu_buffer_rsrc_t rr, int tid) {
    if (SET == 0) { pf_issue1<2 * G>(pf.sa0, pf.sa1, rc, rr, tid); pf_issue1<2 * G + 1>(pf.sb0, pf.sb1, rc, rr, tid); }
    else          { pf_issue1<2 * G>(pf.ta0, pf.ta1, rc, rr, tid); pf_issue1<2 * G + 1>(pf.tb0, pf.tb1, rc, rr, tid); }
}
template <int G, int SET> __device__ __forceinline__ void pf_conv2(Pf& pf) {
    if (SET == 0) { pf_convert1<2 * G>(pf, pf.sa0, pf.sa1); pf_convert1<2 * G + 1>(pf, pf.sb0, pf.sb1); }
    else          { pf_convert1<2 * G>(pf, pf.ta0, pf.ta1); pf_convert1<2 * G + 1>(pf, pf.tb0, pf.tb1); }
}
template <int J> __device__ __forceinline__ void pf_mid(Pf& pf, __amdgpu_buffer_rsrc_t rc, __amdgpu_buffer_rsrc_t rr, int tid) {
    __builtin_amdgcn_sched_barrier(0);
    if (J == 0) pf_issue2<0, 0>(pf, rc, rr, tid);
    if (J == 1) pf_issue2<1, 1>(pf, rc, rr, tid);
    if (J == 2) { pf_conv2<0, 0>(pf); pf_issue2<2, 0>(pf, rc, rr, tid); }
    if (J == 3) { pf_conv2<1, 1>(pf); pf_issue2<3, 1>(pf, rc, rr, tid); }
    if (J == 4) { pf_conv2<2, 0>(pf); pf_issue2<4, 0>(pf, rc, rr, tid); }
    if (J == 5) pf_conv2<3, 1>(pf);
    if (J == 6) pf_conv2<4, 0>(pf);
    __builtin_amdgcn_sched_barrier(0);
}
template <int IT> __device__ __forceinline__ void pf_slot_off(Pf&, __amdgpu_buffer_rsrc_t, __amdgpu_buffer_rsrc_t, int, bool) {}
__device__ __forceinline__ void pf_commit(Pf& pf, LAS unsigned char* lds, int tid) {
    const int r0 = (tid >> 5) & 15, col = (tid & 31) * 8;
    LAS unsigned char* cb = lds + SM_CT + ct_off(r0, col); LAS unsigned char* c8b = lds + SM_C8 + c8_off(r0, col);
#pragma unroll
    for (int it = 0; it < 8; ++it) { *(LAS u32x4*)(cb + 4096 * it) = pf.pk[it]; *(LAS u32x2*)(c8b + 4096 * it) = bf8_to_fp8(pf.pk[it]); }
    const int rr0 = (tid >> 3) & 63;
    LAS unsigned char* rb = lds + SM_RT + rt_off(rr0, (tid & 7) * 8);
#pragma unroll
    for (int it = 0; it < 2; ++it) { *(LAS u32x4*)(rb + 8192 * it) = pf.pk[8 + it];
        if ((tid & 7) == 0) ((LAS float*)(lds + SM_SSQR))[it * 64 + rr0] = it ? pf.ssr1 : pf.ssr0; }
}
__device__ __forceinline__ void smla_load_page(const Params& P, LAS unsigned char* lds, int page, int tid) {
    const float* cs = P.in[3] + (size_t)page * (PAGE * 256); const float* rs = P.in[4] + (size_t)page * (PAGE * 64);
    {
        f32x4 ra[6], rd[6];
#pragma unroll
        for (int it = 0; it < 4; ++it) { const int id = it * 512 + tid; ra[it] = *(const f32x4*)(cs + (size_t)id * 8); rd[it] = *(const f32x4*)(cs + (size_t)id * 8 + 4); }
#pragma unroll
        for (int it = 0; it < 2; ++it) { const int id = it * 512 + tid; ra[4 + it] = *(const f32x4*)(rs + (size_t)id * 8); rd[4 + it] = *(const f32x4*)(rs + (size_t)id * 8 + 4); }
        __builtin_amdgcn_sched_barrier(0);
#pragma unroll
        for (int it = 0; it < 4; ++it) { const int id = it * 512 + tid, row = id >> 5, col = (id & 31) * 8;
            const f32x4 a = ra[it], d = rd[it];
            u32x4 o; o.x = pk2(a.x, a.y); o.y = pk2(a.z, a.w); o.z = pk2(d.x, d.y); o.w = pk2(d.z, d.w);
            ct_store(lds, row, col, o); }
#pragma unroll
        for (int it = 0; it < 2; ++it) { const int id = it * 512 + tid, row = id >> 3, c8 = (id & 7) * 8;
            const f32x4 a = ra[4 + it], d = rd[4 + it];
            u32x4 o; o.x = pk2(a.x, a.y); o.y = pk2(a.z, a.w); o.z = pk2(d.x, d.y); o.w = pk2(d.z, d.w);
            *(LAS u32x4*)(lds + SM_RT + rt_off(row, c8)) = o;
            float ss = sq4(a) + sq4(d); ss += __shfl_xor(ss, 1); ss += __shfl_xor(ss, 2); ss += __shfl_xor(ss, 4);
            if ((id & 7) == 0) ((LAS float*)(lds + SM_SSQR))[row] = ss; }
    }
    __builtin_amdgcn_sched_barrier(0);
    {
        f32x4 ra[4], rd[4];
#pragma unroll
        for (int it = 0; it < 4; ++it) { const int id = (it + 4) * 512 + tid; ra[it] = *(const f32x4*)(cs + (size_t)id * 8); rd[it] = *(const f32x4*)(cs + (size_t)id * 8 + 4); }
        __builtin_amdgcn_sched_barrier(0);
#pragma unroll
        for (int it = 0; it < 4; ++it) { const int id = (it + 4) * 512 + tid, row = id >> 5, col = (id & 31) * 8;
            const f32x4 a = ra[it], d = rd[it];
            u32x4 o; o.x = pk2(a.x, a.y); o.y = pk2(a.z, a.w); o.z = pk2(d.x, d.y); o.w = pk2(d.z, d.w);
            ct_store(lds, row, col, o); }
    }
}
__device__ __forceinline__ void smla_load_fresh(Frame& F, LAS unsigned char* lds, int bs, int tid) {
    asm volatile("" : "+v"(tid));
    const bool v0 = tid < 256, v1 = tid < 64;
    const u32x4 l0 = *(const u32x4*)(WSP(bf16_t, WS_CKVS) + (size_t)(bs * 8 + (v0 ? (tid >> 5) : 0)) * 256 + (tid & 31) * 8);
    const u32x4 l1 = *(const u32x4*)(WSP(bf16_t, WS_KRB) + (size_t)(NP + bs * 8 + (v1 ? (tid >> 3) : 0)) * 64 + (tid & 7) * 8);
    const float l2 = WSP(float, WS_SSQ_KR)[NP + bs * 8 + (tid & 7)];
    __builtin_amdgcn_sched_barrier(0);
    unsigned zz = 0u; asm volatile("" : "+v"(zz)); const u32x4 z = (u32x4){zz, zz, zz, zz};
    ct_store(lds, tid >> 5, (tid & 31) * 8, v0 ? l0 : z);
    ct_store(lds, (tid + 512) >> 5, (tid & 31) * 8, z);
    if (tid < 256) *(LAS u32x4*)(lds + SM_RT + rt_off(tid >> 3, (tid & 7) * 8)) = v1 ? l1 : z;
    if (tid < 32) ((LAS float*)(lds + SM_SSQR))[tid] = (tid < 8) ? l2 : 0.f;
}

template <int PAR, bool FRESH>
__device__ __forceinline__ void smla_tile(Frame& F, const Params& P, int next_page, f32x16 (&oacc)[2], float& lsum, u32x4 (&afX)[8], u32x4 (&afY)[8], __amdgpu_buffer_rsrc_t wrs) {
    int tid = F.tid; asm volatile("" : "+v"(tid));
    const int lane = tid & 63, w = F.wave, i32 = lane & 31, hh = lane >> 5;
    const int wvo = lane * 32, wso = w * 32768;
    LAS unsigned char* lds = F.lds;
    LAS bf16_t* RT = (LAS bf16_t*)(lds + SM_RT); LAS bf16_t* QA = (LAS bf16_t*)(lds + SM_QA); LAS bf16_t* PT = (LAS bf16_t*)(lds + SM_PT);
    LAS float* RINV = (LAS float*)(lds + SM_RINV); LAS float* SSQR = (LAS float*)(lds + SM_SSQR); LAS float* M2S = (LAS float*)(lds + SM_M2);
    const bool pfon = (next_page >= 0);
    const int npg = pfon ? next_page : 0;
    const __amdgpu_buffer_rsrc_t rc = __builtin_amdgcn_make_buffer_rsrc((void*)(P.in[3] + (size_t)npg * (PAGE * 256)), 0, pfon ? PAGE * 256 * 4 : 0, 0x00020000);
    const __amdgpu_buffer_rsrc_t rr = __builtin_amdgcn_make_buffer_rsrc((void*)(P.in[4] + (size_t)npg * (PAGE * 64)), 0, pfon ? PAGE * 64 * 4 : 0, 0x00020000);
    Pf pf;
    {
        float ssq[4] = {0.f, 0.f, 0.f, 0.f};
        constexpr int N1 = PAR ? 2 : 1, N2 = PAR ? 1 : 2, N3 = PAR ? 0 : 3;
        if (FRESH) {
            z_pass<1, true>(afX, afY, lds, 0, i32, hh, ssq[0], ssq[1], wrs, wvo, wso + N1 * 8192);
            z_pass<1, true>(afY, afX, lds, 0, i32, hh, ssq[0], ssq[1], wrs, wvo, wso + N2 * 8192);
            z_pass<1, true>(afX, afY, lds, 0, i32, hh, ssq[0], ssq[1], wrs, wvo, wso + N3 * 8192);
            z_pass<1, false>(afY, afX, lds, 0, i32, hh, ssq[0], ssq[1], wrs, wvo, 0);
        } else if (PAR == 0) {
            z_pass<2, true>(afX, afY, lds, 0, i32, hh, ssq[0], ssq[1], wrs, wvo, wso + N1 * 8192); pf_mid<0>(pf, rc, rr, tid);
            z_pass<2, false>(afX, afY, lds, 2, i32, hh, ssq[2], ssq[3], wrs, wvo, 0);
            z_pass<2, true>(afY, afX, lds, 0, i32, hh, ssq[0], ssq[1], wrs, wvo, wso + N2 * 8192); pf_mid<1>(pf, rc, rr, tid);
            z_pass<2, false>(afY, afX, lds, 2, i32, hh, ssq[2], ssq[3], wrs, wvo, 0);
            z_pass<2, true>(afX, afY, lds, 0, i32, hh, ssq[0], ssq[1], wrs, wvo, wso + N3 * 8192); pf_mid<2>(pf, rc, rr, tid);
            z_pass<2, false>(afX, afY, lds, 2, i32, hh, ssq[2], ssq[3], wrs, wvo, 0);
            z_pass<2, false>(afY, afX, lds, 0, i32, hh, ssq[0], ssq[1], wrs, wvo, 0); pf_mid<3>(pf, rc, rr, tid);
            z_pass<2, false>(afY, afX, lds, 2, i32, hh, ssq[2], ssq[3], wrs, wvo, 0);
            pf_mid<4>(pf, rc, rr, tid);
        } else {
            z_pass<2, true>(afY, afX, lds, 0, i32, hh, ssq[0], ssq[1], wrs, wvo, wso + N1 * 8192); pf_mid<0>(pf, rc, rr, tid);
            z_pass<2, false>(afY, afX, lds, 2, i32, hh, ssq[2], ssq[3], wrs, wvo, 0);
            z_pass<2, true>(afX, afY, lds, 0, i32, hh, ssq[0], ssq[1], wrs, wvo, wso + N2 * 8192); pf_mid<1>(pf, rc, rr, tid);
            z_pass<2, false>(afX, afY, lds, 2, i32, hh, ssq[2], ssq[3], wrs, wvo, 0);
            z_pass<2, true>(afY, afX, lds, 0, i32, hh, ssq[0], ssq[1], wrs, wvo, wso + N3 * 8192); pf_mid<2>(pf, rc, rr, tid);
            z_pass<2, false>(afY, afX, lds, 2, i32, hh, ssq[2], ssq[3], wrs, wvo, 0);
            z_pass<2, false>(afX, afY, lds, 0, i32, hh, ssq[0], ssq[1], wrs, wvo, 0); pf_mid<3>(pf, rc, rr, tid);
            z_pass<2, false>(afX, afY, lds, 2, i32, hh, ssq[2], ssq[3], wrs, wvo, 0);
            pf_mid<4>(pf, rc, rr, tid);
        }
#ifdef PROBE_Z3
        if (!FRESH) {
            for (int rz_ = 0; rz_ < 2; ++rz_) {
                ssq[0] = ssq[1] = ssq[2] = ssq[3] = 0.f;
                const bool fwd = ((PAR == 0) == (rz_ == 1));
                if (fwd) {
                    z_pass<2, true>(afX, afY, lds, 0, i32, hh, ssq[0], ssq[1], wrs, wvo, wso + 1 * 8192); z_pass<2, false>(afX, afY, lds, 2, i32, hh, ssq[2], ssq[3], wrs, wvo, 0);
                    z_pass<2, true>(afY, afX, lds, 0, i32, hh, ssq[0], ssq[1], wrs, wvo, wso + 2 * 8192); z_pass<2, false>(afY, afX, lds, 2, i32, hh, ssq[2], ssq[3], wrs, wvo, 0);
                    z_pass<2, true>(afX, afY, lds, 0, i32, hh, ssq[0], ssq[1], wrs, wvo, wso + 3 * 8192); z_pass<2, false>(afX, afY, lds, 2, i32, hh, ssq[2], ssq[3], wrs, wvo, 0);
                    z_pass<2, false>(afY, afX, lds, 0, i32, hh, ssq[0], ssq[1], wrs, wvo, 0); z_pass<2, false>(afY, afX, lds, 2, i32, hh, ssq[2], ssq[3], wrs, wvo, 0);
                } else {
                    z_pass<2, true>(afY, afX, lds, 0, i32, hh, ssq[0], ssq[1], wrs, wvo, wso + 2 * 8192); z_pass<2, false>(afY, afX, lds, 2, i32, hh, ssq[2], ssq[3], wrs, wvo, 0);
                    z_pass<2, true>(afX, afY, lds, 0, i32, hh, ssq[0], ssq[1], wrs, wvo, wso + 1 * 8192); z_pass<2, false>(afX, afY, lds, 2, i32, hh, ssq[2], ssq[3], wrs, wvo, 0);
                    z_pass<2, true>(afY, afX, lds, 0, i32, hh, ssq[0], ssq[1], wrs, wvo, wso + 0 * 8192); z_pass<2, false>(afY, afX, lds, 2, i32, hh, ssq[2], ssq[3], wrs, wvo, 0);
                    z_pass<2, false>(afX, afY, lds, 0, i32, hh, ssq[0], ssq[1], wrs, wvo, 0); z_pass<2, false>(afX, afY, lds, 2, i32, hh, ssq[2], ssq[3], wrs, wvo, 0);
                }
            }
        }
#endif
        constexpr int ntb = FRESH ? 1 : 4;
        float sqr[ntb];
#pragma unroll
        for (int tb = 0; tb < ntb; ++tb) sqr[tb] = SSQR[tb * 32 + i32];
#pragma unroll
        for (int tb = 0; tb < ntb; ++tb) { float s = ssq[tb]; s += __shfl_xor(s, 32);
            if (hh == 0) RINV[w * 128 + tb * 32 + i32] = __builtin_amdgcn_rsqf((s * (1.f / 256.f) + sqr[tb]) * (1.f / 192.f) + EPS); }
    }
    __syncthreads();
    int tid2 = tid; asm volatile("" : "+v"(tid2));
#ifdef PROBE_SPV2
    for (int rep_ = 0; rep_ < 2; ++rep_) {
    if (rep_) __syncthreads();
#else
    {
#endif
    const int lane = tid2 & 63, i32 = lane & 31, hh = lane >> 5;
    {
        const int tb = w & 3, rb = w >> 2;
        if (!FRESH || tb == 0) {
            f32x16 s = zero16();
            const LAS bf16_t* qa = QA + (rb * 32 + i32) * SM_QP + 8 * hh;
#define S_A(ks_) ((ks_) < 16 ? *(LAS bf16x8*)(lds + SM_CT + ct_off(tb * 32 + i32, 16 * (ks_) + 8 * hh)) : *(LAS bf16x8*)(lds + SM_RT + rt_off(tb * 32 + i32, 16 * ((ks_) - 16) + 8 * hh)))
#define S_B(ks_) (*(const LAS bf16x8*)(qa + ((ks_) < 16 ? 16 * (ks_) : 256 + 16 * ((ks_) - 16))))
            constexpr int SD = 4;
            const int head = rb * 4 + (i32 >> 3), qi = i32 & 7;
            const LAS float* rv = RINV + head * 128 + tb * 32 + 4 * hh;
            f32x4 r4v[4];
#pragma unroll
            for (int g4 = 0; g4 < 4; ++g4) r4v[g4] = *(const LAS f32x4*)(rv + 8 * g4);
            const float m2 = M2S[rb * 32 + i32];
            bf16x8 sa_[SD], sb_[SD];
#pragma unroll
            for (int ks = 0; ks < SD; ++ks) { sa_[ks] = S_A(ks); sb_[ks] = S_B(ks); }
            __builtin_amdgcn_sched_barrier(0);
#pragma unroll
            for (int ks = 0; ks < 20; ++ks) { s = mfma32(sa_[ks % SD], sb_[ks % SD], s);
                if (ks + SD < 20) { sa_[ks % SD] = S_A(ks + SD); sb_[ks % SD] = S_B(ks + SD); }
                __builtin_amdgcn_sched_barrier(0); }
#undef S_A
#undef S_B
#pragma unroll
            for (int g4 = 0; g4 < 4; ++g4) { const f32x4 r4 = r4v[g4]; float p[4];
#pragma unroll
                for (int e = 0; e < 4; ++e) { float x = s[4 * g4 + e] * r4[e] - m2; if (FRESH && (8 * g4 + 4 * hh + e) > qi) x = -__builtin_inff(); p[e] = ex2(x); lsum += p[e]; }
                u32x2 pw; pw.x = pk2(p[0], p[1]); pw.y = pk2(p[2], p[3]);
                *(LAS u32x2*)(PT + (rb * 32 + i32) * SM_PP + tb * 32 + 8 * g4 + 4 * hh) = pw; }
        }
    }
#ifdef PROBE_SPV2
    if (!FRESH && rep_ == 0) pf_mid<5>(pf, rc, rr, tid);
#else
    if (!FRESH) pf_mid<5>(pf, rc, rr, tid);
#endif
    __syncthreads();
    {
        const int rb = w >> 2, lb0 = 2 * (w & 3), nks = FRESH ? 2 : 8;
        const int blk = (lane >> 4) & 1, qq = (lane & 15) >> 2, pp = lane & 3;
        const LAS bf16_t* pt = PT + (rb * 32 + i32) * SM_PP + 8 * hh;
        constexpr int NKS = FRESH ? 2 : 8, PD = 2;
        (void)nks;
        bf16x8 pb_[PD]; s16x4 pt0_[PD][2], pt1_[PD][2];
        LAS unsigned char* pvb[2][2];
#pragma unroll
        for (int q = 0; q < 2; ++q) { const int r0 = 8 * hh + qq, col = (lb0 + q) * 32 + 16 * blk + 4 * pp;
            pvb[q][0] = lds + SM_CT + ct_off(r0, col); pvb[q][1] = lds + SM_CT + ct_off(r0 + 4, col); }
#define PV_FETCH(slot_, ks_) do { pb_[slot_] = *(const LAS bf16x8*)(pt + 16 * (ks_)); _Pragma("unroll") for (int q = 0; q < 2; ++q) { \
            pt0_[slot_][q] = __builtin_amdgcn_ds_read_tr16_b64_v4i16((LAS s16x4*)(pvb[q][0] + 4096 * (ks_))); \
            pt1_[slot_][q] = __builtin_amdgcn_ds_read_tr16_b64_v4i16((LAS s16x4*)(pvb[q][1] + 4096 * (ks_))); } } while (0)
#pragma unroll
        for (int ks = 0; ks < PD; ++ks) PV_FETCH(ks, ks);
        __builtin_amdgcn_sched_barrier(0);
#pragma unroll
        for (int ks = 0; ks < NKS; ++ks) {
#pragma unroll
            for (int q = 0; q < 2; ++q) { const s16x4 t0 = pt0_[ks % PD][q], t1 = pt1_[ks % PD][q];
                const bf16x8 a = {t0[0], t0[1], t0[2], t0[3], t1[0], t1[1], t1[2], t1[3]};
                oacc[q] = mfma32(a, pb_[ks % PD], oacc[q]); }
            if (ks + PD < NKS) PV_FETCH(ks % PD, ks + PD);
            __builtin_amdgcn_sched_barrier(0);
        }
#undef PV_FETCH
    }
    }
    __syncthreads();
    if (!FRESH) {
        if (pfon) { pf_mid<6>(pf, rc, rr, tid); pf_commit(pf, lds, tid);
#ifdef PROBE_COMMIT2
            __syncthreads(); pf_commit(pf, lds, tid);
#endif
        }
        __syncthreads();
    }
}

__device__ __forceinline__ void smla_unit(Frame& F, const Params& P, int unit) {
    int tid = F.tid; asm volatile("" : "+v"(tid));
    const int lane = tid & 63, w = F.wave, i32 = lane & 31, hh = lane >> 5;
    const int bs = unit >> 1, half = unit & 1;
    LAS unsigned char* lds = F.lds;
    LAS bf16_t* QA = (LAS bf16_t*)(lds + SM_QA);
    LAS float* M2S = (LAS float*)(lds + SM_M2); LAS float* LX = (LAS float*)(lds + SM_LX);
    const int* ptab = (const int*)P.in[9] + bs * NPAGES + half * 32;
    const int ptv = (lane < 32) ? ptab[lane] : -1;
#define PTAB(i_) __builtin_amdgcn_readlane(ptv, (i_))
    smla_load_page(P, lds, PTAB(0), tid);
    {
        const int qi = lane & 7, grow = NP + bs * 8 + qi;
        const float* sp = WSP(float, WS_SSQ_Q) + ((size_t)grow * 8 + w) * 8;
        const float sr = (sp[0] + sp[2]) + (sp[4] + sp[6]), sg = (sp[1] + sp[3]) + (sp[5] + sp[7]);
        const float rinv = 1.0f / sqrtf(sr * (1.f / 192.f) + EPS);
        if (lane < 8) M2S[w * 8 + lane] = 13.856406460551018f * rinv * sqrtf(sg);
        const float ra = __shfl(rinv, i32 & 7);
        const bf16_t* qp = WSP(bf16_t, WS_QG) + (size_t)(NP + bs * 8 + (i32 & 7)) * 1536 + w * 192 + 8 * hh;
        bf16x8 aq[8];
        u32x4 qraw[8];
#pragma unroll
        for (int ks = 0; ks < 8; ++ks) qraw[ks] = *(const u32x4*)(qp + 16 * ks);
        __builtin_amdgcn_sched_barrier(0);
#pragma unroll
        for (int ks = 0; ks < 8; ++ks) { const u32x4 v = qraw[ks]; u32x4 o;
            o.x = pk2(bflo(v.x) * ra, bfhi(v.x) * ra); o.y = pk2(bflo(v.y) * ra, bfhi(v.y) * ra); o.z = pk2(bflo(v.z) * ra, bfhi(v.z) * ra); o.w = pk2(bflo(v.w) * ra, bfhi(v.w) * ra);
            aq[ks] = __builtin_bit_cast(bf16x8, o); }
        const bf16_t* wb = WSP(bf16_t, WS_WKV_B) + (size_t)i32 * 2048 + w * 256 + 8 * hh;
        bf16x8 wf0[8], wf1[8];
#pragma unroll
        for (int ks = 0; ks < 8; ++ks) wf0[ks] = *(const bf16x8*)(wb + 16 * ks);
#pragma unroll 1
        for (int lp = 0; lp < 4; ++lp) {
            const int lb1 = 2 * lp + 1, lb2 = (2 * lp + 2) & 7;
#pragma unroll
            for (int ks = 0; ks < 8; ++ks) wf1[ks] = *(const bf16x8*)(wb + (size_t)lb1 * 32 * 2048 + 16 * ks);
            __builtin_amdgcn_sched_barrier(0);
            { f32x16 acc = zero16();
#pragma unroll
              for (int ks = 0; ks < 8; ++ks) acc = mfma32(aq[ks], wf0[ks], acc);
#pragma unroll
              for (int r = 0; r < 4; ++r) QA[(w * 8 + r + 4 * hh) * SM_QP + (2 * lp) * 32 + i32] = (bf16_t)f2bf(acc[r]); }
            __builtin_amdgcn_sched_barrier(0);
#pragma unroll
            for (int ks = 0; ks < 8; ++ks) wf0[ks] = *(const bf16x8*)(wb + (size_t)lb2 * 32 * 2048 + 16 * ks);
            __builtin_amdgcn_sched_barrier(0);
            { f32x16 acc = zero16();
#pragma unroll
              for (int ks = 0; ks < 8; ++ks) acc = mfma32(aq[ks], wf1[ks], acc);
#pragma unroll
              for (int r = 0; r < 4; ++r) QA[(w * 8 + r + 4 * hh) * SM_QP + lb1 * 32 + i32] = (bf16_t)f2bf(acc[r]); }
            __builtin_amdgcn_sched_barrier(0);
        }
        { const int q2 = lane >> 3, c8 = (lane & 7) * 8; const float rq = __shfl(rinv, q2);
          const u32x4 v = *(const u32x4*)(WSP(bf16_t, WS_QG) + (size_t)(NP + bs * 8 + q2) * 1536 + w * 192 + 128 + c8); u32x4 o;
          o.x = pk2(bflo(v.x) * rq, bfhi(v.x) * rq); o.y = pk2(bflo(v.y) * rq, bfhi(v.y) * rq); o.z = pk2(bflo(v.z) * rq, bfhi(v.z) * rq); o.w = pk2(bflo(v.w) * rq, bfhi(v.w) * rq);
          *(LAS u32x4*)(QA + (w * 8 + q2) * SM_QP + 256 + c8) = o; }
    }
    f32x16 oacc[2]; oacc[0] = zero16(); oacc[1] = zero16();
    float lsum = 0.f;
    u32x4 afX[8], afY[8];
    const __amdgpu_buffer_rsrc_t wrs = __builtin_amdgcn_make_buffer_rsrc((void*)(F.ws + WS_W8F), 0, 32 * 4 * 2048, 0x00020000);
    z_load(afX, wrs, lane * 32, w * 32768);
    __syncthreads();
#ifdef NO_PF
    for (int tl = 0; tl < 32; tl += 2) {
        if (tl) { smla_load_page(P, lds, PTAB(tl), tid); __syncthreads(); }
        smla_tile<0, false>(F, P, -1, oacc, lsum, afX, afY, wrs);
        smla_load_page(P, lds, PTAB(tl + 1), tid); __syncthreads();
        smla_tile<1, false>(F, P, -1, oacc, lsum, afX, afY, wrs);
    }
#else
    for (int tl = 0; tl < 32; tl += 2) {
        smla_tile<0, false>(F, P, PTAB(tl + 1), oacc, lsum, afX, afY, wrs);
        smla_tile<1, false>(F, P, PTAB(tl + 2), oacc, lsum, afX, afY, wrs);
    }
#endif
    if (half) { smla_load_fresh(F, lds, bs, tid); __syncthreads(); smla_tile<0, true>(F, P, -1, oacc, lsum, afX, afY, wrs); }
    {
        LAS bf16_t* OL = (LAS bf16_t*)(lds + SM_CT);
        int le = tid; asm volatile("" : "+v"(le)); le &= 63;
        const int i32 = le & 31, hh = le >> 5;
        const int rb = w >> 2, lb0 = 2 * (w & 3);
#pragma unroll
        for (int q = 0; q < 2; ++q)
#pragma unroll
            for (int g4 = 0; g4 < 4; ++g4) { u32x2 pw; pw.x = pk2(oacc[q][4 * g4], oacc[q][4 * g4 + 1]); pw.y = pk2(oacc[q][4 * g4 + 2], oacc[q][4 * g4 + 3]);
                *(LAS u32x2*)(OL + (rb * 32 + i32) * 264 + (lb0 + q) * 32 + 8 * g4 + 4 * hh) = pw; }
        LX[w * 64 + le] = lsum;
        __syncthreads();
        const LAS bf16_t* ar = OL + (w * 8 + (i32 & 7)) * 264 + 8 * hh;
        bf16x8 ao[16];
#pragma unroll
        for (int ks = 0; ks < 16; ++ks) ao[ks] = *(const LAS bf16x8*)(ar + 16 * ks);
        float* yp = WSP(float, WS_YPS) + ((size_t)(bs * 2 + half) * 64 + w * 8) * 128;
        const bf16_t* wt0 = WSP(bf16_t, WS_WKV_T) + (size_t)(w * 256 + 128 + i32) * 256 + 8 * hh;
        bf16x8 vf0[16], vf1[16];
#pragma unroll
        for (int ks = 0; ks < 16; ++ks) vf0[ks] = *(const bf16x8*)(wt0 + 16 * ks);
#pragma unroll 1
        for (int np = 0; np < 2; ++np) {
            const int nb1 = 2 * np + 1, nb2 = (2 * np + 2) & 3;
#pragma unroll
            for (int ks = 0; ks < 16; ++ks) vf1[ks] = *(const bf16x8*)(wt0 + (size_t)nb1 * 32 * 256 + 16 * ks);
            __builtin_amdgcn_sched_barrier(0);
            { f32x16 acc = zero16();
#pragma unroll
              for (int ks = 0; ks < 16; ++ks) acc = mfma32(ao[ks], vf0[ks], acc);
#pragma unroll
              for (int r = 0; r < 4; ++r) yp[(size_t)(r + 4 * hh) * 128 + (2 * np) * 32 + i32] = acc[r]; }
            __builtin_amdgcn_sched_barrier(0);
#pragma unroll
            for (int ks = 0; ks < 16; ++ks) vf0[ks] = *(const bf16x8*)(wt0 + (size_t)nb2 * 32 * 256 + 16 * ks);
            __builtin_amdgcn_sched_barrier(0);
            { f32x16 acc = zero16();
#pragma unroll
              for (int ks = 0; ks < 16; ++ks) acc = mfma32(ao[ks], vf1[ks], acc);
#pragma unroll
              for (int r = 0; r < 4; ++r) yp[(size_t)(r + 4 * hh) * 128 + nb1 * 32 + i32] = acc[r]; }
            __builtin_amdgcn_sched_barrier(0);
        }
        if (le < 8) { const int r32 = (w & 3) * 8 + le; float l = 0.f;
#pragma unroll
            for (int tb = 0; tb < 4; ++tb) l += LX[((w >> 2) * 4 + tb) * 64 + r32] + LX[((w >> 2) * 4 + tb) * 64 + 32 + r32];
            WSP(float, WS_LPS)[(size_t)(bs * 2 + half) * 64 + w * 8 + le] = l; }
        __syncthreads();
    }
}

__device__ __forceinline__ void smem_unit(Frame& F, const Params& P, int unit) {
    int tid = F.tid; asm volatile("" : "+v"(tid));
    const int lane = tid & 63, w = F.wave, bs = unit >> 1, hp = unit & 1;
    LAS float* Qs = (LAS float*)F.lds;
    LAS float* Ps = Qs + 2048;
    LAS float* Ls = Ps + 4096;
    LAS float* Xs = Ls + 64;
    { const int i = tid >> 6, hl = (tid >> 5) & 1, c4 = (tid & 31) * 4;
      const u32x2 v = *(const u32x2*)(WSP(bf16_t, WS_QM) + (size_t)(NP + bs * 8 + i) * 512 + (2 * hp + hl) * 128 + c4);
      *(LAS f32x4*)(Qs + (i * 2 + hl) * 128 + c4) = (f32x4){bflo(v.x), bfhi(v.x), bflo(v.y), bfhi(v.y)}; }
    { const int key = tid & 255, hl = tid >> 8, hd = 2 * hp + hl;
      const f32x4* kp = (const f32x4*)(P.in[5] + ((size_t)(bs * MEMT + key) * 4 + hd) * 128);
      f32x4 kv[32];
#pragma unroll
      for (int j4 = 0; j4 < 32; ++j4) kv[j4] = kp[j4];
      float mq[8];
#pragma unroll
      for (int i = 0; i < 8; ++i) mq[i] = WSP(float, WS_MQM)[(NP + bs * 8 + i) * 4 + hd];
      __syncthreads();
      __builtin_amdgcn_sched_barrier(0);
      float acc[8] = {0.f, 0.f, 0.f, 0.f, 0.f, 0.f, 0.f, 0.f};
#pragma unroll
      for (int j4 = 0; j4 < 32; ++j4) {
#pragma unroll
          for (int i = 0; i < 8; ++i) { const f32x4 qv = *(LAS f32x4*)(Qs + (i * 2 + hl) * 128 + 4 * j4); acc[i] += (kv[j4].x * qv.x + kv[j4].y * qv.y) + (kv[j4].z * qv.z + kv[j4].w * qv.w); } }
#pragma unroll
      for (int i = 0; i < 8; ++i) Ps[(hl * 8 + i) * 256 + key] = ex2(acc[i] - mq[i]); }
    __builtin_amdgcn_sched_barrier(0);
    int tid2 = tid; asm volatile("" : "+v"(tid2));
    const int dv4 = tid2 & 31, hl2 = w & 1, kq = (w >> 1) * 2 + ((tid2 >> 5) & 1), hd2 = 2 * hp + hl2;
    {
      const f32x4* vp = (const f32x4*)(P.in[6] + ((size_t)(bs * MEMT + kq * 32) * 4 + hd2) * 128) + dv4;
      f32x4 vv[32];
#pragma unroll
      for (int k = 0; k < 32; ++k) vv[k] = vp[(size_t)k * 128];
      __syncthreads();
      __builtin_amdgcn_sched_barrier(0);
#pragma unroll
      for (int q = 0; q < 2; ++q) { const int r = 2 * w + q; const LAS float* p = Ps + r * 256 + lane;
          const float s = wave_sum((p[0] + p[64]) + (p[128] + p[192])); if (lane == 0) Ls[r] = s; }
      f32x4 acc[8];
#pragma unroll
      for (int i = 0; i < 8; ++i) acc[i] = (f32x4){0.f, 0.f, 0.f, 0.f};
#pragma unroll
      for (int k4 = 0; k4 < 8; ++k4) {
#pragma unroll
          for (int i = 0; i < 8; ++i) { const f32x4 pv = *(LAS f32x4*)(Ps + (hl2 * 8 + i) * 256 + kq * 32 + 4 * k4);
              acc[i] += (vv[4 * k4] * pv.x + vv[4 * k4 + 1] * pv.y) + (vv[4 * k4 + 2] * pv.z + vv[4 * k4 + 3] * pv.w); } }
#pragma unroll
      for (int i = 0; i < 8; ++i) *(LAS f32x4*)(Xs + ((kq * 8 + i) * 2 + hl2) * 128 + 4 * dv4) = acc[i];
    }
    __syncthreads();
    { const int i = tid2 >> 6, hl = (tid2 >> 5) & 1, hd = 2 * hp + hl;
      f32x4 o = (f32x4){0.f, 0.f, 0.f, 0.f};
#pragma unroll
      for (int g = 0; g < 8; ++g) o += *(LAS f32x4*)(Xs + ((g * 8 + i) * 2 + hl) * 128 + 4 * dv4);
      const float rl = 1.0f / Ls[hl * 8 + i];
      u32x2 ow; ow.x = pk2(o.x * rl, o.y * rl); ow.y = pk2(o.z * rl, o.w * rl);
      *(u32x2*)(WSP(bf16_t, WS_YMEM) + (size_t)(NP + bs * 8 + i) * 512 + hd * 128 + 4 * dv4) = ow; }
    __syncthreads();
}

__device__ __forceinline__ float silu_(float g) { return g * __builtin_amdgcn_rcpf(1.0f + ex2(-g * LOG2E)); }
__device__ __forceinline__ void unpack8(const u32x4 v, float* f) { f[0] = bflo(v.x); f[1] = bfhi(v.x); f[2] = bflo(v.y); f[3] = bfhi(v.y); f[4] = bflo(v.z); f[5] = bfhi(v.z); f[6] = bflo(v.w); f[7] = bfhi(v.w); }
struct OpRow { u32x4 ys, ym, gs, gm, gl0, gl1, yl0, yl1; f32x4 pa[4], pc[4]; float l0, l1; };
__device__ __forceinline__ void oprep_load(Frame& F, OpRow& r, int row, int lane) {
    const bf16_t* gates = WSP(bf16_t, WS_GATES) + (size_t)row * 2048;
    r.ys = *(const u32x4*)(WSP(bf16_t, WS_YSSM) + (size_t)row * 512 + 8 * lane); r.ym = *(const u32x4*)(WSP(bf16_t, WS_YMEM) + (size_t)row * 512 + 8 * lane);
    r.gs = *(const u32x4*)(gates + 8 * lane); r.gm = *(const u32x4*)(gates + 1536 + 8 * lane); r.gl0 = *(const u32x4*)(gates + 512 + 16 * lane); r.gl1 = *(const u32x4*)(gates + 512 + 16 * lane + 8);
    if (row < NP) { r.yl0 = *(const u32x4*)(WSP(bf16_t, WS_YMLA) + (size_t)row * 1024 + 16 * lane); r.yl1 = *(const u32x4*)(WSP(bf16_t, WS_YMLA) + (size_t)row * 1024 + 16 * lane + 8); }
    else { const int sr = row - NP, bs = sr >> 3, qi = sr & 7, h = lane >> 3, dv0 = (lane & 7) * 16;
        const size_t r0 = (size_t)(bs * 2) * 64 + h * 8 + qi, r1 = r0 + 64;
        r.l0 = WSP(float, WS_LPS)[r0]; r.l1 = WSP(float, WS_LPS)[r1];
        const f32x4* a = (const f32x4*)(WSP(float, WS_YPS) + r0 * 128 + dv0); const f32x4* c = (const f32x4*)(WSP(float, WS_YPS) + r1 * 128 + dv0);
#pragma unroll
        for (int q = 0; q < 4; ++q) { r.pa[q] = a[q]; r.pc[q] = c[q]; } }
}
__device__ __forceinline__ void oprep_finish(Frame& F, const Params& P, const OpRow& r, int row, int lane) {
    bf16_t* orow = WSP(bf16_t, WS_O) + (size_t)row * 2048;
    const float* g_ssm = P.in[33]; const float* g_mla = P.in[34]; const float* g_mem = P.in[35];
#pragma unroll
    for (int part = 0; part < 2; ++part) {
        const float* gn = (part == 0 ? g_ssm : g_mem) + 8 * lane;
        const int oc = (part == 0 ? 0 : 1536) + 8 * lane;
        float y[8], gt[8]; unpack8(part == 0 ? r.ys : r.ym, y); unpack8(part == 0 ? r.gs : r.gm, gt);
        float s = 0.f;
#pragma unroll
        for (int e = 0; e < 8; ++e) s += y[e] * y[e];
        const float rinv = 1.0f / sqrtf(wave_sum(s) * (1.f / 512.f) + EPS);
        float o[8];
#pragma unroll
        for (int e = 0; e < 8; ++e) o[e] = y[e] * rinv * gn[e] * silu_(gt[e]);
        u32x4 wv; wv.x = pk2(o[0], o[1]); wv.y = pk2(o[2], o[3]); wv.z = pk2(o[4], o[5]); wv.w = pk2(o[6], o[7]);
        *(u32x4*)(orow + oc) = wv;
    }
    {
        float y[16];
        if (row < NP) { unpack8(r.yl0, &y[0]); unpack8(r.yl1, &y[8]); }
        else { const float inv = 1.0f / (r.l0 + r.l1);
#pragma unroll
            for (int q = 0; q < 4; ++q) { const f32x4 v = (r.pa[q] + r.pc[q]) * inv; y[4 * q] = v.x; y[4 * q + 1] = v.y; y[4 * q + 2] = v.z; y[4 * q + 3] = v.w; } }
        float gt[16]; unpack8(r.gl0, &gt[0]); unpack8(r.gl1, &gt[8]);
        float s = 0.f;
#pragma unroll
        for (int e = 0; e < 16; ++e) s += y[e] * y[e];
        const float rinv = 1.0f / sqrtf(wave_sum(s) * (1.f / 1024.f) + EPS);
        const float* gn = g_mla + 16 * lane;
        float o[16];
#pragma unroll
        for (int e = 0; e < 16; ++e) o[e] = y[e] * rinv * gn[e] * silu_(gt[e]);
        u32x4 w0, w1; w0.x = pk2(o[0], o[1]); w0.y = pk2(o[2], o[3]); w0.z = pk2(o[4], o[5]); w0.w = pk2(o[6], o[7]);
        w1.x = pk2(o[8], o[9]); w1.y = pk2(o[10], o[11]); w1.z = pk2(o[12], o[13]); w1.w = pk2(o[14], o[15]);
        *(u32x4*)(orow + 512 + 16 * lane) = w0; *(u32x4*)(orow + 512 + 16 * lane + 8) = w1;
    }
}
__device__ __forceinline__ void oprep_rows(Frame& F, const Params& P) {
    int tid = F.tid; asm volatile("" : "+v"(tid));
    const int gw = F.bid * 8 + F.wave, NGW = F.G * 8, lane = tid & 63;
    for (int row = gw; row < NR; row += 2 * NGW) {
        const int row2 = row + NGW; const bool has2 = row2 < NR;
        OpRow ra, rb;
        oprep_load(F, ra, row, lane);
        if (has2) oprep_load(F, rb, row2, lane);
        __builtin_amdgcn_sched_barrier(0);
        oprep_finish(F, P, ra, row, lane);
        if (has2) oprep_finish(F, P, rb, row2, lane);
    }
}


struct SchedP1 {
    pg8::StaticOrder a, b; int G, c;
    __device__ void init(int G_, int c_) { G = G_; c = c_; a.init(27 * 256, 4096, G_, c_); b.init(9 * 256, 2048, 1 << 20, 0); }
    __device__ bool next(int i, pg8::Unit& u) const {
        const int L = i * G + c;
        if (L < 432) return a.next(i, u);
        if (L >= 504) return false;
        pg8::StaticOrder t = b; t.c = L - 432; const bool ok = t.next(0, u); u.pm += 27; return ok;
    }
    __device__ __forceinline__ void a_ready(const pg8::Unit&) const {}
    __device__ __forceinline__ void done(const pg8::Unit&) const {}
};
struct SchedGates {
    pg8::StaticOrder b;
    __device__ void init(int c_) { b.init(9 * 256, 2048, 1 << 20, c_); }
    __device__ bool next(int i, pg8::Unit& u) const { if (i > 0) return false; const bool ok = b.next(0, u); u.pm += 27; u.pn += 8; return ok; }
    __device__ __forceinline__ void a_ready(const pg8::Unit&) const {}
    __device__ __forceinline__ void done(const pg8::Unit&) const {}
};
#ifndef PH
#define PH 4095
#endif
#ifndef REP_SMLA
#define REP_SMLA 1
#endif
#ifndef REP_ATT
#define REP_ATT 1
#endif
#ifndef REP_P1
#define REP_P1 1
#endif
#ifndef REP_P5
#define REP_P5 1
#endif
#ifndef REP_P0
#define REP_P0 1
#endif
#ifndef REP_P2
#define REP_P2 1
#endif
#ifndef REP_P3R
#define REP_P3R 1
#endif
#ifndef REP_P4
#define REP_P4 1
#endif
#ifndef REP_MEMP
#define REP_MEMP 1
#endif
#ifndef REP_SSM1
#define REP_SSM1 1
#endif
#ifndef REP_SMEM
#define REP_SMEM 1
#endif
__global__ void __launch_bounds__(512, 2) hymba_fwd(Params P) {
    extern __shared__ __attribute__((aligned(16))) unsigned char lds_raw[];
    Frame F;
    F.lds = (LAS unsigned char*)lds_raw; F.ws = P.ws; F.out = P.out;
    F.tid = threadIdx.x; F.lane = F.tid & 63; F.wave = __builtin_amdgcn_readfirstlane(F.tid >> 6); F.G = gridDim.x; F.bid = blockIdx.x;
    volatile LAS unsigned* MISC = (volatile LAS unsigned*)(F.lds + LDS_MISC);
    if (F.tid < 16) MISC[F.tid] = 0u;
    __syncthreads();
    XcdBarrier bar = xcd_barrier_post((unsigned*)(P.ws + WS_CTL), MISC);

#if PH & 1
    for (int rep_ = 0; rep_ < REP_P0; ++rep_) { if (rep_) __syncthreads(); p0_prologue(F, P); }
#endif
    xcd_barrier(bar);

#if PH & 2
    for (int rep_ = 0; rep_ < REP_P1; ++rep_) {
        if (rep_) __syncthreads();
        pg8::Gemm g{WSP(bf16_t, WS_XN), WSP(bf16_t, WS_WIN_T), NR, NIN, 2048}; SchedP1 S; S.init(F.G, F.bid);
        EpiInProj E{WSP(float, WS_UF), WSP(bf16_t, WS_CQ), WSP(float, WS_SSQ_CQ), WSP(float, WS_CKVF), WSP(bf16_t, WS_CKVB), WSP(float, WS_SSQ_CKV), WSP(bf16_t, WS_QMR), WSP(float, WS_SSQ_QM), WSP(float, WS_KRF), WSP(bf16_t, WS_GATES)};
        pg8::gemm_phase<EpiInProj, SchedP1, false>(F.lds, g, S, E, nullptr);
        __syncthreads();
        pg8::Gemm g2{WSP(bf16_t, WS_MEMN), WSP(bf16_t, WS_MEMKV_T), 512, 1024, 2048}; pg8::StaticOrder S2; S2.init(512, 1024, F.G, F.G - 1 - F.bid);
        EpiMemKV E2{WSP(float, WS_MKRAW), WSP(float, WS_SSQ_MK), F.out + O_MV, WSP(bf16_t, WS_VTM)};
        pg8::gemm_phase<EpiMemKV, pg8::StaticOrder, false>(F.lds, g2, S2, E2, nullptr);
    }
#endif
    xcd_barrier(bar);

    for (int rep_ = 0; rep_ < REP_P2; ++rep_) {
        if (rep_) __syncthreads();
#if PH & 4
        const bool gw = (F.bid >= 184);
        {
            pg8::Gemm gg{WSP(bf16_t, WS_XN), WSP(bf16_t, WS_WIN_T), NR, NIN, 2048}; SchedGates SG; SG.init(gw ? F.bid - 184 : (1 << 20));
            EpiInProj EG{WSP(float, WS_UF), WSP(bf16_t, WS_CQ), WSP(float, WS_SSQ_CQ), WSP(float, WS_CKVF), WSP(bf16_t, WS_CKVB), WSP(float, WS_SSQ_CKV), WSP(bf16_t, WS_QMR), WSP(float, WS_SSQ_QM), WSP(float, WS_KRF), WSP(bf16_t, WS_GATES)};
            pg8::gemm_phase<EpiInProj, SchedGates, false>(F.lds, gg, SG, EG, nullptr);
            __syncthreads();
        }
        const bool sw = (F.bid >= 96 && F.bid < 128);
        const int jq = (gw || sw) ? (1 << 20) : (F.bid < 96 ? F.bid : F.bid - 32);
        pg8::Gemm g{WSP(bf16_t, WS_CQ), WSP(bf16_t, WS_WUQ_T), NR, 2048, 512}; pg8::StaticOrder S; S.init(NR, 2048, 152, jq);
        EpiQ E{WSP(float, WS_SSQ_CQ), WSP(float, WS_QCG), WSP(bf16_t, WS_QG), WSP(float, WS_SSQ_Q)};
        pg8::gemm_phase<EpiQ, pg8::StaticOrder, false>(F.lds, g, S, E, nullptr);
        __syncthreads();
        pg8::Gemm g2{WSP(bf16_t, WS_CKVB), WSP(bf16_t, WS_WKV_TG), NP, 2048, 256}; pg8::StaticOrder S2; S2.init(NP, 2048, 152, (gw || sw) ? (1 << 20) : 151 - jq);
        EpiKV E2{WSP(float, WS_SSQ_CKV), WSP(bf16_t, WS_KNB), WSP(float, WS_SSQ_KN), WSP(bf16_t, WS_VT)};
        pg8::gemm_phase<EpiKV, pg8::StaticOrder, false>(F.lds, g2, S2, E2, nullptr);
        __syncthreads();
#endif
#if PH & 8
        p2a_rows(F, P);
#endif
#if PH & 16
        for (int u = F.bid; u < 256; u += F.G) ssm_unit<0>(F, P, u);
#ifndef REP_SSM2
#define REP_SSM2 1
#endif
        for (int r2_ = 0; r2_ < REP_SSM2; ++r2_)
        if (F.bid >= 96 && F.bid < 128) ssm_unit<2>(F, P, F.bid - 96);
#endif
    }
    xcd_barrier(bar);

    {
#if (PH & 96) == 96
#ifndef STG_SH
#define STG_SH 3
#endif
        #ifdef STG_Q
        const bool smf_ = (STG_Q == 1) ? (((F.bid >> 3) & 3) == 0) : (((F.bid >> 3) & 3) != 3);
#else
        const bool smf_ = ((F.bid >> STG_SH) & 1) == 0;
#endif
        if (smf_) { for (int u = F.bid; u < 256; u += F.G) smla_unit(F, P, u); }
        for (int v = F.bid; v < 256; v += F.G) { const int u = (F.G == 256) ? ((v & 7) << 5) | (v >> 3) : v; const int b = u >> 7, h = (u >> 4) & 7, i = u & 15; attn_qblock<true>(F, b, h, 31 - i); attn_qblock<true>(F, b, h, i, true); }
        if (!smf_) { for (int u = F.bid; u < 256; u += F.G) smla_unit(F, P, u); }
#endif
#if PH & 128
        for (int r2_ = 0; r2_ < REP_MEMP; ++r2_) {
            if (F.G == 256) { if ((F.bid & 1) == 0) { for (int q = 0; q < 2; ++q) { const int u = F.bid + q; attn_qblock<false>(F, u >> 7, (u >> 5) & 3, u & 31); } } }
            else for (int u = F.bid; u < 256; u += F.G) attn_qblock<false>(F, u >> 7, (u >> 5) & 3, u & 31);
        }
#endif
#if PH & 256
        for (int r2_ = 0; r2_ < REP_SSM1; ++r2_)
        for (int u = F.bid; u < 256; u += F.G) ssm_unit<1>(F, P, u);
#endif
#if PH & 512
        for (int r2_ = 0; r2_ < REP_SMEM; ++r2_) {
            if (F.G == 256) { const int c = F.bid & 127; if (c < 96) smem_unit(F, P, F.bid); if (c < 32) smem_unit(F, P, F.bid + 96); }
            else for (int u = F.bid; u < 256; u += F.G) smem_unit(F, P, u);
        }
#endif
    }
    xcd_barrier(bar);

#if PH & 1024
    for (int rep_ = 0; rep_ < REP_P4; ++rep_) oprep_rows(F, P);
#endif
    xcd_barrier(bar);

#if PH & 2048
    {
        pg8::Gemm g{WSP(bf16_t, WS_O), WSP(bf16_t, WS_WOUT_T), NP, 2048, 2048}; pg8::StaticOrder S; S.init(NP, 2048, F.G, F.bid);
        EpiMerge E{P.in[0], P.in[1], F.out + O_Y};
        pg8::gemm_phase<EpiMerge, pg8::StaticOrder, false>(F.lds, g, S, E, nullptr);
        __syncthreads();
        const int tile = F.bid & 31, sl = F.bid >> 5;
        pg8::Gemm g2{WSP(bf16_t, WS_O) + (size_t)NP * 2048 + sl * 256, WSP(bf16_t, WS_WOUT_T) + sl * 256, NS, 2048, 256, 2048}; SchedOne S2{tile >> 3, tile & 7, F.bid < 256};
        EpiPart E2{WSP(float, WS_PART) + (size_t)(sl & 7) * NS * 2048};
        pg8::gemm_phase<EpiPart, SchedOne, false>(F.lds, g2, S2, E2, nullptr);
    }
    xcd_barrier(bar);
    {
        int tid = F.tid; asm volatile("" : "+v"(tid));
        const f32x4* xs = (const f32x4*)P.in[1]; f32x4* ys = (f32x4*)(F.out + O_Y + (size_t)NP * 2048); const f32x4* pt = WSP(f32x4, WS_PART);
        for (int i = F.bid * 512 + tid; i < NS * 2048 / 4; i += F.G * 512) {
            f32x4 v[8];
#pragma unroll
            for (int s = 0; s < 8; ++s) v[s] = pt[(size_t)s * (NS * 2048 / 4) + i];
            ys[i] = xs[i] + ((v[0] + v[1]) + (v[2] + v[3])) + ((v[4] + v[5]) + (v[6] + v[7]));
        }
    }
#endif
}

extern "C" void kernel_launch(void* const* d_in, const int* in_sizes, int n_in, void* d_out, int out_size, void* d_ws, size_t ws_size, hipStream_t stream) {
    static int grid = 0;
    if (grid == 0) {
        if (n_in != 37 || ws_size < WS_END) { fprintf(stderr, "kernel_launch: unexpected problem (n_in %d, ws %zu)\n", n_in, ws_size); grid = -1; return; }
        int dev = 0, cus = 0, per_cu = 0;
        if (hipGetDevice(&dev) != hipSuccess || hipDeviceGetAttribute(&cus, hipDeviceAttributeMultiprocessorCount, dev) != hipSuccess) { grid = -1; return; }
        if (hipFuncSetAttribute((const void*)hymba_fwd, hipFuncAttributeMaxDynamicSharedMemorySize, LDS_TOTAL) != hipSuccess) { fprintf(stderr, "kernel_launch: hipFuncSetAttribute failed\n"); grid = -1; return; }
        if (hipOccupancyMaxActiveBlocksPerMultiprocessor(&per_cu, (const void*)hymba_fwd, 512, LDS_TOTAL) != hipSuccess || per_cu < 1)
            fprintf(stderr, "kernel_launch: note: occupancy query reports %d workgroups per CU\n", per_cu);
        (void)hipGetLastError();
        grid = cus;
    }
    if (grid < 0) return;
    (void)in_sizes; (void)out_size;
    hipMemsetAsync((char*)d_ws + WS_CTL, 0, 16384, stream);
    Params p{};
    for (int i = 0; i < 37; ++i) p.in[i] = (const float*)d_in[i];
    p.out = (float*)d_out; p.ws = (unsigned char*)d_ws;
    hipLaunchKernelGGL(hymba_fwd, dim3(grid), dim3(512), LDS_TOTAL, stream, p);
}
```

```cpp
#include <hip/hip_runtime.h>
#include <cstdio>
#include <cstdint>
namespace pg8 {
#define PG8_LAS __attribute__((address_space(3)))
typedef unsigned short bf16_t;
typedef short bf16x8 __attribute__((ext_vector_type(8)));
typedef float f32x4 __attribute__((ext_vector_type(4)));
typedef unsigned u32x4 __attribute__((ext_vector_type(4)));
constexpr int BM = 256, BK = 64, HALF = 128, HTB = HALF * BK * 2  , STAGE_BYTES = 8 * HTB, NXCD = 8, WGM = 8;

__host__ __device__ __forceinline__ int lds_byte(int r, int c) { const int st = (r >> 4) * 2 + (c >> 5), rr = r & 15, cc = c & 31, ob = rr * 64 + cc * 2; return st * 1024 + (ob ^ (((ob >> 9) & 1) << 5)); }
__host__ __device__ __forceinline__ void stage_rc(int b, int& R, int& C) { const int st = b / 1024, sb = b % 1024, swz = sb ^ (((sb >> 9) & 1) << 5); R = (st >> 1) * 16 + swz / 64; C = (st & 1) * 32 + (swz % 64) / 2; }
__host__ __device__ __forceinline__ int perm32(int rho) { const int n = rho >> 4, i = rho & 15; return 8 * (i >> 2) + 4 * n + (i & 3); }

struct Unit { int pm, pn; };
struct Gemm { const bf16_t* A; const bf16_t* Bt; int M, N, K; int ld = 0; };

struct StaticOrder {
    int nM, nN, nwg, G, c;
    __host__ __device__ void init(int M, int N, int G_, int c_) { nM = M / BM; nN = N / BM; nwg = nM * nN; G = G_; c = c_; }
    __host__ __device__ bool next(int i, Unit& u) const {
        const long L = (long)i * G + c; if (L >= nwg) return false;
        int wgid = (int)L; { const int q = nwg / NXCD, r = nwg % NXCD, xcd = wgid % NXCD, off = wgid / NXCD; wgid = (xcd < r ? xcd * (q + 1) : r * (q + 1) + (xcd - r) * q) + off; }
        const int nig = WGM * nN, gid = wgid / nig, fm = gid * WGM, gsz = (nM - fm) < WGM ? (nM - fm) : WGM;
        u.pm = fm + ((wgid % nig) % gsz); u.pn = (wgid % nig) / gsz; return true;
    }
    __device__ __forceinline__ void a_ready(const Unit&) const {}
    __device__ __forceinline__ void done(const Unit&) const {}
};
__device__ __forceinline__ unsigned cvt_pk_bf16(float lo, float hi) { unsigned r; asm volatile("v_cvt_pk_bf16_f32 %0, %1, %2" : "=v"(r) : "v"(lo), "v"(hi)); return r; }
template <class Epi, class Sched, bool STAMP = false>
__device__ __forceinline__ void gemm_phase(PG8_LAS unsigned char* lds, const Gemm g, const Sched& S, const Epi& E, unsigned long long* stamps) {
    int tid_l = threadIdx.x; asm volatile("" : "+v"(tid_l));
    const int tid = tid_l, wid = __builtin_amdgcn_readfirstlane(tid >> 6), lane = tid & 63, wr = wid >> 2, wc = wid & 3, fr = lane & 15, fq = lane >> 4;
    const int K = g.K, nt = K / BK, LD = g.ld ? g.ld : g.K;
    int ts_lo = 0, ts_hi = 0, nts = 0; const unsigned long long rt_entry = STAMP ? (unsigned long long)wall_clock64() : 0ull;
#define PG8_STAMP() do { if (STAMP && wid == 0 && nts < 64) { const unsigned long long _c = (unsigned long long)clock64(); \
        ts_lo = (lane == nts) ? (int)(unsigned)_c : ts_lo; ts_hi = (lane == nts) ? (int)(unsigned)(_c >> 32) : ts_hi; ++nts; } } while (0)
    PG8_STAMP();
    unsigned voffA[2], voffB[2];
#pragma unroll
    for (int i = 0; i < 2; ++i) { int R, C; stage_rc(tid * 16 + i * 8192, R, C); const int Rb = Epi::PERM ? ((R & ~31) + perm32(R & 31)) : R;
        voffA[i] = (unsigned)(R * LD + C) * 2u; voffB[i] = (unsigned)(Rb * LD + C) * 2u; }
    const size_t kstep = (size_t)(BK * 2);
    const size_t hstep = (size_t)HALF * LD * 2;
    const size_t tstep = 2 * hstep;
    const unsigned ldsw = (unsigned)wid * 1024u;
    const int aoff = lds_byte(wr * 64 + fr, fq * 8), boff = lds_byte(wc * 32 + fr, fq * 8);
#define PG8_SA(b, h) (((b) * 2 + (h)) * HTB)
#define PG8_SB(b, h) ((4 + (b) * 2 + (h)) * HTB)
#define PG8_STAGE(bufoff, gbase, voff) do { _Pragma("unroll") for (int _i = 0; _i < 2; ++_i) \
        __builtin_amdgcn_global_load_lds((const unsigned*)((const char*)(gbase) + (voff)[_i]), (PG8_LAS unsigned*)(lds + (bufoff) + ldsw + _i * 8192), 16, 0, 0); } while (0)
#define PG8_LDA(dst, b, h) do { _Pragma("unroll") for (int m = 0; m < 4; ++m) _Pragma("unroll") for (int k = 0; k < 2; ++k) dst[m][k] = *(const PG8_LAS bf16x8*)(lds + PG8_SA(b, h) + aoff + m * 2048 + k * 1024); } while (0)
#define PG8_LDB(dst, b, h) do { _Pragma("unroll") for (int n = 0; n < 2; ++n) _Pragma("unroll") for (int k = 0; k < 2; ++k) dst[n][k] = *(const PG8_LAS bf16x8*)(lds + PG8_SB(b, h) + boff + n * 2048 + k * 1024); } while (0)
#define PG8_MMA(ai, bj, At, Bt) do { __builtin_amdgcn_s_setprio(1); _Pragma("unroll") for (int m = 0; m < 4; ++m) _Pragma("unroll") for (int n = 0; n < 2; ++n) _Pragma("unroll") for (int k = 0; k < 2; ++k) \
        acc[ai][bj][m][n] = __builtin_amdgcn_mfma_f32_16x16x32_bf16(Bt[n][k], At[m][k], acc[ai][bj][m][n], 0, 0, 0); __builtin_amdgcn_s_setprio(0); } while (0)
#define PG8_WAIT_V(n) asm volatile("s_waitcnt vmcnt(" #n ")" ::: "memory")
#define PG8_WAIT_L(n) asm volatile("s_waitcnt lgkmcnt(" #n ")" ::: "memory")
#define PG8_BAR __builtin_amdgcn_s_barrier()
#define PG8_SCHED __builtin_amdgcn_sched_barrier(0)
    Unit cur, nxt; int ui = 0;
    if (!S.next(0, cur)) return;
    f32x4 acc[2][2][4][2];
#pragma unroll
    for (int a = 0; a < 2; ++a)
#pragma unroll
        for (int b = 0; b < 2; ++b)
#pragma unroll
            for (int m = 0; m < 4; ++m)
#pragma unroll
                for (int n = 0; n < 2; ++n) acc[a][b][m][n] = (f32x4){0.f, 0.f, 0.f, 0.f};
    bf16x8 At[4][2], B0[2][2], B1[2][2];
    const char* cA = (const char*)g.A + (size_t)cur.pm * tstep; const char* cB = (const char*)g.Bt + (size_t)cur.pn * tstep;
    S.a_ready(cur);
    PG8_STAGE(PG8_SB(0, 0), cB, voffB); PG8_STAGE(PG8_SA(0, 0), cA, voffA); PG8_STAGE(PG8_SB(0, 1), cB + hstep, voffB); PG8_STAGE(PG8_SA(0, 1), cA + hstep, voffA);
    if (wr == 1) PG8_BAR;
    PG8_WAIT_V(4); PG8_BAR;
    PG8_STAGE(PG8_SB(1, 0), cB + kstep, voffB); PG8_STAGE(PG8_SA(1, 0), cA + kstep, voffA); PG8_STAGE(PG8_SB(1, 1), cB + hstep + kstep, voffB);
    PG8_WAIT_V(6); PG8_BAR;
    PG8_STAMP();
    for (;;) {
        const bool has_next = S.next(ui + 1, nxt);
        const char* nA = has_next ? (const char*)g.A + (size_t)nxt.pm * tstep : cA; const char* nB = has_next ? (const char*)g.Bt + (size_t)nxt.pn * tstep : cB;
        for (int t = 0; t < nt; t += 2) {
            const bool last = (t == nt - 2);
            const char* a1 = cA + (size_t)(t + 1) * kstep;
            const char* a2 = last ? nA : cA + (size_t)(t + 2) * kstep; const char* b2 = last ? nB : cB + (size_t)(t + 2) * kstep;
            const char* a3 = a2 + kstep; const char* b3 = b2 + kstep;
            if (last && has_next) S.a_ready(nxt);
            PG8_LDB(B0, 0, 0); PG8_SCHED; PG8_LDA(At, 0, 0); PG8_STAGE(PG8_SA(1, 1), a1 + hstep, voffA);
            PG8_WAIT_L(8); PG8_BAR; PG8_WAIT_L(0); PG8_MMA(0, 0, At, B0); PG8_BAR; PG8_SCHED;
            PG8_LDB(B1, 0, 1); PG8_STAGE(PG8_SB(0, 0), b2, voffB);
            PG8_BAR; PG8_WAIT_L(0); PG8_MMA(0, 1, At, B1); PG8_BAR;
            PG8_LDA(At, 0, 1); PG8_STAGE(PG8_SA(0, 0), a2, voffA);
            PG8_BAR; PG8_WAIT_L(0); PG8_MMA(1, 0, At, B0); PG8_BAR; PG8_SCHED;
            PG8_STAGE(PG8_SB(0, 1), b2 + hstep, voffB);
            PG8_WAIT_V(6); PG8_BAR; PG8_MMA(1, 1, At, B1); PG8_BAR;
            PG8_LDB(B0, 1, 0); PG8_SCHED; PG8_LDA(At, 1, 0); PG8_STAGE(PG8_SA(0, 1), a2 + hstep, voffA);
            PG8_WAIT_L(8); PG8_BAR; PG8_WAIT_L(0); PG8_MMA(0, 0, At, B0); PG8_BAR; PG8_SCHED;
            PG8_LDB(B1, 1, 1); PG8_STAGE(PG8_SB(1, 0), b3, voffB);
            PG8_BAR; PG8_WAIT_L(0); PG8_MMA(0, 1, At, B1); PG8_BAR;
            PG8_LDA(At, 1, 1); PG8_STAGE(PG8_SA(1, 0), a3, voffA);
            PG8_BAR; PG8_WAIT_L(0); PG8_MMA(1, 0, At, B0); PG8_BAR; PG8_SCHED;
            PG8_STAGE(PG8_SB(1, 1), b3 + hstep, voffB);
            PG8_WAIT_V(6); PG8_BAR; PG8_MMA(1, 1, At, B1); PG8_BAR;
        }
        PG8_STAMP();
        if constexpr (!Epi::AFTER_DRAIN) { E(acc, cur, wr, wc, fr, fq); S.done(cur); }
        PG8_STAMP();
        if (!has_next) break;
#pragma unroll
        for (int a = 0; a < 2; ++a)
#pragma unroll
            for (int b = 0; b < 2; ++b)
#pragma unroll
                for (int m = 0; m < 4; ++m)
#pragma unroll
                    for (int n = 0; n < 2; ++n) acc[a][b][m][n] = (f32x4){0.f, 0.f, 0.f, 0.f};
        cur = nxt; cA = nA; cB = nB; ++ui;
    }
    PG8_WAIT_V(0);
    if (wr == 0) PG8_BAR;
    PG8_BAR;
    if constexpr (Epi::AFTER_DRAIN) { E.fused(acc, cur, wr, wc, fr, fq, lds, wid, lane); S.done(cur); }
    PG8_STAMP();
    if (STAMP && wid == 0) { stamps[lane] = lane < nts ? (((unsigned long long)(unsigned)ts_hi << 32) | (unsigned)ts_lo) : 0ull;
        if (lane == 62) stamps[62] = rt_entry; if (lane == 63) stamps[63] = (unsigned long long)wall_clock64(); }
#undef PG8_STAMP
#undef PG8_SA
#undef PG8_SB
#undef PG8_STAGE
#undef PG8_LDA
#undef PG8_LDB
#undef PG8_MMA
#undef PG8_WAIT_V
#undef PG8_WAIT_L
#undef PG8_BAR
#undef PG8_SCHED
}
}

#define GAS __attribute__((address_space(1)))
#define LAS __attribute__((address_space(3)))
typedef unsigned short bf16_t;
typedef short bf16x8 __attribute__((ext_vector_type(8)));
typedef short s16x4 __attribute__((ext_vector_type(4)));
typedef float f32x4 __attribute__((ext_vector_type(4)));
typedef float f32x2 __attribute__((ext_vector_type(2)));
typedef float f32x16 __attribute__((ext_vector_type(16)));
typedef unsigned u32x4 __attribute__((ext_vector_type(4)));
typedef unsigned u32x2 __attribute__((ext_vector_type(2)));

constexpr int D = 2048, SEQ = 4096, NB = 2, NP = NB * SEQ  , NSB = 128  , NS = NSB * 8  , NR = NP + NS  ;
constexpr int NIN = 4096;
constexpr int PAST = 8192, PAGE = 128, NPAGES = 64;
constexpr int MEMT = 256;
constexpr float EPS = 1e-6f;
constexpr float LOG2E = 1.4426950408889634f;
constexpr size_t O_Y = 0, O_CKV_P = 18874368, O_KR_P = 20971520, O_CKV_S = 21495808, O_KR_S = 21757952, O_MK = 21823488, O_MV = 22085632,
                 O_SRE_P = 22347776, O_SIM_P = 22351872, O_SRE_S = 22355968, O_SIM_S = 22618112;

constexpr size_t al256(size_t x) { return (x + 255) & ~(size_t)255; }
constexpr size_t WS_CTL = 0, CTL_BYTES = 1u << 20;
constexpr size_t WS_WIN_T   = WS_CTL + CTL_BYTES;
constexpr size_t WS_WUQ_T   = WS_WIN_T + (size_t)4096 * 2048 * 2;
constexpr size_t WS_WKV_TG  = WS_WUQ_T + (size_t)2048 * 512 * 2;
constexpr size_t WS_WKV_T   = WS_WKV_TG + (size_t)2048 * 256 * 2;
constexpr size_t WS_WKV_B   = WS_WKV_T + (size_t)2048 * 256 * 2;
constexpr size_t WS_WF      = WS_WKV_B + (size_t)256 * 2048 * 2;
constexpr size_t WS_W8F     = WS_WF + (size_t)32 * 16 * 1024;
constexpr size_t WS_MEMKV_T = WS_W8F + (size_t)32 * 4 * 2048;
constexpr size_t WS_WOUT_T  = WS_MEMKV_T + (size_t)1024 * 2048 * 2;
constexpr size_t WS_GLUF    = WS_WOUT_T + (size_t)2048 * 2048 * 2;
constexpr size_t WS_ABAR    = WS_GLUF + (size_t)16 * 32 * 1024;
constexpr size_t WS_ABARL   = WS_ABAR + 32 * 64 * 8;
constexpr size_t WS_BBAR    = WS_ABARL + 32 * 64 * 8;
constexpr size_t WS_CSTB    = WS_BBAR + (size_t)32 * 64 * 16 * 8;
constexpr size_t WS_BBST    = WS_CSTB + (size_t)32 * 32 * 128 * 2;
constexpr size_t WS_QCG     = WS_BBST + (size_t)32 * 128 * 16 * 2;
constexpr size_t WS_XN      = WS_QCG + 1024;
constexpr size_t WS_MEMN    = WS_XN + (size_t)NR * 2048 * 2;
constexpr size_t WS_UF      = WS_MEMN + (size_t)512 * 2048 * 2;
constexpr size_t WS_CQ      = WS_UF + (size_t)NR * 512 * 4;
constexpr size_t WS_SSQ_CQ  = WS_CQ + (size_t)NR * 512 * 2;
constexpr size_t WS_CKVF    = WS_SSQ_CQ + (size_t)NR * 8 * 4;
constexpr size_t WS_CKVB    = WS_CKVF + (size_t)NR * 256 * 4;
constexpr size_t WS_SSQ_CKV = WS_CKVB + (size_t)NR * 256 * 2;
constexpr size_t WS_QMR     = WS_SSQ_CKV + (size_t)NR * 4 * 4;
constexpr size_t WS_SSQ_QM  = WS_QMR + (size_t)NR * 512 * 2;
constexpr size_t WS_KRF     = WS_SSQ_QM + (size_t)NR * 16 * 4;
constexpr size_t WS_GATES   = WS_KRF + (size_t)NR * 64 * 4;
constexpr size_t WS_MKRAW   = WS_GATES + (size_t)NR * 2048 * 2;
constexpr size_t WS_SSQ_MK  = WS_MKRAW + (size_t)512 * 512 * 4;
constexpr size_t WS_VTM     = WS_SSQ_MK + (size_t)512 * 16 * 4;
constexpr size_t WS_MKB     = WS_VTM + (size_t)2 * 4 * 128 * 256 * 2;
constexpr size_t WS_CKVS    = WS_MKB + (size_t)2 * 4 * 256 * 128 * 2;
constexpr size_t WS_KRB     = WS_CKVS + (size_t)1024 * 256 * 2;
constexpr size_t WS_SSQ_KR  = WS_KRB + (size_t)NR * 64 * 2;
constexpr size_t WS_QM      = WS_SSQ_KR + (size_t)NR * 4;
constexpr size_t WS_MQM     = WS_QM + (size_t)NR * 512 * 2;
constexpr size_t WS_QG      = WS_MQM + (size_t)NR * 4 * 4;
constexpr size_t WS_SSQ_Q   = WS_QG + (size_t)NR * 1536 * 2;
constexpr size_t WS_KNB     = WS_SSQ_Q + (size_t)NR * 64 * 4;
constexpr size_t WS_SSQ_KN  = WS_KNB + (size_t)2 * 8 * 4096 * 128 * 2;
constexpr size_t WS_VT      = WS_SSQ_KN + (size_t)NP * 32 * 4;
constexpr size_t WS_SCH     = WS_VT + (size_t)2 * 8 * 128 * 4096 * 2;
constexpr size_t WS_YSSM    = WS_SCH + (size_t)2 * 128 * 32 * 64 * 8;
constexpr size_t WS_YMLA    = WS_YSSM + (size_t)NR * 512 * 2;
constexpr size_t WS_YMEM    = WS_YMLA + (size_t)NP * 1024 * 2;
constexpr size_t WS_YPS     = WS_YMEM + (size_t)NR * 512 * 2;
constexpr size_t WS_LPS     = WS_YPS + (size_t)128 * 2 * 64 * 128 * 4;
constexpr size_t WS_O       = WS_LPS + (size_t)128 * 2 * 64 * 4;
constexpr size_t WS_PART    = WS_O + (size_t)NR * 2048 * 2;
constexpr size_t WS_END     = WS_PART + (size_t)8 * 1024 * 2048 * 4;
static_assert(WS_END < ((size_t)1 << 30), "workspace map");

constexpr int LDS_TOTAL = 163840 - 256;
constexpr int LDS_MISC = LDS_TOTAL - 64;

__device__ __forceinline__ unsigned f2bf(float f) { unsigned u = __builtin_bit_cast(unsigned, f); return (u + 0x7fffu + ((u >> 16) & 1u)) >> 16; }
__device__ __forceinline__ unsigned pk2(float lo, float hi) { unsigned r; asm volatile("v_cvt_pk_bf16_f32 %0, %1, %2" : "=v"(r) : "v"(lo), "v"(hi)); return r; }
__device__ __forceinline__ float bf2f(unsigned short b) { return __builtin_bit_cast(float, ((unsigned)b) << 16); }
__device__ __forceinline__ float bflo(unsigned w) { return __builtin_bit_cast(float, w << 16); }
__device__ __forceinline__ float bfhi(unsigned w) { return __builtin_bit_cast(float, w & 0xffff0000u); }
__device__ __forceinline__ float wave_sum(float v) {
#pragma unroll
    for (int o = 1; o < 64; o <<= 1) v += __shfl_xor(v, o);
    return v;
}
__device__ __forceinline__ float ex2(float x) { return __builtin_amdgcn_exp2f(x); }
#define LDS_WAIT() asm volatile("s_waitcnt lgkmcnt(0)" ::: "memory")
__device__ __forceinline__ f32x16 mfma32(bf16x8 a, bf16x8 b, f32x16 c) { return __builtin_amdgcn_mfma_f32_32x32x16_bf16(a, b, c, 0, 0, 0); }
__device__ __forceinline__ f32x16 zero16() { f32x16 z;
#pragma unroll
    for (int i = 0; i < 16; ++i) z[i] = 0.f; return z; }
__device__ __forceinline__ int crow(int r, int hh) { return (r & 3) + 8 * (r >> 2) + 4 * hh; }
__device__ __forceinline__ int perm23(int k) { return (k & ~0xC) | ((k & 4) << 1) | ((k & 8) >> 1); }

__device__ const double ROPE_TURNS[32] = {
    0.15915494309189535, 0.11934937021124886, 0.08949940160889101, 0.06711508300522726, 0.050329212104487035, 0.03774158471741977, 0.0283021958306234, 0.02122365276477766, 0.015915494309189534, 0.011934937021124886, 0.008949940160889102, 0.006711508300522725, 0.005032921210448704, 0.003774158471741977, 0.00283021958306234, 0.0021223652764777662, 0.0015915494309189536, 0.0011934937021124885, 0.0008949940160889102, 0.0006711508300522726, 0.0005032921210448703, 0.00037741584717419774, 0.00028302195830623395, 0.0002122365276477766, 0.00015915494309189535, 0.00011934937021124886, 8.949940160889102e-05, 6.711508300522725e-05, 5.0329212104487035e-05, 3.774158471741978e-05, 2.8302195830623396e-05, 2.122365276477766e-05
};
__device__ __forceinline__ void rope_cs_t(int pos, double turns, float& c, float& s) {
    double a = (double)pos * turns; a -= __builtin_rint(a);
    const float t = (float)a;
    s = __builtin_amdgcn_sinf(t); c = __builtin_amdgcn_cosf(t);
}
__device__ __forceinline__ void rope_cs(int pos, int i, float& c, float& s) {
    double a = (double)pos * ROPE_TURNS[i]; a -= __builtin_rint(a);
    const float t = (float)a;
    s = __builtin_amdgcn_sinf(t); c = __builtin_amdgcn_cosf(t);
}

#define XB_TMO      128
#define XB_XCNT(j)  (256  + 64 * (j))
#define XB_XSUB(j)  (1280 + 64 * (j))
#define XB_XGEN(j)  (2304 + 64 * (j))
#define XB_TOP      3328
#define XB_TOPGEN   3392
#define XCD_BAR_WORDS 3456
#define XB_SPIN_CAP (1u << 18)
__device__ __forceinline__ unsigned xb_ld(unsigned* p)              { return __hip_atomic_load(p, __ATOMIC_RELAXED, __HIP_MEMORY_SCOPE_AGENT); }
__device__ __forceinline__ unsigned xb_add(unsigned* p, unsigned v) { return __hip_atomic_fetch_add(p, v, __ATOMIC_RELAXED, __HIP_MEMORY_SCOPE_AGENT); }
__device__ __forceinline__ unsigned xb_xcc_id() { return (unsigned)__builtin_amdgcn_s_getreg((3 << 11) | 20) & 0xFu; }
#define XB_SPIN(cond, bar) do { unsigned _sp = 0; while (cond) { __builtin_amdgcn_s_sleep(1); \
    if ((++_sp & 255u) == 0u) { if (xb_ld(&(bar)[XB_TMO])) break; if (_sp > XB_SPIN_CAP) { atomicAdd(&(bar)[XB_TMO], 1u); break; } } } } while (0)
struct XcdBarrier { unsigned* bar; unsigned x; volatile LAS unsigned* st; };
__device__ __forceinline__ XcdBarrier xcd_barrier_post(unsigned* bar, volatile LAS unsigned* st) {
    XcdBarrier b; b.bar = bar; b.x = xb_xcc_id(); b.st = st;
    if (threadIdx.x == 0) (void)xb_add(&bar[XB_XCNT(b.x)], 1u);
    return b;
}
__device__ __forceinline__ void xcd_barrier_complete(unsigned* bar, unsigned x, unsigned& nloc, unsigned& nx) {
    const unsigned G = gridDim.x * gridDim.y * gridDim.z;
    unsigned sum, cnt, mine, sp = 0u;
    for (;;) {
        sum = 0u; cnt = 0u; mine = 0u;
#pragma unroll
        for (unsigned j = 0; j < 16; ++j) { const unsigned c = xb_ld(&bar[XB_XCNT(j)]); sum += c; cnt += (c > 0u) ? 1u : 0u; mine = (j == x) ? c : mine; }
        if (sum == G) break;
        __builtin_amdgcn_s_sleep(1);
        if ((++sp & 255u) == 0u) { if (xb_ld(&bar[XB_TMO])) break; if (sp > XB_SPIN_CAP) { atomicAdd(&bar[XB_TMO], 1u); break; } }
    }
    nloc = mine > 0u ? mine : 1u; nx = cnt > 0u ? cnt : 1u;
}
__device__ __forceinline__ void xcd_barrier(const XcdBarrier& b) {
    asm volatile("s_waitcnt vmcnt(0)" ::: "memory");
    __syncthreads();
    if (threadIdx.x == 0) {
        unsigned* bar = b.bar;
        __builtin_amdgcn_s_waitcnt(0);
        unsigned nloc = b.st[0], nx = b.st[1];
        if (nloc == 0u) { xcd_barrier_complete(bar, b.x, nloc, nx); b.st[0] = nloc; b.st[1] = nx; }
        const unsigned old = xb_add(&bar[XB_XSUB(b.x)], 1u);
        const unsigned gen = old / nloc;
        if (old + 1u == (gen + 1u) * nloc) {
            __builtin_amdgcn_fence(__ATOMIC_RELEASE, "agent");
            asm volatile("s_waitcnt vmcnt(0)" ::: "memory");
            const unsigned og = xb_add(&bar[XB_TOP], 1u);
            const unsigned tg = og / nx;
            if (og + 1u == (tg + 1u) * nx) xb_add(&bar[XB_TOPGEN], 1u);
            else XB_SPIN(xb_ld(&bar[XB_TOPGEN]) == tg, bar);
            __builtin_amdgcn_fence(__ATOMIC_ACQUIRE, "agent");
            xb_add(&bar[XB_XGEN(b.x)], 1u);
            asm volatile("s_waitcnt vmcnt(0)" ::: "memory");
        } else {
            XB_SPIN(xb_ld(&bar[XB_XGEN(b.x)]) == gen, bar);
            __builtin_amdgcn_fence(__ATOMIC_ACQUIRE, "agent");
            asm volatile("s_waitcnt vmcnt(0)" ::: "memory");
        }
    }
    __syncthreads();
}

struct Params {
    const float* in[37];
    float* out;
    unsigned char* ws;
};
struct Frame {
    LAS unsigned char* lds;
    unsigned char* ws;
    float* out;
    int tid, lane, wave, G, bid;
};
#define WSP(T, off) ((T*)(F.ws + (off)))

template <class Map>
__device__ __forceinline__ void p0_transpose_item(const float* W, int K, int Nsrc, int Ndst, bf16_t* WT, const float* gain, const Map& map, LAS float* scr, int item, int lane) {
    const int nblk = Ndst / 32, kb = item / nblk, nb = item % nblk, k0 = 64 * kb, n0 = 32 * nb;
    const int sc = map(n0 + (lane & 31));
    const int scc = sc < 0 ? 0 : sc; const float msk = sc < 0 ? 0.f : 1.f;
    const float* wp = W + (size_t)(k0 + (lane >> 5)) * Nsrc + scc;
    float v[32];
#pragma unroll
    for (int i = 0; i < 32; ++i) v[i] = wp[(size_t)(2 * i) * Nsrc];
    if (gain) {
        const float* gp = gain + k0 + (lane >> 5); float g[32];
#pragma unroll
        for (int i = 0; i < 32; ++i) g[i] = gp[2 * i];
#pragma unroll
        for (int i = 0; i < 32; ++i) v[i] *= g[i];
    }
#pragma unroll
    for (int i = 0; i < 32; ++i) scr[(2 * i + (lane >> 5)) * 33 + (lane & 31)] = v[i] * msk;
    LDS_WAIT(); asm volatile("" ::: "memory");
    const int c = lane & 7;
    float tv[4][8];
#pragma unroll
    for (int j = 0; j < 4; ++j) { const LAS float* s = scr + (8 * c) * 33 + (lane >> 3) + 8 * j;
#pragma unroll
        for (int e = 0; e < 8; ++e) tv[j][e] = s[e * 33]; }
#pragma unroll
    for (int j = 0; j < 4; ++j) { const int n = (lane >> 3) + 8 * j;
        u32x4 o; o.x = pk2(tv[j][0], tv[j][1]); o.y = pk2(tv[j][2], tv[j][3]); o.z = pk2(tv[j][4], tv[j][5]); o.w = pk2(tv[j][6], tv[j][7]);
        *(u32x4*)(WT + (size_t)(n0 + n) * K + k0 + 8 * c) = o; }
    LDS_WAIT(); asm volatile("" ::: "memory");
}
struct MapIn { __device__ __forceinline__ int operator()(int n) const {
    if (n < 512) return n;
    if (n < 1024) return 1024 + (n - 512);
    if (n < 1280) return 1536 + (n - 1024);
    if (n < 1792) return 2880 + (n - 1280);
    if (n < 1856) return n;
    if (n < 2048) return -1;
    if (n < 2560) return 512 + (n - 2048);
    if (n < 3584) return 1856 + (n - 2560);
    return 3392 + (n - 3584);
} };
struct MapUq { __device__ __forceinline__ int operator()(int n) const {
    const int h = n >> 8, p = n & 255;
    if (p < 128) return h * 192 + p;
    if (p >= 192) return -1;
    const int pp = p - 128, wc = pp >> 5, nn = (pp >> 4) & 1, rest = pp & 15;
    return h * 192 + 128 + 32 * nn + 16 * wc + rest;
} };
struct MapId { __device__ __forceinline__ int operator()(int n) const { return n; } };
struct MapOff { int off; __device__ __forceinline__ int operator()(int n) const { return n - off; } };

__device__ __forceinline__ void p0_norm_row(const float* xrow, const float* g, bf16_t* orow, int lane) {
    const f32x4* xr = (const f32x4*)xrow + lane; const f32x4* gr = (const f32x4*)g + lane;
    f32x4 v[8], gv[8]; float s = 0.f;
#pragma unroll
    for (int j = 0; j < 8; ++j) { v[j] = xr[64 * j]; gv[j] = gr[64 * j]; }
    __builtin_amdgcn_sched_barrier(0);
#pragma unroll
    for (int j = 0; j < 8; ++j) s += (v[j].x * v[j].x + v[j].y * v[j].y) + (v[j].z * v[j].z + v[j].w * v[j].w);
    const float rinv = 1.0f / sqrtf(wave_sum(s) * (1.f / 2048.f) + EPS);
    u32x2* o8 = (u32x2*)orow + lane;
#pragma unroll
    for (int j = 0; j < 8; ++j) { const f32x4 gg = gv[j]; u32x2 w; w.x = pk2(v[j].x * rinv * gg.x, v[j].y * rinv * gg.y); w.y = pk2(v[j].z * rinv * gg.z, v[j].w * rinv * gg.w); o8[64 * j] = w; }
}

__device__ __forceinline__ void p0_norm_row2(const float* x0, const float* x1, const float* g, bf16_t* o0, bf16_t* o1, int lane) {
    const f32x4* xr0 = (const f32x4*)x0 + lane; const f32x4* xr1 = (const f32x4*)x1 + lane; const f32x4* gr = (const f32x4*)g + lane;
    f32x4 v[8], u[8], gv[8]; float s = 0.f, t = 0.f;
#pragma unroll
    for (int j = 0; j < 8; ++j) { v[j] = xr0[64 * j]; u[j] = xr1[64 * j]; gv[j] = gr[64 * j]; }
    __builtin_amdgcn_sched_barrier(0);
#pragma unroll
    for (int j = 0; j < 8; ++j) { s += (v[j].x * v[j].x + v[j].y * v[j].y) + (v[j].z * v[j].z + v[j].w * v[j].w); t += (u[j].x * u[j].x + u[j].y * u[j].y) + (u[j].z * u[j].z + u[j].w * u[j].w); }
    const float r0 = 1.0f / sqrtf(wave_sum(s) * (1.f / 2048.f) + EPS), r1 = 1.0f / sqrtf(wave_sum(t) * (1.f / 2048.f) + EPS);
    u32x2* p0 = (u32x2*)o0 + lane; u32x2* p1 = (u32x2*)o1 + lane;
#pragma unroll
    for (int j = 0; j < 8; ++j) { const f32x4 gg = gv[j]; u32x2 w;
        w.x = pk2(v[j].x * r0 * gg.x, v[j].y * r0 * gg.y); w.y = pk2(v[j].z * r0 * gg.z, v[j].w * r0 * gg.w); p0[64 * j] = w;
        w.x = pk2(u[j].x * r1 * gg.x, u[j].y * r1 * gg.y); w.y = pk2(u[j].z * r1 * gg.z, u[j].w * r1 * gg.w); p1[64 * j] = w; }
}
__device__ __forceinline__ void p0_prologue(Frame& F, const Params& P) {
    int tid = F.tid; asm volatile("" : "+v"(tid)); const int lane_ = tid & 63;
    LAS float* scr = (LAS float*)(F.lds + F.wave * 16384);
    const int gw = F.bid * 8 + F.wave, NGW = F.G * 8;
    const int gt = F.bid * 512 + tid, NGT = F.G * 512;
    constexpr int I_IN = (2048 / 64) * (4096 / 32), I_UQ = (512 / 64) * (2048 / 32), I_KV = (256 / 64) * (2048 / 32), I_MK = (2048 / 64) * (512 / 32), I_OUT = (2048 / 64) * (2048 / 32);
    constexpr int NITEMS = I_IN + I_UQ + 2 * I_KV + 2 * I_MK + I_OUT;
#ifndef REP_P0T
#define REP_P0T 1
#endif
#ifndef REP_P0X
#define REP_P0X 1
#endif
    for (int rp_ = 0; rp_ < REP_P0T; ++rp_)
    for (int it = gw; it < NITEMS; it += NGW) {
        int r = it;
        if (r < I_IN) { p0_transpose_item(P.in[11], 2048, 3904, 4096, WSP(bf16_t, WS_WIN_T), (const float*)nullptr, MapIn{}, scr, r, lane_); continue; } r -= I_IN;
        if (r < I_UQ) { p0_transpose_item(P.in[23], 512, 1536, 2048, WSP(bf16_t, WS_WUQ_T), P.in[22], MapUq{}, scr, r, lane_); continue; } r -= I_UQ;
        if (r < I_KV) { p0_transpose_item(P.in[25], 256, 2048, 2048, WSP(bf16_t, WS_WKV_TG), P.in[24], MapId{}, scr, r, lane_); continue; } r -= I_KV;
        if (r < I_KV) { p0_transpose_item(P.in[25], 256, 2048, 2048, WSP(bf16_t, WS_WKV_T), (const float*)nullptr, MapId{}, scr, r, lane_); continue; } r -= I_KV;
        if (r < I_MK) { p0_transpose_item(P.in[29], 2048, 512, 512, WSP(bf16_t, WS_MEMKV_T), (const float*)nullptr, MapId{}, scr, r, lane_); continue; } r -= I_MK;
        if (r < I_MK) { p0_transpose_item(P.in[30], 2048, 512, 512, WSP(bf16_t, WS_MEMKV_T) + (size_t)512 * 2048, (const float*)nullptr, MapId{}, scr, r, lane_); continue; } r -= I_MK;
        p0_transpose_item(P.in[36], 2048, 2048, 2048, WSP(bf16_t, WS_WOUT_T), (const float*)nullptr, MapId{}, scr, r, lane_);
    }
#ifndef REP_P0M
#define REP_P0M 1
#endif
    for (int rm_ = 0; rm_ < REP_P0M; ++rm_) {
    { const float* w = P.in[25]; bf16_t* o = WSP(bf16_t, WS_WKV_B);
      for (int i = gt; i < 256 * 2048 / 4; i += NGT) { const f32x4 v = ((const f32x4*)w)[i]; u32x2 q; q.x = pk2(v.x, v.y); q.y = pk2(v.z, v.w); ((u32x2*)o)[i] = q; } }
    { const float* w = P.in[25]; u32x4* o = WSP(u32x4, WS_WF);
      for (int i = gt; i < 32 * 16 * 64; i += NGT) { const int ln = i & 63, ks = (i >> 6) & 15, hn = i >> 10, h = hn >> 2, nb = hn & 3, ii = ln & 31, hh = ln >> 5;
          const float* s = w + (size_t)(16 * ks + 8 * hh) * 2048 + h * 256 + nb * 32 + ii;
          u32x4 q; q.x = pk2(s[0], s[2048]); q.y = pk2(s[2 * 2048], s[3 * 2048]); q.z = pk2(s[4 * 2048], s[5 * 2048]); q.w = pk2(s[6 * 2048], s[7 * 2048]); o[i] = q; } }
    { const float* wsrc = P.in[25]; u32x4* o = WSP(u32x4, WS_W8F);
      for (int i = (gt + NGT - 64 * 512) % NGT; i < 32 * 4 * 64 * 2; i += NGT) { const int hf = i & 1, ln = (i >> 1) & 63, ks = (i >> 7) & 3, hn = i >> 9, h = hn >> 2, nb = hn & 3, ii = ln & 31, hh = ln >> 5;
          const float* s = wsrc + (size_t)(64 * ks + 32 * hh + 16 * hf) * 2048 + h * 256 + nb * 32 + ii;
          unsigned q[4];
#pragma unroll
          for (int d = 0; d < 4; ++d) { int t = __builtin_amdgcn_cvt_pk_fp8_f32(16.f * s[(size_t)(4 * d) * 2048], 16.f * s[(size_t)(4 * d + 1) * 2048], 0, false);
              t = __builtin_amdgcn_cvt_pk_fp8_f32(16.f * s[(size_t)(4 * d + 2) * 2048], 16.f * s[(size_t)(4 * d + 3) * 2048], t, true); q[d] = (unsigned)t; }
          o[i] = (u32x4){q[0], q[1], q[2], q[3]}; } }
    { const float* w = P.in[20]; u32x4* o = WSP(u32x4, WS_GLUF);
      for (int i = (gt + NGT - 96 * 512) % NGT; i < 16 * 32 * 64; i += NGT) { const int ln = i & 63, ks = (i >> 6) & 31, cb = i >> 11, ii = ln & 31, hh = ln >> 5;
          const float* s = w + (size_t)(16 * ks + 8 * hh) * 512 + cb * 32 + ii;
          u32x4 q; q.x = pk2(s[0], s[512]); q.y = pk2(s[2 * 512], s[3 * 512]); q.z = pk2(s[4 * 512], s[5 * 512]); q.w = pk2(s[6 * 512], s[7 * 512]); o[i] = q; } }
    { const float* a_re = P.in[12]; const float* a_im = P.in[13]; const float* ldt = P.in[14]; const float* b_re = P.in[15]; const float* b_im = P.in[16];
      f32x2* abar = WSP(f32x2, WS_ABAR); f32x2* abarl = WSP(f32x2, WS_ABARL); f32x2* bbar = WSP(f32x2, WS_BBAR);
      for (int i = (gt + NGT - 160 * 512) % NGT; i < 32 * 64; i += NGT) { const int g = i >> 6;
          const float dt = expf(ldt[g]), ar = a_re[i], ai = a_im[i];
          const float mag = expf(dt * ar), ph = dt * ai;
          const float abr = mag * cosf(ph), abi = mag * sinf(ph);
          abar[i] = (f32x2){abr, abi};
          const float magl = expf(32.f * dt * ar), phl = 32.f * ph;
          abarl[i] = (f32x2){magl * cosf(phl), magl * sinf(phl)};
          const float den = ar * ar + ai * ai, nr = abr - 1.0f, ni = abi;
          const float fr = (nr * ar + ni * ai) / den, fi = (ni * ar - nr * ai) / den;
          f32x4 brv[4], biv[4];
#pragma unroll
          for (int q = 0; q < 4; ++q) { brv[q] = *(const f32x4*)(b_re + i * 16 + 4 * q); biv[q] = *(const f32x4*)(b_im + i * 16 + 4 * q); }
          __builtin_amdgcn_sched_barrier(0);
#pragma unroll
          for (int p = 0; p < 16; ++p) { const float br = brv[p >> 2][p & 3], bi = biv[p >> 2][p & 3]; const float vr = fr * br - fi * bi, vi = fr * bi + fi * br; bbar[i * 16 + p] = (f32x2){vr, vi};
              WSP(bf16_t, WS_BBST)[((size_t)g * 128 + (i & 63)) * 16 + p] = (bf16_t)f2bf(vr); WSP(bf16_t, WS_BBST)[((size_t)g * 128 + 64 + (i & 63)) * 16 + p] = (bf16_t)f2bf(vi); } } }
    { const float* c_re = P.in[17]; const float* c_im = P.in[18]; bf16_t* o = WSP(bf16_t, WS_CSTB);
      for (int i = gt; i < 32 * 32 * 128; i += NGT) { const int k = i & 127, p = (i >> 7) & 31, g = i >> 12; float v = 0.f;
          if (p < 16) v = (k < 64) ? c_re[(g * 16 + p) * 64 + k] : -c_im[(g * 16 + p) * 64 + (k - 64)];
          o[i] = (bf16_t)f2bf(v); } }
    if (gt < 192) WSP(float, WS_QCG)[gt] = P.in[26][gt] * P.in[27][gt] * (0.07216878364870322f * LOG2E);
    }
    for (int rp_ = 0; rp_ < REP_P0X; ++rp_)
    for (int m = gw; m < NR; m += 2 * NGW) {
        const int m2 = m + NGW; const bool has2 = m2 < NR; const int mb = has2 ? m2 : m;
        const float* s0 = (m < NP) ? P.in[0] + (size_t)m * 2048 : P.in[1] + (size_t)(m - NP) * 2048;
        const float* s1 = (mb < NP) ? P.in[0] + (size_t)mb * 2048 : P.in[1] + (size_t)(mb - NP) * 2048;
        p0_norm_row2(s0, s1, P.in[10], WSP(bf16_t, WS_XN) + (size_t)m * 2048, WSP(bf16_t, WS_XN) + (size_t)mb * 2048, lane_);
    }
    for (int m = gw; m < 512; m += NGW) p0_norm_row(P.in[2] + (size_t)m * 2048, P.in[28], WSP(bf16_t, WS_MEMN) + (size_t)m * 2048, lane_);
}

#define EPI_RELANE() do { int ln_ = (int)__builtin_amdgcn_mbcnt_hi(~0u, __builtin_amdgcn_mbcnt_lo(~0u, 0u)); asm volatile("" : "+v"(ln_)); fr = ln_ & 15; fq = ln_ >> 4; } while (0)
__device__ __forceinline__ float sq4(const f32x4 v) { return (v.x * v.x + v.y * v.y) + (v.z * v.z + v.w * v.w); }
__device__ __forceinline__ void st_bf4(bf16_t* p, const f32x4 v) { u32x2 w; w.x = pk2(v.x, v.y); w.y = pk2(v.z, v.w); *(u32x2*)p = w; }
__device__ __forceinline__ float red_fq_(float s, int hh) {
    s += __builtin_bit_cast(float, __builtin_amdgcn_ds_swizzle(__builtin_bit_cast(int, s), 0x401F));
    const auto rr = __builtin_amdgcn_permlane32_swap(__builtin_bit_cast(unsigned, s), __builtin_bit_cast(unsigned, s), false, false);
    return s + __builtin_bit_cast(float, hh ? rr[0] : rr[1]);
}
#define red_fq(s_) red_fq_((s_), fq >> 1)

struct EpiInProj {
    static constexpr bool PERM = false, AFTER_DRAIN = false;
    float* UF; bf16_t* CQ; float* SSQ_CQ; float* CKVF; bf16_t* CKVB; float* SSQ_CKV; bf16_t* QMR; float* SSQ_QM; float* KRF; bf16_t* GATES;
    __device__ __forceinline__ void operator()(const f32x4 (&acc)[2][2][4][2], const pg8::Unit& u, int wr, int wc, int fr, int fq) const {
        EPI_RELANE();
        const int pn = u.pn;
#pragma unroll
        for (int ai = 0; ai < 2; ++ai)
#pragma unroll
            for (int m = 0; m < 4; ++m) {
                const int row = u.pm * 256 + ai * 128 + wr * 64 + m * 16 + fr;
                const int cl = wc * 32 + 4 * fq;
                if (pn < 2) {
#pragma unroll
                    for (int bj = 0; bj < 2; ++bj)
#pragma unroll
                        for (int n = 0; n < 2; ++n) *(f32x4*)(UF + (size_t)row * 512 + pn * 256 + bj * 128 + cl + 16 * n) = acc[ai][bj][m][n];
                } else if (pn < 4) {
                    float s = 0.f;
#pragma unroll
                    for (int bj = 0; bj < 2; ++bj)
#pragma unroll
                        for (int n = 0; n < 2; ++n) { st_bf4(CQ + (size_t)row * 512 + (pn - 2) * 256 + bj * 128 + cl + 16 * n, acc[ai][bj][m][n]); s += sq4(acc[ai][bj][m][n]); }
                    s = red_fq(s); if (fq == 0) SSQ_CQ[row * 8 + (pn - 2) * 4 + wc] = s;
                } else if (pn == 4) {
                    float s = 0.f;
#pragma unroll
                    for (int bj = 0; bj < 2; ++bj)
#pragma unroll
                        for (int n = 0; n < 2; ++n) { const int c = bj * 128 + cl + 16 * n; *(f32x4*)(CKVF + (size_t)row * 256 + c) = acc[ai][bj][m][n]; st_bf4(CKVB + (size_t)row * 256 + c, acc[ai][bj][m][n]); s += sq4(acc[ai][bj][m][n]); }
                    s = red_fq(s); if (fq == 0) SSQ_CKV[row * 4 + wc] = s;
                } else if (pn < 7) {
#pragma unroll
                    for (int bj = 0; bj < 2; ++bj) { float s = 0.f; const int head = 2 * (pn - 5) + bj;
#pragma unroll
                        for (int n = 0; n < 2; ++n) { st_bf4(QMR + (size_t)row * 512 + head * 128 + cl + 16 * n, acc[ai][bj][m][n]); s += sq4(acc[ai][bj][m][n]); }
                        s = red_fq(s); if (fq == 0) SSQ_QM[row * 16 + head * 4 + wc] = s; }
                } else if (pn == 7) {
                    if (wc < 2) {
#pragma unroll
                        for (int n = 0; n < 2; ++n) *(f32x4*)(KRF + (size_t)row * 64 + cl + 16 * n) = acc[ai][0][m][n];
                    }
                } else {
#pragma unroll
                    for (int bj = 0; bj < 2; ++bj)
#pragma unroll
                        for (int n = 0; n < 2; ++n) st_bf4(GATES + (size_t)row * 2048 + (pn - 8) * 256 + bj * 128 + cl + 16 * n, acc[ai][bj][m][n]);
                }
            }
    }
};

struct EpiMemKV {
    static constexpr bool PERM = false, AFTER_DRAIN = false;
    float* MKRAW; float* SSQ_MK; float* OUTV; bf16_t* VTM;
    __device__ __forceinline__ void operator()(const f32x4 (&acc)[2][2][4][2], const pg8::Unit& u, int wr, int wc, int fr, int fq) const {
        EPI_RELANE();
        const int pn = u.pn;
#pragma unroll
        for (int ai = 0; ai < 2; ++ai)
#pragma unroll
            for (int m = 0; m < 4; ++m) {
                const int row = u.pm * 256 + ai * 128 + wr * 64 + m * 16 + fr;
                const int cl = wc * 32 + 4 * fq;
                if (pn < 2) {
#pragma unroll
                    for (int bj = 0; bj < 2; ++bj) { float s = 0.f; const int head = 2 * pn + bj;
#pragma unroll
                        for (int n = 0; n < 2; ++n) { *(f32x4*)(MKRAW + (size_t)row * 512 + head * 128 + cl + 16 * n) = acc[ai][bj][m][n]; s += sq4(acc[ai][bj][m][n]); }
                        s = red_fq(s); if (fq == 0) SSQ_MK[row * 16 + head * 4 + wc] = s; }
                } else {
                    const int b = row >> 8, key = row & 255, kp = perm23(key);
#pragma unroll
                    for (int bj = 0; bj < 2; ++bj) { const int head = 2 * (pn - 2) + bj;
#pragma unroll
                        for (int n = 0; n < 2; ++n) { const f32x4 v = acc[ai][bj][m][n]; const int dv = cl + 16 * n;
                            *(f32x4*)(OUTV + (size_t)row * 512 + head * 128 + dv) = v;
                            bf16_t* t = VTM + ((size_t)(b * 4 + head) * 128 + dv) * 256 + kp;
                            t[0] = (bf16_t)f2bf(v.x); t[256] = (bf16_t)f2bf(v.y); t[512] = (bf16_t)f2bf(v.z); t[768] = (bf16_t)f2bf(v.w); } }
                }
            }
    }
};

struct EpiQ {
    static constexpr bool PERM = false, AFTER_DRAIN = false;
    const float* SSQ_CQ; const float* QCG; bf16_t* QG; float* SSQ_Q;
    __device__ __forceinline__ void operator()(const f32x4 (&acc)[2][2][4][2], const pg8::Unit& u, int wr, int wc, int fr, int fq) const {
        EPI_RELANE();
        const int h = u.pn;
        const int cl = wc * 32 + 4 * fq;
        const f32x4 g00 = *(const f32x4*)(QCG + cl), g01 = *(const f32x4*)(QCG + cl + 16);
        const int ri = 16 * wc + 4 * fq;
        f32x4 g10 = (f32x4){0.f, 0.f, 0.f, 0.f}, g11 = g10;
        double rtn[4] = {0., 0., 0., 0.};
        if (wc < 2) { g10 = *(const f32x4*)(QCG + 128 + ri); g11 = *(const f32x4*)(QCG + 160 + ri);
#pragma unroll
            for (int e = 0; e < 4; ++e) rtn[e] = ROPE_TURNS[ri + e]; }
        float rinvs[2][4];
#pragma unroll
        for (int ai = 0; ai < 2; ++ai)
#pragma unroll
            for (int m = 0; m < 4; ++m) { const int row = u.pm * 256 + ai * 128 + wr * 64 + m * 16 + fr; const f32x4 s0 = *(const f32x4*)(SSQ_CQ + row * 8), s1 = *(const f32x4*)(SSQ_CQ + row * 8 + 4);
                rinvs[ai][m] = 1.0f / sqrtf(((s0.x + s0.y) + (s0.z + s0.w) + (s1.x + s1.y) + (s1.z + s1.w)) * (1.f / 512.f) + EPS); }
        __builtin_amdgcn_sched_barrier(0);
#pragma unroll
        for (int ai = 0; ai < 2; ++ai)
#pragma unroll
            for (int m = 0; m < 4; ++m) {
                const int row = u.pm * 256 + ai * 128 + wr * 64 + m * 16 + fr;
                const float rinv = rinvs[ai][m];
                const f32x4 a0 = acc[ai][0][m][0] * rinv, a1 = acc[ai][0][m][1] * rinv;
                float sr = sq4(a0) + sq4(a1);
                const f32x4 q0 = a0 * g00, q1 = a1 * g01;
                float sg = sq4(q0) + sq4(q1);
                bf16_t* qrow = QG + (size_t)row * 1536 + h * 192;
                st_bf4(qrow + cl, q0); st_bf4(qrow + cl + 16, q1);
                if (wc < 2) {
                    const int pos = (row < NP) ? (row & (SEQ - 1)) : PAST + ((row - NP) & 7);
                    const f32x4 x1 = acc[ai][1][m][0] * rinv, x2 = acc[ai][1][m][1] * rinv;
                    f32x4 o1, o2;
#pragma unroll
                    for (int e = 0; e < 4; ++e) { float c, s; rope_cs_t(pos, rtn[e], c, s); o1[e] = x1[e] * c - x2[e] * s; o2[e] = x1[e] * s + x2[e] * c; }
                    sr += sq4(o1) + sq4(o2);
                    const f32x4 r1 = o1 * g10, r2 = o2 * g11;
                    sg += sq4(r1) + sq4(r2);
                    st_bf4(qrow + 128 + ri, r1); st_bf4(qrow + 160 + ri, r2);
                }
                sr = red_fq(sr); sg = red_fq(sg);
                if (fq == 0) { float* d = SSQ_Q + ((size_t)row * 8 + h) * 8 + wc * 2; d[0] = sr; d[1] = sg; }
            }
    }
};

struct EpiKV {
    static constexpr bool PERM = false, AFTER_DRAIN = false;
    const float* SSQ_CKV; bf16_t* KNB; float* SSQ_KN; bf16_t* VT;
    __device__ __forceinline__ void operator()(const f32x4 (&acc)[2][2][4][2], const pg8::Unit& u, int wr, int wc, int fr, int fq) const {
        EPI_RELANE();
        const int h = u.pn;
        const int cl = wc * 32 + 4 * fq;
        f32x4 sv[8]; float rinvs[8];
#pragma unroll
        for (int q0 = 0; q0 < 8; q0 += 4) {
#pragma unroll
            for (int q = q0; q < q0 + 4; ++q) sv[q] = *(const f32x4*)(SSQ_CKV + (u.pm * 256 + (q >> 2) * 128 + wr * 64 + (q & 3) * 16 + fr) * 4);
            __builtin_amdgcn_sched_barrier(0);
#pragma unroll
            for (int q = q0; q < q0 + 4; ++q) rinvs[q] = 1.0f / sqrtf(((sv[q].x + sv[q].y) + (sv[q].z + sv[q].w)) * (1.f / 256.f) + EPS);
            __builtin_amdgcn_sched_barrier(0);
        }
#pragma unroll
        for (int ai = 0; ai < 2; ++ai)
#pragma unroll
            for (int m = 0; m < 4; ++m) {
                const int row = u.pm * 256 + ai * 128 + wr * 64 + m * 16 + fr;
                const int b = row >> 12, t = row & (SEQ - 1);
                const float rinv = rinvs[ai * 4 + m];
                const f32x4 k0 = acc[ai][0][m][0] * rinv, k1 = acc[ai][0][m][1] * rinv;
                bf16_t* kr = KNB + ((size_t)(b * 8 + h) * SEQ + t) * 128;
                st_bf4(kr + cl, k0); st_bf4(kr + cl + 16, k1);
                float s = red_fq(sq4(k0) + sq4(k1));
                if (fq == 0) SSQ_KN[((size_t)row * 8 + h) * 4 + wc] = s;
                const int tp = perm23(t);
#pragma unroll
                for (int n = 0; n < 2; ++n) { const f32x4 v = acc[ai][1][m][n] * rinv; const int dv = cl + 16 * n;
                    bf16_t* vp = VT + ((size_t)(b * 8 + h) * 128 + dv) * SEQ + tp;
                    vp[0] = (bf16_t)f2bf(v.x); vp[SEQ] = (bf16_t)f2bf(v.y); vp[2 * SEQ] = (bf16_t)f2bf(v.z); vp[3 * SEQ] = (bf16_t)f2bf(v.w); }
            }
    }
};

struct EpiMerge {
    static constexpr bool PERM = false, AFTER_DRAIN = false;
    const float* XP; const float* XS; float* Y;
    __device__ __forceinline__ void operator()(const f32x4 (&acc)[2][2][4][2], const pg8::Unit& u, int wr, int wc, int fr, int fq) const {
        EPI_RELANE();
        const int c0 = u.pn * 256 + wc * 32 + 4 * fq;
#pragma unroll
        for (int ai = 0; ai < 2; ++ai) {
            f32x4 xv[4][2][2];
#pragma unroll
            for (int m = 0; m < 4; ++m) {
                const int row = u.pm * 256 + ai * 128 + wr * 64 + m * 16 + fr;
                const float* xr = (row < NP) ? XP + (size_t)row * 2048 : XS + (size_t)(row - NP) * 2048;
#pragma unroll
                for (int bj = 0; bj < 2; ++bj)
#pragma unroll
                    for (int n = 0; n < 2; ++n) xv[m][bj][n] = *(const f32x4*)(xr + c0 + bj * 128 + 16 * n);
            }
            __builtin_amdgcn_sched_barrier(0);
#pragma unroll
            for (int m = 0; m < 4; ++m) {
                const int row = u.pm * 256 + ai * 128 + wr * 64 + m * 16 + fr;
#pragma unroll
                for (int bj = 0; bj < 2; ++bj)
#pragma unroll
                    for (int n = 0; n < 2; ++n) *(f32x4*)(Y + (size_t)row * 2048 + c0 + bj * 128 + 16 * n) = acc[ai][bj][m][n] + xv[m][bj][n];
            }
            __builtin_amdgcn_sched_barrier(0);
        }
    }
};

struct EpiPart {
    static constexpr bool PERM = false, AFTER_DRAIN = false;
    float* C;
    __device__ __forceinline__ void operator()(const f32x4 (&acc)[2][2][4][2], const pg8::Unit& u, int wr, int wc, int fr, int fq) const {
        EPI_RELANE();
#pragma unroll
        for (int ai = 0; ai < 2; ++ai)
#pragma unroll
            for (int m = 0; m < 4; ++m) {
                const int row = u.pm * 256 + ai * 128 + wr * 64 + m * 16 + fr;
                const int c0 = u.pn * 256 + wc * 32 + 4 * fq;
#pragma unroll
                for (int bj = 0; bj < 2; ++bj)
#pragma unroll
                    for (int n = 0; n < 2; ++n) *(f32x4*)(C + (size_t)row * 2048 + c0 + bj * 128 + 16 * n) = acc[ai][bj][m][n];
            }
    }
};
struct SchedOne {
    int pm, pn; bool on;
    __device__ bool next(int i, pg8::Unit& u) const { if (i > 0 || !on) return false; u.pm = pm; u.pn = pn; return true; }
    __device__ __forceinline__ void a_ready(const pg8::Unit&) const {}
    __device__ __forceinline__ void done(const pg8::Unit&) const {}
};

struct P2Row { f32x4 sck, ckv, sqm, smk, mk0, mk1; u32x4 qm; float k1, k2; };
__device__ __forceinline__ void p2a_load(Frame& F, P2Row& r, int row, int lane) {
    const f32x4 z4 = (f32x4){0.f, 0.f, 0.f, 0.f}; r.sck = z4; r.ckv = z4; r.sqm = z4; r.smk = z4; r.mk0 = z4; r.mk1 = z4; r.qm = (u32x4){0u, 0u, 0u, 0u}; r.k1 = 0.f; r.k2 = 0.f;
    if (row < NR) {
        r.sck = *(const f32x4*)(WSP(float, WS_SSQ_CKV) + row * 4);
        r.ckv = *((const f32x4*)(WSP(float, WS_CKVF) + (size_t)row * 256) + lane);
        const float* kr = WSP(float, WS_KRF) + (size_t)row * 64; r.k1 = kr[lane & 31]; r.k2 = kr[(lane & 31) + 32];
        r.qm = *((const u32x4*)(WSP(bf16_t, WS_QMR) + (size_t)row * 512) + lane);
        r.sqm = *(const f32x4*)(WSP(float, WS_SSQ_QM) + row * 16 + (lane >> 4) * 4);
    } else {
        const int mr = row - NR;
        const float* src = WSP(float, WS_MKRAW) + (size_t)mr * 512 + 8 * lane;
        r.mk0 = *(const f32x4*)src; r.mk1 = *(const f32x4*)(src + 4);
        r.smk = *(const f32x4*)(WSP(float, WS_SSQ_MK) + mr * 16 + (lane >> 4) * 4);
    }
}
__device__ __forceinline__ void p2a_finish(Frame& F, const P2Row& r, int row, int lane, const f32x4 gkv, const f32x4 gq0, const f32x4 gq1, const f32x4 gk0, const f32x4 gk1, const double rtn) {
    const float gmq[8] = {gq0.x, gq0.y, gq0.z, gq0.w, gq1.x, gq1.y, gq1.z, gq1.w}, gmk[8] = {gk0.x, gk0.y, gk0.z, gk0.w, gk1.x, gk1.y, gk1.z, gk1.w};
    const int head = lane >> 4, j0 = (8 * lane) & 127;
    if (row < NR) {
        const bool prompt = row < NP;
        const int pos = prompt ? (row & (SEQ - 1)) : PAST + ((row - NP) & 7);
        { const float rinv = 1.0f / sqrtf(((r.sck.x + r.sck.y) + (r.sck.z + r.sck.w)) * (1.f / 256.f) + EPS);
          const f32x4 v = r.ckv * rinv * gkv;
          float* o = prompt ? F.out + O_CKV_P + (size_t)row * 256 : F.out + O_CKV_S + (size_t)(row - NP) * 256;
          *((f32x4*)o + lane) = v;
          if (!prompt) st_bf4(WSP(bf16_t, WS_CKVS) + (size_t)(row - NP) * 256 + 4 * lane, v); }
        { float c, s; rope_cs_t(pos, rtn, c, s);
          const float o = (lane < 32) ? (r.k1 * c - r.k2 * s) : (r.k1 * s + r.k2 * c);
          float* op = prompt ? F.out + O_KR_P + (size_t)row * 64 : F.out + O_KR_S + (size_t)(row - NP) * 64;
          op[lane] = o;
          WSP(bf16_t, WS_KRB)[(size_t)row * 64 + lane] = (bf16_t)f2bf(o);
          const float ss = wave_sum(o * o);
          if (lane == 0) WSP(float, WS_SSQ_KR)[row] = ss; }
        { const float rinv = 1.0f / sqrtf(((r.sqm.x + r.sqm.y) + (r.sqm.z + r.sqm.w)) * (1.f / 128.f) + EPS);
          const float sc = rinv * (0.08838834764831845f * LOG2E);
          float q[8] = {bflo(r.qm.x), bfhi(r.qm.x), bflo(r.qm.y), bfhi(r.qm.y), bflo(r.qm.z), bfhi(r.qm.z), bflo(r.qm.w), bfhi(r.qm.w)};
          float sb = 0.f;
#pragma unroll
          for (int e = 0; e < 8; ++e) { q[e] *= sc * gmq[e]; const float t = q[e] * gmk[e]; sb += t * t; }
          u32x4 o; o.x = pk2(q[0], q[1]); o.y = pk2(q[2], q[3]); o.z = pk2(q[4], q[5]); o.w = pk2(q[6], q[7]);
          *((u32x4*)(WSP(bf16_t, WS_QM) + (size_t)row * 512) + lane) = o;
          sb += __shfl_xor(sb, 1); sb += __shfl_xor(sb, 2); sb += __shfl_xor(sb, 4); sb += __shfl_xor(sb, 8);
          if ((lane & 15) == 0) WSP(float, WS_MQM)[row * 4 + head] = sqrtf(sb) * 11.313708498984761f; }
    } else {
        const int mr = row - NR, b = mr >> 8, key = mr & 255;
        const float rinv = 1.0f / sqrtf(((r.smk.x + r.smk.y) + (r.smk.z + r.smk.w)) * (1.f / 128.f) + EPS);
        const f32x4 a = r.mk0 * rinv * gk0, c = r.mk1 * rinv * gk1;
        float* o = F.out + O_MK + (size_t)mr * 512 + 8 * lane;
        *(f32x4*)o = a; *(f32x4*)(o + 4) = c;
        u32x4 w; w.x = pk2(a.x, a.y); w.y = pk2(a.z, a.w); w.z = pk2(c.x, c.y); w.w = pk2(c.z, c.w);
        *(u32x4*)(WSP(bf16_t, WS_MKB) + ((size_t)(b * 4 + head) * 256 + key) * 128 + j0) = w;
    }
}
__device__ __forceinline__ void p2a_rows(Frame& F, const Params& P) {
    int tid = F.tid; asm volatile("" : "+v"(tid));
    const int gw = F.bid * 8 + F.wave, NGW = F.G * 8, lane = tid & 63;
    const f32x4 gkv = *((const f32x4*)P.in[24] + lane);
    const int j0 = (8 * lane) & 127;
    const f32x4 gq0 = *(const f32x4*)(P.in[31] + j0), gq1 = *(const f32x4*)(P.in[31] + j0 + 4), gk0 = *(const f32x4*)(P.in[32] + j0), gk1 = *(const f32x4*)(P.in[32] + j0 + 4);
    const double rtn = ROPE_TURNS[lane & 31];
    for (int row = gw; row < NR + 512; row += 2 * NGW) {
        const int row2 = row + NGW; const bool has2 = row2 < NR + 512;
        P2Row ra, rb;
        p2a_load(F, ra, row, lane);
        if (has2) p2a_load(F, rb, row2, lane);
        __builtin_amdgcn_sched_barrier(0);
        p2a_finish(F, ra, row, lane, gkv, gq0, gq1, gk0, gk1, rtn);
        if (has2) p2a_finish(F, rb, row2, lane, gkv, gq0, gq1, gk0, gk1, rtn);
    }
}

constexpr int SSM_U_OFF = 0, SSM_X_OFF = 16384, SSM_X_BYTES = 32 * 136 * 2, SSM_G_OFF = SSM_X_OFF + 8 * SSM_X_BYTES, SSM_G_PITCH = 520, SSM_C_OFF = SSM_G_OFF + 32 * SSM_G_PITCH * 2;
static_assert(SSM_C_OFF + 16384 <= LDS_MISC, "ssm LDS map");
__device__ __forceinline__ float sigmoidf_(float a) { return __builtin_amdgcn_rcpf(1.0f + ex2(-a * LOG2E)); }
__device__ __forceinline__ float other_half(float x, int hh) {
    const auto rr = __builtin_amdgcn_permlane32_swap(__builtin_bit_cast(unsigned, x), __builtin_bit_cast(unsigned, x), false, false);
    return __builtin_bit_cast(float, hh ? rr[0] : rr[1]);
}
template <int MODE>
__device__ __forceinline__ void ssm_unit(Frame& F, const Params& P, int unit) {
    int tid = F.tid; asm volatile("" : "+v"(tid));
    const int lane = tid & 63, w = F.wave, i32 = lane & 31, hh = lane >> 5;
    const int b = unit >> 7, c = unit & 127;
    const int base = (MODE == 2) ? NP + 32 * unit : b * SEQ + c * 32;
    LAS float* Uw = (LAS float*)(F.lds + SSM_U_OFF + w * 2048);
    LAS bf16_t* Xw = (LAS bf16_t*)(F.lds + SSM_X_OFF + w * SSM_X_BYTES);
    LAS bf16_t* Gt = (LAS bf16_t*)(F.lds + SSM_G_OFF);
    const float* UF = WSP(float, WS_UF);
    LAS f32x2* CR = (LAS f32x2*)(F.lds + SSM_C_OFF + w * 2048);
    if (MODE == 1) {
        const int n = lane;
        float cr[4] = {0.f, 0.f, 0.f, 0.f}, ci[4] = {0.f, 0.f, 0.f, 0.f};
        f32x2 al[4];
#pragma unroll
        for (int gi = 0; gi < 4; ++gi) al[gi] = WSP(f32x2, WS_ABARL)[(4 * w + gi) * 64 + n];
        const f32x2* sch = WSP(f32x2, WS_SCH) + ((size_t)(b * 128) * 32 + 4 * w) * 64 + n;
        const int nbt = (c + 7) >> 3;
#ifdef PROBE_SSM_C
        for (int rc_ = 0; rc_ < 2; ++rc_) { if (rc_) { cr[0] = cr[1] = cr[2] = cr[3] = 0.f; ci[0] = ci[1] = ci[2] = ci[3] = 0.f; }
#else
        {
#endif
        const int nbt2 = (nbt + 1) & ~1;
        f32x2 svA[4][8], svB[4][8];
#define CARRY_LOAD(sv_, bq_) do { const int c0_ = c - (nbt2 - (bq_)) * 8; _Pragma("unroll") for (int k = 0; k < 8; ++k) _Pragma("unroll") for (int gi = 0; gi < 4; ++gi) { \
            const int cc = c0_ + k; sv_[gi][k] = sch[(size_t)(cc >= 0 ? cc : 0) * 2048 + gi * 64]; } } while (0)
#define CARRY_STEP(sv_, bq_) do { const int c0_ = c - (nbt2 - (bq_)) * 8; _Pragma("unroll") for (int k = 0; k < 8; ++k) _Pragma("unroll") for (int gi = 0; gi < 4; ++gi) { \
            const float mk = (c0_ + k >= 0) ? 1.f : 0.f; const float nr = al[gi].x * cr[gi] - al[gi].y * ci[gi] + sv_[gi][k].x * mk, ni = al[gi].x * ci[gi] + al[gi].y * cr[gi] + sv_[gi][k].y * mk; cr[gi] = nr; ci[gi] = ni; } } while (0)
        if (nbt2 > 0) CARRY_LOAD(svA, 0);
        for (int bq = 0; bq < nbt2; bq += 2) {
            CARRY_LOAD(svB, bq + 1);
            __builtin_amdgcn_sched_barrier(0);
            CARRY_STEP(svA, bq);
            __builtin_amdgcn_sched_barrier(0);
            { const int bn = (bq + 2 < nbt2) ? bq + 2 : nbt2 - 1; CARRY_LOAD(svA, bn); }
            __builtin_amdgcn_sched_barrier(0);
            CARRY_STEP(svB, bq + 1);
            __builtin_amdgcn_sched_barrier(0);
        }
#undef CARRY_LOAD
#undef CARRY_STEP
        }
#pragma unroll
        for (int gi = 0; gi < 4; ++gi) CR[gi * 64 + n] = (f32x2){cr[gi], ci[gi]};
        LDS_WAIT();
    }
#ifdef PROBE_SSM_G
    for (int rg_ = 0; rg_ < 2; ++rg_)
#endif
    for (int gi = 0; gi < 4; ++gi) {
        const int g = 4 * w + gi;
        bf16x8 ua;
        { const float* s = UF + (size_t)(base + i32) * 512 + 16 * g + 8 * hh;
          const f32x4 a = *(const f32x4*)s, d = *(const f32x4*)(s + 4);
          *(LAS f32x4*)(Uw + i32 * 16 + 8 * hh) = a; *(LAS f32x4*)(Uw + i32 * 16 + 8 * hh + 4) = d;
          u32x4 o; o.x = pk2(a.x, a.y); o.y = pk2(a.z, a.w); o.z = pk2(d.x, d.y); o.w = pk2(d.z, d.w); ua = __builtin_bit_cast(bf16x8, o); }
        f32x16 bu0, bu1, bu2, bu3;
        { const bf16_t* bs = WSP(bf16_t, WS_BBST) + ((size_t)g * 128 + i32) * 16 + 8 * hh;
          bu0 = mfma32(ua, *(const bf16x8*)(bs), zero16());
          bu1 = mfma32(ua, *(const bf16x8*)(bs + 32 * 16), zero16());
          bu2 = mfma32(ua, *(const bf16x8*)(bs + 64 * 16), zero16());
          bu3 = mfma32(ua, *(const bf16x8*)(bs + 96 * 16), zero16()); }
        const f32x2 a0 = WSP(f32x2, WS_ABAR)[g * 64 + i32], a1 = WSP(f32x2, WS_ABAR)[g * 64 + 32 + i32];
        float dp = 0.f; if (MODE >= 1) dp = P.in[19][16 * g + (i32 & 15)];
        bf16x8 cfr[8]; float h0v[4][4];
        if (MODE >= 1) { const bf16_t* cbp = WSP(bf16_t, WS_CSTB) + (size_t)(g * 32 + i32) * 128 + 8 * hh;
#pragma unroll
            for (int ks = 0; ks < 8; ++ks) cfr[ks] = *(const bf16x8*)(cbp + 16 * ks); }
        if (MODE == 2) {
#pragma unroll
            for (int m = 0; m < 4; ++m) { const size_t so = (size_t)((4 * unit + m) * 32 + g) * 64 + i32;
                h0v[m][0] = P.in[7][so]; h0v[m][1] = P.in[8][so]; h0v[m][2] = P.in[7][so + 32]; h0v[m][3] = P.in[8][so + 32]; } }
        float x0r = 0.f, x0i = 0.f, x1r = 0.f, x1i = 0.f;
        if (MODE == 1) { const f32x2 v0 = CR[gi * 64 + i32], v1 = CR[gi * 64 + 32 + i32]; x0r = v0.x; x0i = v0.y; x1r = v1.x; x1i = v1.y; }
#pragma unroll
        for (int m = 0; m < 4; ++m) {
#pragma unroll
            for (int ps = 0; ps < 2; ++ps) {
                if (MODE == 2 && ps == 0) { x0r = h0v[m][0]; x0i = h0v[m][1]; x1r = h0v[m][2]; x1i = h0v[m][3]; }
#pragma unroll
                for (int e = 0; e < 4; ++e) { const int r = 4 * m + e;
                    const float n0r = a0.x * x0r - a0.y * x0i + bu0[r], n0i = a0.x * x0i + a0.y * x0r + bu2[r];
                    const float n1r = a1.x * x1r - a1.y * x1i + bu1[r], n1i = a1.x * x1i + a1.y * x1r + bu3[r];
                    x0r = n0r; x0i = n0i; x1r = n1r; x1i = n1i;
                    if (MODE >= 1 && hh == ps) { LAS bf16_t* xp = Xw + (8 * m + 4 * ps + e) * 136 + i32;
                        xp[0] = (bf16_t)f2bf(x0r); xp[32] = (bf16_t)f2bf(x1r); xp[64] = (bf16_t)f2bf(x0i); xp[96] = (bf16_t)f2bf(x1i); }
                }
                if (MODE == 2 && ps == 1 && hh == 1) { const int bs = 4 * unit + m; const size_t so = (size_t)(bs * 32 + g) * 64 + i32;
                    F.out[O_SRE_S + so] = x0r; F.out[O_SIM_S + so] = x0i; F.out[O_SRE_S + so + 32] = x1r; F.out[O_SIM_S + so + 32] = x1i; }
                x0r = other_half(x0r, hh); x0i = other_half(x0i, hh); x1r = other_half(x1r, hh); x1i = other_half(x1i, hh);
            }
        }
        if (MODE == 0 && hh == 0) { f32x2* d = WSP(f32x2, WS_SCH) + ((size_t)(b * 128 + c) * 32 + g) * 64 + i32; d[0] = (f32x2){x0r, x0i}; d[32] = (f32x2){x1r, x1i}; }
        if (MODE == 1 && c == 127 && hh == 0) { const size_t so = (size_t)(b * 32 + g) * 64 + i32;
            F.out[O_SRE_P + so] = x0r; F.out[O_SIM_P + so] = x0i; F.out[O_SRE_P + so + 32] = x1r; F.out[O_SIM_P + so + 32] = x1i; }
        if (MODE >= 1) {
            LDS_WAIT();
            f32x16 acc = zero16();
            bf16x8 xa[8]; float uv[16];
#pragma unroll
            for (int ks = 0; ks < 8; ++ks) xa[ks] = *(LAS bf16x8*)(Xw + i32 * 136 + 16 * ks + 8 * hh);
#pragma unroll
            for (int r = 0; r < 16; ++r) uv[r] = Uw[crow(r, hh) * 16 + (i32 & 15)];
            __builtin_amdgcn_sched_barrier(0);
#pragma unroll
            for (int ks = 0; ks < 8; ++ks) acc = mfma32(xa[ks], cfr[ks], acc);
            asm volatile("" : "+v"(dp));
            if (i32 < 16) {
#pragma unroll
                for (int r = 0; r < 16; ++r) { const int t = crow(r, hh); const float y = acc[r] + dp * uv[r];
                    const float gl = y * sigmoidf_(1.5957691216057308f * (y + 0.044715f * y * y * y));
                    Gt[t * SSM_G_PITCH + 16 * g + i32] = (bf16_t)f2bf(gl); } }
        }
        LDS_WAIT();
    }
    if (MODE >= 1) {
        __syncthreads();
        const u32x4* gf = WSP(u32x4, WS_GLUF) + lane;
        u32x4 fa[8], fb[8];
#define GLU_LOAD(dst, cbk_, q8_) do { _Pragma("unroll") for (int k_ = 0; k_ < 8; ++k_) dst[k_] = gf[(size_t)((cbk_) * 32 + (q8_) * 8 + k_) * 64]; __builtin_amdgcn_sched_barrier(0); } while (0)
#define GLU_MMA(src, q8_) do { bf16x8 ga_[8]; _Pragma("unroll") for (int k_ = 0; k_ < 8; ++k_) ga_[k_] = *(LAS bf16x8*)(Gt + i32 * SSM_G_PITCH + 16 * ((q8_) * 8 + k_) + 8 * hh); __builtin_amdgcn_sched_barrier(0); \
        _Pragma("unroll") for (int k_ = 0; k_ < 8; ++k_) acc = mfma32(ga_[k_], __builtin_bit_cast(bf16x8, src[k_]), acc); __builtin_amdgcn_sched_barrier(0); } while (0)
#define GLU_EPI(cbk_, bias) do { const int ch = (cbk_) * 32 + i32; \
            float gvv_[16]; _Pragma("unroll") for (int r = 0; r < 16; ++r) gvv_[r] = bf2f(Gt[crow(r, hh) * SSM_G_PITCH + ch]); \
            _Pragma("unroll") for (int r = 0; r < 16; ++r) { const int t = crow(r, hh); const float gv = gvv_[r]; \
                WSP(bf16_t, WS_YSSM)[(size_t)(base + t) * 512 + ch] = (bf16_t)f2bf(gv * sigmoidf_(acc[r] + bias)); } } while (0)
        f32x16 acc = zero16();
        const float bias0 = P.in[21][(2 * w) * 32 + i32], bias1 = P.in[21][(2 * w + 1) * 32 + i32];
        GLU_LOAD(fa, 2 * w, 0); GLU_LOAD(fb, 2 * w, 1);
        GLU_MMA(fa, 0); GLU_LOAD(fa, 2 * w, 2);
        GLU_MMA(fb, 1); GLU_LOAD(fb, 2 * w, 3);
        GLU_MMA(fa, 2); GLU_LOAD(fa, 2 * w + 1, 0);
        GLU_MMA(fb, 3); GLU_LOAD(fb, 2 * w + 1, 1);
        GLU_EPI(2 * w, bias0);
        acc = zero16();
        GLU_MMA(fa, 0); GLU_LOAD(fa, 2 * w + 1, 2);
        GLU_MMA(fb, 1); GLU_LOAD(fb, 2 * w + 1, 3);
        GLU_MMA(fa, 2);
        GLU_MMA(fb, 3);
        GLU_EPI(2 * w + 1, bias1);
#undef GLU_LOAD
#undef GLU_MMA
#undef GLU_EPI
        __syncthreads();
    }
}

template <bool MLA> struct AttnCfg { static constexpr int DQK = MLA ? 192 : 128, KS = DQK / 16, CK = DQK / 8  , KBYTES = 64 * DQK * 2, VBYTES = 128 * 128,
                                     BUF = KBYTES + VBYTES, NDMA = BUF / (512 * 16), RK_OFF = 3 * BUF; };
template <bool MLA> __device__ __forceinline__ int aswz_k(int row) { return MLA ? ((row >> 1) & 7) : (row & 15); }
__device__ __forceinline__ int aswz_v(int row) { return (row >> 1) & 7; }
template <bool MLA>
__device__ __forceinline__ void attn_qblock(Frame& F, int b, int h, int qb, bool rk_valid = false) {
    typedef AttnCfg<MLA> C;
    int tid = F.tid; asm volatile("" : "+v"(tid));
    const int lane = tid & 63, w = F.wave, i32 = lane & 31, hh = lane >> 5, qs = w & 3, kh = w >> 2;
    const int qrow = qb * 128 + qs * 32 + i32, grow = b * SEQ + qrow;
    LAS unsigned char* lds = F.lds;
    const int ntiles = MLA ? 2 * qb + 2 : 4;
    unsigned goff[C::NDMA], gstr[C::NDMA];
#pragma unroll
    for (int k = 0; k < C::NDMA; ++k) {
        const int L = k * 512 + tid;
        if (L < 64 * C::CK) {
            const int row = L / C::CK, lc = (L % C::CK) ^ aswz_k<MLA>(row);
            if (MLA) {
                if (lc < 16) { goff[k] = (unsigned)(WS_KNB + (((size_t)(b * 8 + h) * SEQ + row) * 128 + lc * 8) * 2); gstr[k] = 64 * 128 * 2; }
                else         { goff[k] = (unsigned)(WS_KRB + (((size_t)b * SEQ + row) * 64 + (lc - 16) * 8) * 2); gstr[k] = 64 * 64 * 2; }
            } else { goff[k] = (unsigned)(WS_MKB + (((size_t)(b * 4 + h) * MEMT + row) * 128 + lc * 8) * 2); gstr[k] = 64 * 128 * 2; }
        } else {
            const int Lv = L - 64 * C::CK, row = Lv >> 3, lc = (Lv & 7) ^ aswz_v(row);
            if (MLA) goff[k] = (unsigned)(WS_VT + (((size_t)(b * 8 + h) * 128 + row) * SEQ + lc * 8) * 2);
            else     goff[k] = (unsigned)(WS_VTM + (((size_t)(b * 4 + h) * 128 + row) * MEMT + lc * 8) * 2);
            gstr[k] = 64 * 2;
        }
    }
#define ATT_ISSUE(j) ATT_ISSUE_AT(j, ((j) % 3) * C::BUF)
#define ATT_ISSUE_AT(j, boff_) do { const int bo_ = (boff_) + w * 1024; _Pragma("unroll") for (int k_ = 0; k_ < C::NDMA; ++k_) \
        __builtin_amdgcn_global_load_lds((const unsigned*)(F.ws + goff[k_] + (size_t)(j) * gstr[k_]), (LAS unsigned*)(lds + bo_ + k_ * 8192), 16, 0, 0); } while (0)
    if (MLA && !rk_valid) {
        LAS float* rk = (LAS float*)(lds + C::RK_OFF);
        const int nk = ntiles * 64;
#pragma unroll 1
        for (int t0 = 0; t0 < nk; t0 += 2048) {
            f32x4 spv[4]; float krv[4];
#pragma unroll
            for (int u = 0; u < 4; ++u) { const int t = t0 + u * 512 + tid, gk = b * SEQ + (t < nk ? t : nk - 1);
                spv[u] = *(const f32x4*)(WSP(float, WS_SSQ_KN) + ((size_t)gk * 8 + h) * 4); krv[u] = WSP(float, WS_SSQ_KR)[gk]; }
            __builtin_amdgcn_sched_barrier(0);
#pragma unroll
            for (int u = 0; u < 4; ++u) { const int t = t0 + u * 512 + tid; const f32x4 sp = spv[u];
                if (t < nk) rk[t] = __builtin_amdgcn_rsqf(((sp.x + sp.y) + (sp.z + sp.w) + krv[u]) * (1.f / 192.f) + EPS); }
        }
    }
    bf16x8 qf[C::KS]; float M2;
    if (MLA) {
        const float* sp = WSP(float, WS_SSQ_Q) + ((size_t)grow * 8 + h) * 8;
        const float sr = (sp[0] + sp[2]) + (sp[4] + sp[6]), sg = (sp[1] + sp[3]) + (sp[5] + sp[7]);
        const float rinv = 1.0f / sqrtf(sr * (1.f / 192.f) + EPS);
        M2 = 13.856406460551018f * rinv * sqrtf(sg);
        const bf16_t* qp = WSP(bf16_t, WS_QG) + (size_t)grow * 1536 + h * 192 + 8 * hh;
        u32x4 qraw[C::KS];
#pragma unroll
        for (int ks = 0; ks < C::KS; ++ks) qraw[ks] = *(const u32x4*)(qp + 16 * ks);
        __builtin_amdgcn_sched_barrier(0);
#pragma unroll
        for (int ks = 0; ks < C::KS; ++ks) { const u32x4 v = qraw[ks]; u32x4 o;
            o.x = pk2(bflo(v.x) * rinv, bfhi(v.x) * rinv); o.y = pk2(bflo(v.y) * rinv, bfhi(v.y) * rinv); o.z = pk2(bflo(v.z) * rinv, bfhi(v.z) * rinv); o.w = pk2(bflo(v.w) * rinv, bfhi(v.w) * rinv);
            qf[ks] = __builtin_bit_cast(bf16x8, o); }
    } else {
        M2 = WSP(float, WS_MQM)[grow * 4 + h];
        const bf16_t* qp = WSP(bf16_t, WS_QM) + (size_t)grow * 512 + h * 128 + 8 * hh;
#pragma unroll
        for (int ks = 0; ks < C::KS; ++ks) qf[ks] = *(const bf16x8*)(qp + 16 * ks);
    }
    asm volatile("s_waitcnt vmcnt(0) lgkmcnt(0)" ::: "memory");
    ATT_ISSUE(0); ATT_ISSUE(1);
    f32x16 o[4]; o[0] = zero16(); o[1] = zero16(); o[2] = zero16(); o[3] = zero16();
    float lsum = 0.f;
    const int kswz = aswz_k<MLA>(kh * 32 + i32), vswz = aswz_v(i32);
    int kx[4];
#pragma unroll
    for (int m = 0; m < 4; ++m) kx[m] = 16 * ((2 * m + hh) ^ kswz);
    int bcur = 0;
    for (int j = 0; j < ntiles; ++j) {
        if (j + 1 < ntiles) { if (C::NDMA == 5) asm volatile("s_waitcnt vmcnt(5)" ::: "memory"); else asm volatile("s_waitcnt vmcnt(4)" ::: "memory"); }
        else asm volatile("s_waitcnt vmcnt(0)" ::: "memory");
        __builtin_amdgcn_s_barrier(); asm volatile("" ::: "memory");
        if (j + 2 < ntiles) { int b2 = bcur + 2 * C::BUF; if (b2 >= 3 * C::BUF) b2 -= 3 * C::BUF; ATT_ISSUE_AT(j + 2, b2); }
        const LAS unsigned char* kt = lds + bcur + (kh * 32 + i32) * (C::CK * 16);
        constexpr int KH = C::KS / 2;
        bf16x8 kf[KH];
#pragma unroll
#define K_ADDR(ks_) (MLA ? kt + kx[(ks_) & 3] + 128 * ((ks_) >> 2) : kt + 16 * ((2 * (ks_) + hh) ^ kswz))
        for (int ks = 0; ks < KH; ++ks) kf[ks] = *(const LAS bf16x8*)K_ADDR(ks);
        __builtin_amdgcn_sched_barrier(0);
        f32x16 s = zero16();
#pragma unroll
        for (int ks = 0; ks < KH; ++ks) { s = mfma32(kf[ks], qf[ks], s); kf[ks] = *(const LAS bf16x8*)K_ADDR(ks + KH); __builtin_amdgcn_sched_barrier(0); }
#undef K_ADDR
#pragma unroll
        for (int ks = 0; ks < KH; ++ks) s = mfma32(kf[ks], qf[ks + KH], s);
        float p[16];
        if (MLA) {
            const LAS float* rk = (const LAS float*)(lds + C::RK_OFF) + j * 64 + kh * 32 + 4 * hh;
#pragma unroll
            for (int g4 = 0; g4 < 4; ++g4) { const f32x4 r4 = *(const LAS f32x4*)(rk + 8 * g4);
#pragma unroll
                for (int e = 0; e < 4; ++e) p[4 * g4 + e] = s[4 * g4 + e] * r4[e] - M2; }
            if (j >= 2 * qb) {
                const int kbase = j * 64 + kh * 32 + 4 * hh;
#pragma unroll
                for (int r = 0; r < 16; ++r) if (kbase + (r & 3) + 8 * (r >> 2) > qrow) p[r] = -__builtin_inff();
            }
        } else {
#pragma unroll
            for (int r = 0; r < 16; ++r) p[r] = s[r] - M2;
        }
#pragma unroll
        for (int r = 0; r < 16; ++r) { p[r] = ex2(p[r]); lsum += p[r]; }
        u32x4 w0, w1; w0.x = pk2(p[0], p[1]); w0.y = pk2(p[2], p[3]); w0.z = pk2(p[4], p[5]); w0.w = pk2(p[6], p[7]);
        w1.x = pk2(p[8], p[9]); w1.y = pk2(p[10], p[11]); w1.z = pk2(p[12], p[13]); w1.w = pk2(p[14], p[15]);
        const bf16x8 pb0 = __builtin_bit_cast(bf16x8, w0), pb1 = __builtin_bit_cast(bf16x8, w1);
        const LAS unsigned char* vt = lds + bcur + C::KBYTES + i32 * 128;
        bf16x8 vf[8];
#pragma unroll
        for (int db = 0; db < 4; ++db) {
            vf[2 * db] = *(const LAS bf16x8*)(vt + db * 32 * 128 + 16 * ((kh * 4 + hh) ^ vswz));
            vf[2 * db + 1] = *(const LAS bf16x8*)(vt + db * 32 * 128 + 16 * ((kh * 4 + 2 + hh) ^ vswz)); }
        __builtin_amdgcn_sched_barrier(0);
#pragma unroll
        for (int db = 0; db < 4; ++db) { o[db] = mfma32(vf[2 * db], pb0, o[db]); o[db] = mfma32(vf[2 * db + 1], pb1, o[db]); }
        bcur += C::BUF; if (bcur == 3 * C::BUF) bcur = 0;
    }
#undef ATT_ISSUE
#undef ATT_ISSUE_AT
    __syncthreads();
    lsum += __shfl_xor(lsum, 32);
    asm volatile("" : "+v"(tid));
    const int lane_e = tid & 63, hh_e = lane_e >> 5;
    const int grow_e = b * SEQ + qb * 128 + qs * 32 + (lane_e & 31);
    LAS float* xo = (LAS float*)lds + qs * 4096;
    LAS float* xl = (LAS float*)lds + 4 * 4096 + qs * 64;
#define lane lane_e
#define hh hh_e
#define grow grow_e
    if (kh == 1) {
#pragma unroll
        for (int db = 0; db < 4; ++db)
#pragma unroll
            for (int r = 0; r < 16; ++r) xo[(db * 16 + r) * 64 + lane] = o[db][r];
        xl[lane] = lsum;
    }
    __syncthreads();
    if (kh == 0) {
        float xv[4][16];
#pragma unroll
        for (int db = 0; db < 4; ++db)
#pragma unroll
            for (int r = 0; r < 16; ++r) xv[db][r] = xo[(db * 16 + r) * 64 + lane];
        const float inv = 1.0f / (lsum + xl[lane]);
        bf16_t* yp = MLA ? WSP(bf16_t, WS_YMLA) + (size_t)grow * 1024 + h * 128 : WSP(bf16_t, WS_YMEM) + (size_t)grow * 512 + h * 128;
#pragma unroll
        for (int db = 0; db < 4; ++db)
#pragma unroll
            for (int g4 = 0; g4 < 4; ++g4) { f32x4 v;
#pragma unroll
                for (int e = 0; e < 4; ++e) v[e] = (o[db][4 * g4 + e] + xv[db][4 * g4 + e]) * inv;
                st_bf4(yp + db * 32 + 8 * g4 + 4 * hh, v); }
    }
        __syncthreads();
#undef lane
#undef hh
#undef grow
}

constexpr int SM_CT = 0, SM_RT = 65536, SM_QA = SM_RT + 128 * 128, SM_QP = 328, SM_C8 = SM_QA + 64 * SM_QP * 2, SM_PT = SM_C8  , SM_PP = 136,
              SM_RINV = SM_C8 + 32768, SM_LX = SM_RINV  , SM_SSQR = SM_RINV + 8 * 128 * 4, SM_M2 = SM_SSQR + 512, SM_END = SM_M2 + 256;
static_assert(SM_END <= LDS_MISC && 64 * SM_PP * 2 <= 32768, "sample-MLA LDS map");
__device__ __forceinline__ int rt_off(int row, int col) { return row * 128 + 16 * ((col >> 3) ^ ((row >> 1) & 7)) + (col & 7) * 2; }
__device__ __forceinline__ int c8_off(int row, int col) { return 256 * row + 16 * ((col >> 4) ^ (((row & 3) << 2) | ((row >> 2) & 3))) + (col & 15); }
__device__ __forceinline__ int ct_off(int row, int col) {
    const int ch = (col & 127) >> 3;
    return ((col >> 7) << 15) + 256 * row + 16 * (ch ^ (((row & 3) << 2) | ((row >> 2) & 3))) + (col & 7) * 2;
}
typedef int i32x8 __attribute__((ext_vector_type(8)));
__device__ __forceinline__ f32x16 mfma8(const u32x4 a0, const u32x4 a1, const u32x4 b0, const u32x4 b1, const f32x16 c) {
    const i32x8 a = {(int)a0.x, (int)a0.y, (int)a0.z, (int)a0.w, (int)a1.x, (int)a1.y, (int)a1.z, (int)a1.w};
    const i32x8 b = {(int)b0.x, (int)b0.y, (int)b0.z, (int)b0.w, (int)b1.x, (int)b1.y, (int)b1.z, (int)b1.w};
    return __builtin_amdgcn_mfma_scale_f32_32x32x64_f8f6f4(a, b, c, 0, 0, 0, 0x7f7f7f7f, 0, 0x7f7f7f7f);
}
template <int W2, bool LOADN>
__device__ __forceinline__ void z_pass(const u32x4 (&cur)[8], u32x4 (&nxt)[8], LAS unsigned char* lds, int tb0, int i32, int hh, float& sa, float& sb, __amdgpu_buffer_rsrc_t rs, int voff, int soff_next) {
    f32x16 acc[W2];
#pragma unroll
    for (int q = 0; q < W2; ++q) acc[q] = zero16();
    u32x4 bc[W2][2], bn[W2][2];
#pragma unroll
    for (int q = 0; q < W2; ++q) { bc[q][0] = *(LAS u32x4*)(lds + SM_C8 + c8_off((tb0 + q) * 32 + i32, 32 * hh)); bc[q][1] = *(LAS u32x4*)(lds + SM_C8 + c8_off((tb0 + q) * 32 + i32, 32 * hh + 16)); }
#pragma unroll
    for (int ks = 0; ks < 4; ++ks) {
        if (ks < 3) {
#pragma unroll
            for (int q = 0; q < W2; ++q) { bn[q][0] = *(LAS u32x4*)(lds + SM_C8 + c8_off((tb0 + q) * 32 + i32, 64 * (ks + 1) + 32 * hh)); bn[q][1] = *(LAS u32x4*)(lds + SM_C8 + c8_off((tb0 + q) * 32 + i32, 64 * (ks + 1) + 32 * hh + 16)); }
        }
        __builtin_amdgcn_s_setprio(1);
#pragma unroll
        for (int q = 0; q < W2; ++q) acc[q] = mfma8(cur[2 * ks], cur[2 * ks + 1], bc[q][0], bc[q][1], acc[q]);
        __builtin_amdgcn_s_setprio(0);
        if (LOADN) { nxt[2 * ks] = __builtin_bit_cast(u32x4, __builtin_amdgcn_raw_buffer_load_b128(rs, voff, soff_next + ks * 2048, 0)); nxt[2 * ks + 1] = __builtin_bit_cast(u32x4, __builtin_amdgcn_raw_buffer_load_b128(rs, voff, soff_next + ks * 2048 + 16, 0)); }
#pragma unroll
        for (int q = 0; q < W2; ++q) { bc[q][0] = bn[q][0]; bc[q][1] = bn[q][1]; }
        __builtin_amdgcn_sched_barrier(0);
    }
#pragma unroll
    for (int q = 0; q < W2; ++q) { f32x2 p2 = (f32x2){0.f, 0.f};
#pragma unroll
        for (int r = 0; r < 16; r += 2) { const f32x2 a2 = (f32x2){acc[q][r], acc[q][r + 1]}; p2 = __builtin_elementwise_fma(a2, a2, p2); }
        float s0 = p2.x + p2.y;
        asm volatile("" : "+v"(s0));
        if (q == 0) sa += s0; else sb += s0; }
    __builtin_amdgcn_sched_barrier(0);
}
__device__ __forceinline__ void z_load(u32x4 (&af)[8], __amdgpu_buffer_rsrc_t rs, int voff, int soff) {
#pragma unroll
    for (int ks = 0; ks < 4; ++ks) { af[2 * ks] = __builtin_bit_cast(u32x4, __builtin_amdgcn_raw_buffer_load_b128(rs, voff, soff + ks * 2048, 0)); af[2 * ks + 1] = __builtin_bit_cast(u32x4, __builtin_amdgcn_raw_buffer_load_b128(rs, voff, soff + ks * 2048 + 16, 0)); }
}
__device__ __forceinline__ u32x2 bf8_to_fp8(const u32x4 v) {
    u32x2 o; int t;
    t = __builtin_amdgcn_cvt_pk_fp8_f32(bflo(v.x), bfhi(v.x), 0, false); t = __builtin_amdgcn_cvt_pk_fp8_f32(bflo(v.y), bfhi(v.y), t, true); o.x = (unsigned)t;
    t = __builtin_amdgcn_cvt_pk_fp8_f32(bflo(v.z), bfhi(v.z), 0, false); t = __builtin_amdgcn_cvt_pk_fp8_f32(bflo(v.w), bfhi(v.w), t, true); o.y = (unsigned)t;
    return o;
}
__device__ __forceinline__ void ct_store(LAS unsigned char* lds, int row, int col, const u32x4 o) {
    *(LAS u32x4*)(lds + SM_CT + ct_off(row, col)) = o;
    *(LAS u32x2*)(lds + SM_C8 + c8_off(row, col)) = bf8_to_fp8(o);
}
struct Pf { u32x4 pk[10]; f32x4 sa0, sa1, sb0, sb1, ta0, ta1, tb0, tb1; float ssr0, ssr1; };
template <int IT> __device__ __forceinline__ void pf_issue1(f32x4& a, f32x4& d, __amdgpu_buffer_rsrc_t rc, __amdgpu_buffer_rsrc_t rr, int tid) {
    const __amdgpu_buffer_rsrc_t r = (IT < 8) ? rc : rr; constexpr int so = (IT < 8 ? IT : IT - 8) * 16384;
    a = __builtin_bit_cast(f32x4, __builtin_amdgcn_raw_buffer_load_b128(r, tid * 32, so, 0)); d = __builtin_bit_cast(f32x4, __builtin_amdgcn_raw_buffer_load_b128(r, tid * 32, so + 16, 0));
}
template <int IT> __device__ __forceinline__ void pf_convert1(Pf& pf, const f32x4 a, const f32x4 d) {
    u32x4 o; o.x = pk2(a.x, a.y); o.y = pk2(a.z, a.w); o.z = pk2(d.x, d.y); o.w = pk2(d.z, d.w); pf.pk[IT] = o;
    if (IT >= 8) { float ss = sq4(a) + sq4(d); ss += __shfl_xor(ss, 1); ss += __shfl_xor(ss, 2); ss += __shfl_xor(ss, 4); if (IT == 8) pf.ssr0 = ss; else pf.ssr1 = ss; }
}
template <int J> __device__ __forceinline__ void pf_slot(Pf& pf, __amdgpu_buffer_rsrc_t rc, __amdgpu_buffer_rsrc_t rr, int tid, bool on) {
    (void)on;
    {
        if (J >= 1) { pf_convert1<(J >= 1 ? 2 * J - 2 : 0)>(pf, pf.sa0, pf.sa1); pf_convert1<(J >= 1 ? 2 * J - 1 : 1)>(pf, pf.sb0, pf.sb1); }
        if (J < 5) { pf_issue1<(J < 5 ? 2 * J : 0)>(pf.sa0, pf.sa1, rc, rr, tid); pf_issue1<(J < 5 ? 2 * J + 1 : 1)>(pf.sb0, pf.sb1, rc, rr, tid); }
    }
    __builtin_amdgcn_sched_barrier(0);
}
template <int G, int SET> __device__ __forceinline__ void pf_issue2(Pf& pf, __amdgpu_buffer_rsrc_t rc, __amdgpu_buffer_rsrc_t rr, int tid) {
    if (SET == 0) { pf_issue1<2 * G>(pf.sa0, pf.sa1, rc, rr, tid); pf_issue1<2 * G + 1>(pf.sb0, pf.sb1, rc, rr, tid); }
    else          { pf_issue1<2 * G>(pf.ta0, pf.ta1, rc, rr, tid); pf_issue1<2 * G + 1>(pf.tb0, pf.tb1, rc, rr, tid); }
}
template <int G, int SET> __device__ __forceinline__ void pf_conv2(Pf& pf) {
    if (SET == 0) { pf_convert1<2 * G>(pf, pf.sa0, pf.sa1); pf_convert1<2 * G + 1>(pf, pf.sb0, pf.sb1); }
    else          { pf_convert1<2 * G>(pf, pf.ta0, pf.ta1); pf_convert1<2 * G + 1>(pf, pf.tb0, pf.tb1); }
}
template <int J> __device__ __forceinline__ void pf_mid(Pf& pf, __amdgpu_buffer_rsrc_t rc, __amdgpu_buffer_rsrc_t rr, int tid) {
    __builtin_amdgcn_sched_barrier(0);
    if (J == 0) pf_issue2<0, 0>(pf, rc, rr, tid);
    if (J == 1) pf_issue2<1, 1>(pf, rc, rr, tid);
    if (J == 2) { pf_conv2<0, 0>(pf); pf_issue2<2, 0>(pf, rc, rr, tid); }
    if (J == 3) { pf_conv2<1, 1>(pf); pf_issue2<3, 1>(pf, rc, rr, tid); }
    if (J == 4) { pf_conv2<2, 0>(pf); pf_issue2<4, 0>(pf, rc, rr, tid); }
    if (J == 5) pf_conv2<3, 1>(pf);
    if (J == 6) pf_conv2<4, 0>(pf);
    __builtin_amdgcn_sched_barrier(0);
}
template <int IT> __device__ __forceinline__ void pf_slot_off(Pf&, __amdgpu_buffer_rsrc_t, __amdgpu_buffer_rsrc_t, int, bool) {}
__device__ __forceinline__ void pf_commit(Pf& pf, LAS unsigned char* lds, int tid) {
    const int r0 = (tid >> 5) & 15, col = (tid & 31) * 8;
    LAS unsigned char* cb = lds + SM_CT + ct_off(r0, col); LAS unsigned char* c8b = lds + SM_C8 + c8_off(r0, col);
#pragma unroll
    for (int it = 0; it < 8; ++it) { *(LAS u32x4*)(cb + 4096 * it) = pf.pk[it]; *(LAS u32x2*)(c8b + 4096 * it) = bf8_to_fp8(pf.pk[it]); }
    const int rr0 = (tid >> 3) & 63;
    LAS unsigned char* rb = lds + SM_RT + rt_off(rr0, (tid & 7) * 8);
#pragma unroll
    for (int it = 0; it < 2; ++it) { *(LAS u32x4*)(rb + 8192 * it) = pf.pk[8 + it];
        if ((tid & 7) == 0) ((LAS float*)(lds + SM_SSQR))[it * 64 + rr0] = it ? pf.ssr1 : pf.ssr0; }
}
__device__ __forceinline__ void smla_load_page(const Params& P, LAS unsigned char* lds, int page, int tid) {
    const float* cs = P.in[3] + (size_t)page * (PAGE * 256); const float* rs = P.in[4] + (size_t)page * (PAGE * 64);
    {
        f32x4 ra[6], rd[6];
#pragma unroll
        for (int it = 0; it < 4; ++it) { const int id = it * 512 + tid; ra[it] = *(const f32x4*)(cs + (size_t)id * 8); rd[it] = *(const f32x4*)(cs + (size_t)id * 8 + 4); }
#pragma unroll
        for (int it = 0; it < 2; ++it) { const int id = it * 512 + tid; ra[4 + it] = *(const f32x4*)(rs + (size_t)id * 8); rd[4 + it] = *(const f32x4*)(rs + (size_t)id * 8 + 4); }
        __builtin_amdgcn_sched_barrier(0);
#pragma unroll
        for (int it = 0; it < 4; ++it) { const int id = it * 512 + tid, row = id >> 5, col = (id & 31) * 8;
            const f32x4 a = ra[it], d = rd[it];
            u32x4 o; o.x = pk2(a.x, a.y); o.y = pk2(a.z, a.w); o.z = pk2(d.x, d.y); o.w = pk2(d.z, d.w);
            ct_store(lds, row, col, o); }
#pragma unroll
        for (int it = 0; it < 2; ++it) { const int id = it * 512 + tid, row = id >> 3, c8 = (id & 7) * 8;
            const f32x4 a = ra[4 + it], d = rd[4 + it];
            u32x4 o; o.x = pk2(a.x, a.y); o.y = pk2(a.z, a.w); o.z = pk2(d.x, d.y); o.w = pk2(d.z, d.w);
            *(LAS u32x4*)(lds + SM_RT + rt_off(row, c8)) = o;
            float ss = sq4(a) + sq4(d); ss += __shfl_xor(ss, 1); ss += __shfl_xor(ss, 2); ss += __shfl_xor(ss, 4);
            if ((id & 7) == 0) ((LAS float*)(lds + SM_SSQR))[row] = ss; }
    }
    __builtin_amdgcn_sched_barrier(0);
    {
        f32x4 ra[4], rd[4];
#pragma unroll
        for (int it = 0; it < 4; ++it) { const int id = (it + 4) * 512 + tid; ra[it] = *(const f32x4*)(cs + (size_t)id * 8); rd[it] = *(const f32x4*)(cs + (size_t)id * 8 + 4); }
        __builtin_amdgcn_sched_barrier(0);
#pragma unroll
        for (int it = 0; it < 4; ++it) { const int id = (it + 4) * 512 + tid, row = id >> 5, col = (id & 31) * 8;
            const f32x4 a = ra[it], d = rd[it];
            u32x4 o; o.x = pk2(a.x, a.y); o.y = pk2(a.z, a.w); o.z = pk2(d.x, d.y); o.w = pk2(d.z, d.w);
            ct_store(lds, row, col, o); }
    }
}
__device__ __forceinline__ void smla_load_fresh(Frame& F, LAS unsigned char* lds, int bs, int tid) {
    asm volatile("" : "+v"(tid));
    const bool v0 = tid < 256, v1 = tid < 64;
    const u32x4 l0 = *(const u32x4*)(WSP(bf16_t, WS_CKVS) + (size_t)(bs * 8 + (v0 ? (tid >> 5) : 0)) * 256 + (tid & 31) * 8);
    const u32x4 l1 = *(const u32x4*)(WSP(bf16_t, WS_KRB) + (size_t)(NP + bs * 8 + (v1 ? (tid >> 3) : 0)) * 64 + (tid & 7) * 8);
    const float l2 = WSP(float, WS_SSQ_KR)[NP + bs * 8 + (tid & 7)];
    __builtin_amdgcn_sched_barrier(0);
    unsigned zz = 0u; asm volatile("" : "+v"(zz)); const u32x4 z = (u32x4){zz, zz, zz, zz};
    ct_store(lds, tid >> 5, (tid & 31) * 8, v0 ? l0 : z);
    ct_store(lds, (tid + 512) >> 5, (tid & 31) * 8, z);
    if (tid < 256) *(LAS u32x4*)(lds + SM_RT + rt_off(tid >> 3, (tid & 7) * 8)) = v1 ? l1 : z;
    if (tid < 32) ((LAS float*)(lds + SM_SSQR))[tid] = (tid < 8) ? l2 : 0.f;
}

template <int PAR, bool FRESH>
__device__ __forceinline__ void smla_tile(Frame& F, const Params& P, int next_page, f32x16 (&oacc)[2], float& lsum, u32x4 (&afX)[8], u32x4 (&afY)[8], __amdgpu_buffer_rsrc_t wrs) {
    int tid = F.tid; asm volatile("" : "+v"(tid));
    const int lane = tid & 63, w = F.wave, i32 = lane & 31, hh = lane >> 5;
    const int wvo = lane * 32, wso = w * 32768;
    LAS unsigned char* lds = F.lds;
    LAS bf16_t* RT = (LAS bf16_t*)(lds + SM_RT); LAS bf16_t* QA = (LAS bf16_t*)(lds + SM_QA); LAS bf16_t* PT = (LAS bf16_t*)(lds + SM_PT);
    LAS float* RINV = (LAS float*)(lds + SM_RINV); LAS float* SSQR = (LAS float*)(lds + SM_SSQR); LAS float* M2S = (LAS float*)(lds + SM_M2);
    const bool pfon = (next_page >= 0);
    const int npg = pfon ? next_page : 0;
    const __amdgpu_buffer_rsrc_t rc = __builtin_amdgcn_make_buffer_rsrc((void*)(P.in[3] + (size_t)npg * (PAGE * 256)), 0, pfon ? PAGE * 256 * 4 : 0, 0x00020000);
    const __amdgpu_buffer_rsrc_t rr = __builtin_amdgcn_make_buffer_rsrc((void*)(P.in[4] + (size_t)npg * (PAGE * 64)), 0, pfon ? PAGE * 64 * 4 : 0, 0x00020000);
    Pf pf;
    {
        float ssq[4] = {0.f, 0.f, 0.f, 0.f};
        constexpr int N1 = PAR ? 2 : 1, N2 = PAR ? 1 : 2, N3 = PAR ? 0 : 3;
        if (FRESH) {
            z_pass<1, true>(afX, afY, lds, 0, i32, hh, ssq[0], ssq[1], wrs, wvo, wso + N1 * 8192);
            z_pass<1, true>(afY, afX, lds, 0, i32, hh, ssq[0], ssq[1], wrs, wvo, wso + N2 * 8192);
            z_pass<1, true>(afX, afY, lds, 0, i32, hh, ssq[0], ssq[1], wrs, wvo, wso + N3 * 8192);
            z_pass<1, false>(afY, afX, lds, 0, i32, hh, ssq[0], ssq[1], wrs, wvo, 0);
        } else if (PAR == 0) {
            z_pass<2, true>(afX, afY, lds, 0, i32, hh, ssq[0], ssq[1], wrs, wvo, wso + N1 * 8192); pf_mid<0>(pf, rc, rr, tid);
            z_pass<2, false>(afX, afY, lds, 2, i32, hh, ssq[2], ssq[3], wrs, wvo, 0);
            z_pass<2, true>(afY, afX, lds, 0, i32, hh, ssq[0], ssq[1], wrs, wvo, wso + N2 * 8192); pf_mid<1>(pf, rc, rr, tid);
            z_pass<2, false>(afY, afX, lds, 2, i32, hh, ssq[2], ssq[3], wrs, wvo, 0);
            z_pass<2, true>(afX, afY, lds, 0, i32, hh, ssq[0], ssq[1], wrs, wvo, wso + N3 * 8192); pf_mid<2>(pf, rc, rr, tid);
            z_pass<2, false>(afX, afY, lds, 2, i32, hh, ssq[2], ssq[3], wrs, wvo, 0);
            z_pass<2, false>(afY, afX, lds, 0, i32, hh, ssq[0], ssq[1], wrs, wvo, 0); pf_mid<3>(pf, rc, rr, tid);
            z_pass<2, false>(afY, afX, lds, 2, i32, hh, ssq[2], ssq[3], wrs, wvo, 0);
            pf_mid<4>(pf, rc, rr, tid);
        } else {
            z_pass<2, true>(afY, afX, lds, 0, i32, hh, ssq[0], ssq[1], wrs, wvo, wso + N1 * 8192); pf_mid<0>(pf, rc, rr, tid);
            z_pass<2, false>(afY, afX, lds, 2, i32, hh, ssq[2], ssq[3], wrs, wvo, 0);
            z_pass<2, true>(afX, afY, lds, 0, i32, hh, ssq[0], ssq[1], wrs, wvo, wso + N2 * 8192); pf_mid<1>(pf, rc, rr, tid);
            z_pass<2, false>(afX, afY, lds, 2, i32, hh, ssq[2], ssq[3], wrs, wvo, 0);
            z_pass<2, true>(afY, afX, lds, 0, i32, hh, ssq[0], ssq[1], wrs, wvo, wso + N3 * 8192); pf_mid<2>(pf, rc, rr, tid);
            z_pass<2, false>(afY, afX, lds, 2, i32, hh, ssq[2], ssq[3], wrs, wvo, 0);
            z_pass<2, false>(afX, afY, lds, 0, i32, hh, ssq[0], ssq[1], wrs, wvo, 0); pf_mid<3>(pf, rc, rr, tid);
            z_pass<2, false>(afX, afY, lds, 2, i32, hh, ssq[2], ssq[3], wrs, wvo, 0);
            pf_mid<4>(pf, rc, rr, tid);
        }
#ifdef PROBE_Z3
        if (!FRESH) {
            for (int rz_ = 0; rz_ < 2; ++rz_) {
                ssq[0] = ssq[1] = ssq[2] = ssq[3] = 0.f;
                const bool fwd = ((PAR == 0) == (rz_ == 1));
                if (fwd) {
                    z_pass<2, true>(afX, afY, lds, 0, i32, hh, ssq[0], ssq[1], wrs, wvo, wso + 1 * 8192); z_pass<2, false>(afX, afY, lds, 2, i32, hh, ssq[2], ssq[3], wrs, wvo, 0);
                    z_pass<2, true>(afY, afX, lds, 0, i32, hh, ssq[0], ssq[1], wrs, wvo, wso + 2 * 8192); z_pass<2, false>(afY, afX, lds, 2, i32, hh, ssq[2], ssq[3], wrs, wvo, 0);
                    z_pass<2, true>(afX, afY, lds, 0, i32, hh, ssq[0], ssq[1], wrs, wvo, wso + 3 * 8192); z_pass<2, false>(afX, afY, lds, 2, i32, hh, ssq[2], ssq[3], wrs, wvo, 0);
                    z_pass<2, false>(afY, afX, lds, 0, i32, hh, ssq[0], ssq[1], wrs, wvo, 0); z_pass<2, false>(afY, afX, lds, 2, i32, hh, ssq[2], ssq[3], wrs, wvo, 0);
                } else {
                    z_pass<2, true>(afY, afX, lds, 0, i32, hh, ssq[0], ssq[1], wrs, wvo, wso + 2 * 8192); z_pass<2, false>(afY, afX, lds, 2, i32, hh, ssq[2], ssq[3], wrs, wvo, 0);
                    z_pass<2, true>(afX, afY, lds, 0, i32, hh, ssq[0], ssq[1], wrs, wvo, wso + 1 * 8192); z_pass<2, false>(afX, afY, lds, 2, i32, hh, ssq[2], ssq[3], wrs, wvo, 0);
                    z_pass<2, true>(afY, afX, lds, 0, i32, hh, ssq[0], ssq[1], wrs, wvo, wso + 0 * 8192); z_pass<2, false>(afY, afX, lds, 2, i32, hh, ssq[2], ssq[3], wrs, wvo, 0);
                    z_pass<2, false>(afX, afY, lds, 0, i32, hh, ssq[0], ssq[1], wrs, wvo, 0); z_pass<2, false>(afX, afY, lds, 2, i32, hh, ssq[2], ssq[3], wrs, wvo, 0);
                }
            }
        }
#endif
        constexpr int ntb = FRESH ? 1 : 4;
        float sqr[ntb];
#pragma unroll
        for (int tb = 0; tb < ntb; ++tb) sqr[tb] = SSQR[tb * 32 + i32];
#pragma unroll
        for (int tb = 0; tb < ntb; ++tb) { float s = ssq[tb]; s += __shfl_xor(s, 32);
            if (hh == 0) RINV[w * 128 + tb * 32 + i32] = __builtin_amdgcn_rsqf((s * (1.f / 256.f) + sqr[tb]) * (1.f / 192.f) + EPS); }
    }
    __syncthreads();
    int tid2 = tid; asm volatile("" : "+v"(tid2));
#ifdef PROBE_SPV2
    for (int rep_ = 0; rep_ < 2; ++rep_) {
    if (rep_) __syncthreads();
#else
    {
#endif
    const int lane = tid2 & 63, i32 = lane & 31, hh = lane >> 5;
    {
        const int tb = w & 3, rb = w >> 2;
        if (!FRESH || tb == 0) {
            f32x16 s = zero16();
            const LAS bf16_t* qa = QA + (rb * 32 + i32) * SM_QP + 8 * hh;
#define S_A(ks_) ((ks_) < 16 ? *(LAS bf16x8*)(lds + SM_CT + ct_off(tb * 32 + i32, 16 * (ks_) + 8 * hh)) : *(LAS bf16x8*)(lds + SM_RT + rt_off(tb * 32 + i32, 16 * ((ks_) - 16) + 8 * hh)))
#define S_B(ks_) (*(const LAS bf16x8*)(qa + ((ks_) < 16 ? 16 * (ks_) : 256 + 16 * ((ks_) - 16))))
            constexpr int SD = 4;
            const int head = rb * 4 + (i32 >> 3), qi = i32 & 7;
            const LAS float* rv = RINV + head * 128 + tb * 32 + 4 * hh;
            f32x4 r4v[4];
#pragma unroll
            for (int g4 = 0; g4 < 4; ++g4) r4v[g4] = *(const LAS f32x4*)(rv + 8 * g4);
            const float m2 = M2S[rb * 32 + i32];
            bf16x8 sa_[SD], sb_[SD];
#pragma unroll
            for (int ks = 0; ks < SD; ++ks) { sa_[ks] = S_A(ks); sb_[ks] = S_B(ks); }
            __builtin_amdgcn_sched_barrier(0);
#pragma unroll
            for (int ks = 0; ks < 20; ++ks) { s = mfma32(sa_[ks % SD], sb_[ks % SD], s);
                if (ks + SD < 20) { sa_[ks % SD] = S_A(ks + SD); sb_[ks % SD] = S_B(ks + SD); }
                __builtin_amdgcn_sched_barrier(0); }
#undef S_A
#undef S_B
#pragma unroll
            for (int g4 = 0; g4 < 4; ++g4) { const f32x4 r4 = r4v[g4]; float p[4];
#pragma unroll
                for (int e = 0; e < 4; ++e) { float x = s[4 * g4 + e] * r4[e] - m2; if (FRESH && (8 * g4 + 4 * hh + e) > qi) x = -__builtin_inff(); p[e] = ex2(x); lsum += p[e]; }
                u32x2 pw; pw.x = pk2(p[0], p[1]); pw.y = pk2(p[2], p[3]);
                *(LAS u32x2*)(PT + (rb * 32 + i32) * SM_PP + tb * 32 + 8 * g4 + 4 * hh) = pw; }
        }
    }
#ifdef PROBE_SPV2
    if (!FRESH && rep_ == 0) pf_mid<5>(pf, rc, rr, tid);
#else
    if (!FRESH) pf_mid<5>(pf, rc, rr, tid);
#endif
    __syncthreads();
    {
        const int rb = w >> 2, lb0 = 2 * (w & 3), nks = FRESH ? 2 : 8;
        const int blk = (lane >> 4) & 1, qq = (lane & 15) >> 2, pp = lane & 3;
        const LAS bf16_t* pt = PT + (rb * 32 + i32) * SM_PP + 8 * hh;
        constexpr int NKS = FRESH ? 2 : 8, PD = 2;
        (void)nks;
        bf16x8 pb_[PD]; s16x4 pt0_[PD][2], pt1_[PD][2];
        LAS unsigned char* pvb[2][2];
#pragma unroll
        for (int q = 0; q < 2; ++q) { const int r0 = 8 * hh + qq, col = (lb0 + q) * 32 + 16 * blk + 4 * pp;
            pvb[q][0] = lds + SM_CT + ct_off(r0, col); pvb[q][1] = lds + SM_CT + ct_off(r0 + 4, col); }
#define PV_FETCH(slot_, ks_) do { pb_[slot_] = *(const LAS bf16x8*)(pt + 16 * (ks_)); _Pragma("unroll") for (int q = 0; q < 2; ++q) { \
            pt0_[slot_][q] = __builtin_amdgcn_ds_read_tr16_b64_v4i16((LAS s16x4*)(pvb[q][0] + 4096 * (ks_))); \
            pt1_[slot_][q] = __builtin_amdgcn_ds_read_tr16_b64_v4i16((LAS s16x4*)(pvb[q][1] + 4096 * (ks_))); } } while (0)
#pragma unroll
        for (int ks = 0; ks < PD; ++ks) PV_FETCH(ks, ks);
        __builtin_amdgcn_sched_barrier(0);
#pragma unroll
        for (int ks = 0; ks < NKS; ++ks) {
#pragma unroll
            for (int q = 0; q < 2; ++q) { const s16x4 t0 = pt0_[ks % PD][q], t1 = pt1_[ks % PD][q];
                const bf16x8 a = {t0[0], t0[1], t0[2], t0[3], t1[0], t1[1], t1[2], t1[3]};
                oacc[q] = mfma32(a, pb_[ks % PD], oacc[q]); }
            if (ks + PD < NKS) PV_FETCH(ks % PD, ks + PD);
            __builtin_amdgcn_sched_barrier(0);
        }
#undef PV_FETCH
    }
    }
    __syncthreads();
    if (!FRESH) {
        if (pfon) { pf_mid<6>(pf, rc, rr, tid); pf_commit(pf, lds, tid);
#ifdef PROBE_COMMIT2
            __syncthreads(); pf_commit(pf, lds, tid);
#endif
        }
        __syncthreads();
    }
}

__device__ __forceinline__ void smla_unit(Frame& F, const Params& P, int unit) {
    int tid = F.tid; asm volatile("" : "+v"(tid));
    const int lane = tid & 63, w = F.wave, i32 = lane & 31, hh = lane >> 5;
    const int bs = unit >> 1, half = unit & 1;
    LAS unsigned char* lds = F.lds;
    LAS bf16_t* QA = (LAS bf16_t*)(lds + SM_QA);
    LAS float* M2S = (LAS float*)(lds + SM_M2); LAS float* LX = (LAS float*)(lds + SM_LX);
    const int* ptab = (const int*)P.in[9] + bs * NPAGES + half * 32;
    const int ptv = (lane < 32) ? ptab[lane] : -1;
#define PTAB(i_) __builtin_amdgcn_readlane(ptv, (i_))
    smla_load_page(P, lds, PTAB(0), tid);
    {
        const int qi = lane & 7, grow = NP + bs * 8 + qi;
        const float* sp = WSP(float, WS_SSQ_Q) + ((size_t)grow * 8 + w) * 8;
        const float sr = (sp[0] + sp[2]) + (sp[4] + sp[6]), sg = (sp[1] + sp[3]) + (sp[5] + sp[7]);
        const float rinv = 1.0f / sqrtf(sr * (1.f / 192.f) + EPS);
        if (lane < 8) M2S[w * 8 + lane] = 13.856406460551018f * rinv * sqrtf(sg);
        const float ra = __shfl(rinv, i32 & 7);
        const bf16_t* qp = WSP(bf16_t, WS_QG) + (size_t)(NP + bs * 8 + (i32 & 7)) * 1536 + w * 192 + 8 * hh;
        bf16x8 aq[8];
        u32x4 qraw[8];
#pragma unroll
        for (int ks = 0; ks < 8; ++ks) qraw[ks] = *(const u32x4*)(qp + 16 * ks);
        __builtin_amdgcn_sched_barrier(0);
#pragma unroll
        for (int ks = 0; ks < 8; ++ks) { const u32x4 v = qraw[ks]; u32x4 o;
            o.x = pk2(bflo(v.x) * ra, bfhi(v.x) * ra); o.y = pk2(bflo(v.y) * ra, bfhi(v.y) * ra); o.z = pk2(bflo(v.z) * ra, bfhi(v.z) * ra); o.w = pk2(bflo(v.w) * ra, bfhi(v.w) * ra);
            aq[ks] = __builtin_bit_cast(bf16x8, o); }
        const bf16_t* wb = WSP(bf16_t, WS_WKV_B) + (size_t)i32 * 2048 + w * 256 + 8 * hh;
        bf16x8 wf0[8], wf1[8];
#pragma unroll
        for (int ks = 0; ks < 8; ++ks) wf0[ks] = *(const bf16x8*)(wb + 16 * ks);
#pragma unroll 1
        for (int lp = 0; lp < 4; ++lp) {
            const int lb1 = 2 * lp + 1, lb2 = (2 * lp + 2) & 7;
#pragma unroll
            for (int ks = 0; ks < 8; ++ks) wf1[ks] = *(const bf16x8*)(wb + (size_t)lb1 * 32 * 2048 + 16 * ks);
            __builtin_amdgcn_sched_barrier(0);
            { f32x16 acc = zero16();
#pragma unroll
              for (int ks = 0; ks < 8; ++ks) acc = mfma32(aq[ks], wf0[ks], acc);
#pragma unroll
              for (int r = 0; r < 4; ++r) QA[(w * 8 + r + 4 * hh) * SM_QP + (2 * lp) * 32 + i32] = (bf16_t)f2bf(acc[r]); }
            __builtin_amdgcn_sched_barrier(0);
#pragma unroll
            for (int ks = 0; ks < 8; ++ks) wf0[ks] = *(const bf16x8*)(wb + (size_t)lb2 * 32 * 2048 + 16 * ks);
            __builtin_amdgcn_sched_barrier(0);
            { f32x16 acc = zero16();
#pragma unroll
              for (int ks = 0; ks < 8; ++ks) acc = mfma32(aq[ks], wf1[ks], acc);
#pragma unroll
              for (int r = 0; r < 4; ++r) QA[(w * 8 + r + 4 * hh) * SM_QP + lb1 * 32 + i32] = (bf16_t)f2bf(acc[r]); }
            __builtin_amdgcn_sched_barrier(0);
        }
        { const int q2 = lane >> 3, c8 = (lane & 7) * 8; const float rq = __shfl(rinv, q2);
          const u32x4 v = *(const u32x4*)(WSP(bf16_t, WS_QG) + (size_t)(NP + bs * 8 + q2) * 1536 + w * 192 + 128 + c8); u32x4 o;
          o.x = pk2(bflo(v.x) * rq, bfhi(v.x) * rq); o.y = pk2(bflo(v.y) * rq, bfhi(v.y) * rq); o.z = pk2(bflo(v.z) * rq, bfhi(v.z) * rq); o.w = pk2(bflo(v.w) * rq, bfhi(v.w) * rq);
          *(LAS u32x4*)(QA + (w * 8 + q2) * SM_QP + 256 + c8) = o; }
    }
    f32x16 oacc[2]; oacc[0] = zero16(); oacc[1] = zero16();
    float lsum = 0.f;
    u32x4 afX[8], afY[8];
    const __amdgpu_buffer_rsrc_t wrs = __builtin_amdgcn_make_buffer_rsrc((void*)(F.ws + WS_W8F), 0, 32 * 4 * 2048, 0x00020000);
    z_load(afX, wrs, lane * 32, w * 32768);
    __syncthreads();
#ifdef NO_PF
    for (int tl = 0; tl < 32; tl += 2) {
        if (tl) { smla_load_page(P, lds, PTAB(tl), tid); __syncthreads(); }
        smla_tile<0, false>(F, P, -1, oacc, lsum, afX, afY, wrs);
        smla_load_page(P, lds, PTAB(tl + 1), tid); __syncthreads();
        smla_tile<1, false>(F, P, -1, oacc, lsum, afX, afY, wrs);
    }
#else
    for (int tl = 0; tl < 32; tl += 2) {
        smla_tile<0, false>(F, P, PTAB(tl + 1), oacc, lsum, afX, afY, wrs);
        smla_tile<1, false>(F, P, PTAB(tl + 2), oacc, lsum, afX, afY, wrs);
    }
#endif
    if (half) { smla_load_fresh(F, lds, bs, tid); __syncthreads(); smla_tile<0, true>(F, P, -1, oacc, lsum, afX, afY, wrs); }
    {
        LAS bf16_t* OL = (LAS bf16_t*)(lds + SM_CT);
        int le = tid; asm volatile("" : "+v"(le)); le &= 63;
        const int i32 = le & 31, hh = le >> 5;
        const int rb = w >> 2, lb0 = 2 * (w & 3);
#pragma unroll
        for (int q = 0; q < 2; ++q)
#pragma unroll
            for (int g4 = 0; g4 < 4; ++g4) { u32x2 pw; pw.x = pk2(oacc[q][4 * g4], oacc[q][4 * g4 + 1]); pw.y = pk2(oacc[q][4 * g4 + 2], oacc[q][4 * g4 + 3]);
                *(LAS u32x2*)(OL + (rb * 32 + i32) * 264 + (lb0 + q) * 32 + 8 * g4 + 4 * hh) = pw; }
        LX[w * 64 + le] = lsum;
        __syncthreads();
        const LAS bf16_t* ar = OL + (w * 8 + (i32 & 7)) * 264 + 8 * hh;
        bf16x8 ao[16];
#pragma unroll
        for (int ks = 0; ks < 16; ++ks) ao[ks] = *(const LAS bf16x8*)(ar + 16 * ks);
        float* yp = WSP(float, WS_YPS) + ((size_t)(bs * 2 + half) * 64 + w * 8) * 128;
        const bf16_t* wt0 = WSP(bf16_t, WS_WKV_T) + (size_t)(w * 256 + 128 + i32) * 256 + 8 * hh;
        bf16x8 vf0[16], vf1[16];
#pragma unroll
        for (int ks = 0; ks < 16; ++ks) vf0[ks] = *(const bf16x8*)(wt0 + 16 * ks);
#pragma unroll 1
        for (int np = 0; np < 2; ++np) {
            const int nb1 = 2 * np + 1, nb2 = (2 * np + 2) & 3;
#pragma unroll
            for (int ks = 0; ks < 16; ++ks) vf1[ks] = *(const bf16x8*)(wt0 + (size_t)nb1 * 32 * 256 + 16 * ks);
            __builtin_amdgcn_sched_barrier(0);
            { f32x16 acc = zero16();
#pragma unroll
              for (int ks = 0; ks < 16; ++ks) acc = mfma32(ao[ks], vf0[ks], acc);
#pragma unroll
              for (int r = 0; r < 4; ++r) yp[(size_t)(r + 4 * hh) * 128 + (2 * np) * 32 + i32] = acc[r]; }
            __builtin_amdgcn_sched_barrier(0);
#pragma unroll
            for (int ks = 0; ks < 16; ++ks) vf0[ks] = *(const bf16x8*)(wt0 + (size_t)nb2 * 32 * 256 + 16 * ks);
            __builtin_amdgcn_sched_barrier(0);
            { f32x16 acc = zero16();
#pragma unroll
              for (int ks = 0; ks < 16; ++ks) acc = mfma32(ao[ks], vf1[ks], acc);
#pragma unroll
              for (int r = 0; r < 4; ++r) yp[(size_t)(r + 4 * hh) * 128 + nb1 * 32 + i32] = acc[r]; }
            __builtin_amdgcn_sched_barrier(0);
        }
        if (le < 8) { const int r32 = (w & 3) * 8 + le; float l = 0.f;
#pragma unroll
            for (int tb = 0; tb < 4; ++tb) l += LX[((w >> 2) * 4 + tb) * 64 + r32] + LX[((w >> 2) * 4 + tb) * 64 + 32 + r32];
            WSP(float, WS_LPS)[(size_t)(bs * 2 + half) * 64 + w * 8 + le] = l; }
        __syncthreads();
    }
}

__device__ __forceinline__ void smem_unit(Frame& F, const Params& P, int unit) {
    int tid = F.tid; asm volatile("" : "+v"(tid));
    const int lane = tid & 63, w = F.wave, bs = unit >> 1, hp = unit & 1;
    LAS float* Qs = (LAS float*)F.lds;
    LAS float* Ps = Qs + 2048;
    LAS float* Ls = Ps + 4096;
    LAS float* Xs = Ls + 64;
    { const int i = tid >> 6, hl = (tid >> 5) & 1, c4 = (tid & 31) * 4;
      const u32x2 v = *(const u32x2*)(WSP(bf16_t, WS_QM) + (size_t)(NP + bs * 8 + i) * 512 + (2 * hp + hl) * 128 + c4);
      *(LAS f32x4*)(Qs + (i * 2 + hl) * 128 + c4) = (f32x4){bflo(v.x), bfhi(v.x), bflo(v.y), bfhi(v.y)}; }
    { const int key = tid & 255, hl = tid >> 8, hd = 2 * hp + hl;
      const f32x4* kp = (const f32x4*)(P.in[5] + ((size_t)(bs * MEMT + key) * 4 + hd) * 128);
      f32x4 kv[32];
#pragma unroll
      for (int j4 = 0; j4 < 32; ++j4) kv[j4] = kp[j4];
      float mq[8];
#pragma unroll
      for (int i = 0; i < 8; ++i) mq[i] = WSP(float, WS_MQM)[(NP + bs * 8 + i) * 4 + hd];
      __syncthreads();
      __builtin_amdgcn_sched_barrier(0);
      float acc[8] = {0.f, 0.f, 0.f, 0.f, 0.f, 0.f, 0.f, 0.f};
#pragma unroll
      for (int j4 = 0; j4 < 32; ++j4) {
#pragma unroll
          for (int i = 0; i < 8; ++i) { const f32x4 qv = *(LAS f32x4*)(Qs + (i * 2 + hl) * 128 + 4 * j4); acc[i] += (kv[j4].x * qv.x + kv[j4].y * qv.y) + (kv[j4].z * qv.z + kv[j4].w * qv.w); } }
#pragma unroll
      for (int i = 0; i < 8; ++i) Ps[(hl * 8 + i) * 256 + key] = ex2(acc[i] - mq[i]); }
    __builtin_amdgcn_sched_barrier(0);
    int tid2 = tid; asm volatile("" : "+v"(tid2));
    const int dv4 = tid2 & 31, hl2 = w & 1, kq = (w >> 1) * 2 + ((tid2 >> 5) & 1), hd2 = 2 * hp + hl2;
    {
      const f32x4* vp = (const f32x4*)(P.in[6] + ((size_t)(bs * MEMT + kq * 32) * 4 + hd2) * 128) + dv4;
      f32x4 vv[32];
#pragma unroll
      for (int k = 0; k < 32; ++k) vv[k] = vp[(size_t)k * 128];
      __syncthreads();
      __builtin_amdgcn_sched_barrier(0);
#pragma unroll
      for (int q = 0; q < 2; ++q) { const int r = 2 * w + q; const LAS float* p = Ps + r * 256 + lane;
          const float s = wave_sum((p[0] + p[64]) + (p[128] + p[192])); if (lane == 0) Ls[r] = s; }
      f32x4 acc[8];
#pragma unroll
      for (int i = 0; i < 8; ++i) acc[i] = (f32x4){0.f, 0.f, 0.f, 0.f};
#pragma unroll
      for (int k4 = 0; k4 < 8; ++k4) {
#pragma unroll
          for (int i = 0; i < 8; ++i) { const f32x4 pv = *(LAS f32x4*)(Ps + (hl2 * 8 + i) * 256 + kq * 32 + 4 * k4);
              acc[i] += (vv[4 * k4] * pv.x + vv[4 * k4 + 1] * pv.y) + (vv[4 * k4 + 2] * pv.z + vv[4 * k4 + 3] * pv.w); } }
#pragma unroll
      for (int i = 0; i < 8; ++i) *(LAS f32x4*)(Xs + ((kq * 8 + i) * 2 + hl2) * 128 + 4 * dv4) = acc[i];
    }
    __syncthreads();
    { const int i = tid2 >> 6, hl = (tid2 >> 5) & 1, hd = 2 * hp + hl;
      f32x4 o = (f32x4){0.f, 0.f, 0.f, 0.f};
#pragma unroll
      for (int g = 0; g < 8; ++g) o += *(LAS f32x4*)(Xs + ((g * 8 + i) * 2 + hl) * 128 + 4 * dv4);
      const float rl = 1.0f / Ls[hl * 8 + i];
      u32x2 ow; ow.x = pk2(o.x * rl, o.y * rl); ow.y = pk2(o.z * rl, o.w * rl);
      *(u32x2*)(WSP(bf16_t, WS_YMEM) + (size_t)(NP + bs * 8 + i) * 512 + hd * 128 + 4 * dv4) = ow; }
    __syncthreads();
}

__device__ __forceinline__ float silu_(float g) { return g * __builtin_amdgcn_rcpf(1.0f + ex2(-g * LOG2E)); }
__device__ __forceinline__ void unpack8(const u32x4 v, float* f) { f[0] = bflo(v.x); f[1] = bfhi(v.x); f[2] = bflo(v.y); f[3] = bfhi(v.y); f[4] = bflo(v.z); f[5] = bfhi(v.z); f[6] = bflo(v.w); f[7] = bfhi(v.w); }
struct OpRow { u32x4 ys, ym, gs, gm, gl0, gl1, yl0, yl1; f32x4 pa[4], pc[4]; float l0, l1; };
__device__ __forceinline__ void oprep_load(Frame& F, OpRow& r, int row, int lane) {
    const bf16_t* gates = WSP(bf16_t, WS_GATES) + (size_t)row * 2048;
    r.ys = *(const u32x4*)(WSP(bf16_t, WS_YSSM) + (size_t)row * 512 + 8 * lane); r.ym = *(const u32x4*)(WSP(bf16_t, WS_YMEM) + (size_t)row * 512 + 8 * lane);
    r.gs = *(const u32x4*)(gates + 8 * lane); r.gm = *(const u32x4*)(gates + 1536 + 8 * lane); r.gl0 = *(const u32x4*)(gates + 512 + 16 * lane); r.gl1 = *(const u32x4*)(gates + 512 + 16 * lane + 8);
    if (row < NP) { r.yl0 = *(const u32x4*)(WSP(bf16_t, WS_YMLA) + (size_t)row * 1024 + 16 * lane); r.yl1 = *(const u32x4*)(WSP(bf16_t, WS_YMLA) + (size_t)row * 1024 + 16 * lane + 8); }
    else { const int sr = row - NP, bs = sr >> 3, qi = sr & 7, h = lane >> 3, dv0 = (lane & 7) * 16;
        const size_t r0 = (size_t)(bs * 2) * 64 + h * 8 + qi, r1 = r0 + 64;
        r.l0 = WSP(float, WS_LPS)[r0]; r.l1 = WSP(float, WS_LPS)[r1];
        const f32x4* a = (const f32x4*)(WSP(float, WS_YPS) + r0 * 128 + dv0); const f32x4* c = (const f32x4*)(WSP(float, WS_YPS) + r1 * 128 + dv0);
#pragma unroll
        for (int q = 0; q < 4; ++q) { r.pa[q] = a[q]; r.pc[q] = c[q]; } }
}
__device__ __forceinline__ void oprep_finish(Frame& F, const Params& P, const OpRow& r, int row, int lane) {
    bf16_t* orow = WSP(bf16_t, WS_O) + (size_t)row * 2048;
    const float* g_ssm = P.in[33]; const float* g_mla = P.in[34]; const float* g_mem = P.in[35];
#pragma unroll
    for (int part = 0; part < 2; ++part) {
        const float* gn = (part == 0 ? g_ssm : g_mem) + 8 * lane;
        const int oc = (part == 0 ? 0 : 1536) + 8 * lane;
        float y[8], gt[8]; unpack8(part == 0 ? r.ys : r.ym, y); unpack8(part == 0 ? r.gs : r.gm, gt);
        float s = 0.f;
#pragma unroll
        for (int e = 0; e < 8; ++e) s += y[e] * y[e];
        const float rinv = 1.0f / sqrtf(wave_sum(s) * (1.f / 512.f) + EPS);
        float o[8];
#pragma unroll
        for (int e = 0; e < 8; ++e) o[e] = y[e] * rinv * gn[e] * silu_(gt[e]);
        u32x4 wv; wv.x = pk2(o[0], o[1]); wv.y = pk2(o[2], o[3]); wv.z = pk2(o[4], o[5]); wv.w = pk2(o[6], o[7]);
        *(u32x4*)(orow + oc) = wv;
    }
    {
        float y[16];
        if (row < NP) { unpack8(r.yl0, &y[0]); unpack8(r.yl1, &y[8]); }
        else { const float inv = 1.0f / (r.l0 + r.l1);
#pragma unroll
            for (int q = 0; q < 4; ++q) { const f32x4 v = (r.pa[q] + r.pc[q]) * inv; y[4 * q] = v.x; y[4 * q + 1] = v.y; y[4 * q + 2] = v.z; y[4 * q + 3] = v.w; } }
        float gt[16]; unpack8(r.gl0, &gt[0]); unpack8(r.gl1, &gt[8]);
        float s = 0.f;
#pragma unroll
        for (int e = 0; e < 16; ++e) s += y[e] * y[e];
        const float rinv = 1.0f / sqrtf(wave_sum(s) * (1.f / 1024.f) + EPS);
        const float* gn = g_mla + 16 * lane;
        float o[16];
#pragma unroll
        for (int e = 0; e < 16; ++e) o[e] = y[e] * rinv * gn[e] * silu_(gt[e]);
        u32x4 w0, w1; w0.x = pk2(o[0], o[1]); w0.y = pk2(o[2], o[3]); w0.z = pk2(o[4], o[5]); w0.w = pk2(o[6], o[7]);
        w1.x = pk2(o[8], o[9]); w1.y = pk2(o[10], o[11]); w1.z = pk2(o[12], o[13]); w1.w = pk2(o[14], o[15]);
        *(u32x4*)(orow + 512 + 16 * lane) = w0; *(u32x4*)(orow + 512 + 16 * lane + 8) = w1;
    }
}
__device__ __forceinline__ void oprep_rows(Frame& F, const Params& P) {
    int tid = F.tid; asm volatile("" : "+v"(tid));
    const int gw = F.bid * 8 + F.wave, NGW = F.G * 8, lane = tid & 63;
    for (int row = gw; row < NR; row += 2 * NGW) {
        const int row2 = row + NGW; const bool has2 = row2 < NR;
        OpRow ra, rb;
        oprep_load(F, ra, row, lane);
        if (has2) oprep_load(F, rb, row2, lane);
        __builtin_amdgcn_sched_barrier(0);
        oprep_finish(F, P, ra, row, lane);
        if (has2) oprep_finish(F, P, rb, row2, lane);
    }
}


struct SchedP1 {
    pg8::StaticOrder a, b; int G, c;
    __device__ void init(int G_, int c_) { G = G_; c = c_; a.init(27 * 256, 4096, G_, c_); b.init(9 * 256, 2048, 1 << 20, 0); }
    __device__ bool next(int i, pg8::Unit& u) const {
        const int L = i * G + c;
        if (L < 432) return a.next(i, u);
        if (L >= 504) return false;
        pg8::StaticOrder t = b; t.c = L - 432; const bool ok = t.next(0, u); u.pm += 27; return ok;
    }
    __device__ __forceinline__ void a_ready(const pg8::Unit&) const {}
    __device__ __forceinline__ void done(const pg8::Unit&) const {}
};
struct SchedGates {
    pg8::StaticOrder b;
    __device__ void init(int c_) { b.init(9 * 256, 2048, 1 << 20, c_); }
    __device__ bool next(int i, pg8::Unit& u) const { if (i > 0) return false; const bool ok = b.next(0, u); u.pm += 27; u.pn += 8; return ok; }
    __device__ __forceinline__ void a_ready(const pg8::Unit&) const {}
    __device__ __forceinline__ void done(const pg8::Unit&) const {}
};
#ifndef PH
#define PH 4095
#endif
#ifndef REP_SMLA
#define REP_SMLA 1
#endif
#ifndef REP_ATT
#define REP_ATT 1
#endif
#ifndef REP_P1
#define REP_P1 1
#endif
#ifndef REP_P5
#define REP_P5 1
#endif
#ifndef REP_P0
#define REP_P0 1
#endif
#ifndef REP_P2
#define REP_P2 1
#endif
#ifndef REP_P3R
#define REP_P3R 1
#endif
#ifndef REP_P4
#define REP_P4 1
#endif
#ifndef REP_MEMP
#define REP_MEMP 1
#endif
#ifndef REP_SSM1
#define REP_SSM1 1
#endif
#ifndef REP_SMEM
#define REP_SMEM 1
#endif
__global__ void __launch_bounds__(512, 2) hymba_fwd(Params P) {
    extern __shared__ __attribute__((aligned(16))) unsigned char lds_raw[];
    Frame F;
    F.lds = (LAS unsigned char*)lds_raw; F.ws = P.ws; F.out = P.out;
    F.tid = threadIdx.x; F.lane = F.tid & 63; F.wave = __builtin_amdgcn_readfirstlane(F.tid >> 6); F.G = gridDim.x; F.bid = blockIdx.x;
    volatile LAS unsigned* MISC = (volatile LAS unsigned*)(F.lds + LDS_MISC);
    if (F.tid < 16) MISC[F.tid] = 0u;
    __syncthreads();
    XcdBarrier bar = xcd_barrier_post((unsigned*)(P.ws + WS_CTL), MISC);

#if PH & 1
    for (int rep_ = 0; rep_ < REP_P0; ++rep_) { if (rep_) __syncthreads(); p0_prologue(F, P); }
#endif
    xcd_barrier(bar);

#if PH & 2
    for (int rep_ = 0; rep_ < REP_P1; ++rep_) {
        if (rep_) __syncthreads();
        pg8::Gemm g{WSP(bf16_t, WS_XN), WSP(bf16_t, WS_WIN_T), NR, NIN, 2048}; SchedP1 S; S.init(F.G, F.bid);
        EpiInProj E{WSP(float, WS_UF), WSP(bf16_t, WS_CQ), WSP(float, WS_SSQ_CQ), WSP(float, WS_CKVF), WSP(bf16_t, WS_CKVB), WSP(float, WS_SSQ_CKV), WSP(bf16_t, WS_QMR), WSP(float, WS_SSQ_QM), WSP(float, WS_KRF), WSP(bf16_t, WS_GATES)};
        pg8::gemm_phase<EpiInProj, SchedP1, false>(F.lds, g, S, E, nullptr);
        __syncthreads();
        pg8::Gemm g2{WSP(bf16_t, WS_MEMN), WSP(bf16_t, WS_MEMKV_T), 512, 1024, 2048}; pg8::StaticOrder S2; S2.init(512, 1024, F.G, F.G - 1 - F.bid);
        EpiMemKV E2{WSP(float, WS_MKRAW), WSP(float, WS_SSQ_MK), F.out + O_MV, WSP(bf16_t, WS_VTM)};
        pg8::gemm_phase<EpiMemKV, pg8::StaticOrder, false>(F.lds, g2, S2, E2, nullptr);
    }
#endif
    xcd_barrier(bar);

    for (int rep_ = 0; rep_ < REP_P2; ++rep_) {
        if (rep_) __syncthreads();
#if PH & 4
        const bool gw = (F.bid >= 184);
        {
            pg8::Gemm gg{WSP(bf16_t, WS_XN), WSP(bf16_t, WS_WIN_T), NR, NIN, 2048}; SchedGates SG; SG.init(gw ? F.bid - 184 : (1 << 20));
            EpiInProj EG{WSP(float, WS_UF), WSP(bf16_t, WS_CQ), WSP(float, WS_SSQ_CQ), WSP(float, WS_CKVF), WSP(bf16_t, WS_CKVB), WSP(float, WS_SSQ_CKV), WSP(bf16_t, WS_QMR), WSP(float, WS_SSQ_QM), WSP(float, WS_KRF), WSP(bf16_t, WS_GATES)};
            pg8::gemm_phase<EpiInProj, SchedGates, false>(F.lds, gg, SG, EG, nullptr);
            __syncthreads();
        }
        const bool sw = (F.bid >= 96 && F.bid < 128);
        const int jq = (gw || sw) ? (1 << 20) : (F.bid < 96 ? F.bid : F.bid - 32);
        pg8::Gemm g{WSP(bf16_t, WS_CQ), WSP(bf16_t, WS_WUQ_T), NR, 2048, 512}; pg8::StaticOrder S; S.init(NR, 2048, 152, jq);
        EpiQ E{WSP(float, WS_SSQ_CQ), WSP(float, WS_QCG), WSP(bf16_t, WS_QG), WSP(float, WS_SSQ_Q)};
        pg8::gemm_phase<EpiQ, pg8::StaticOrder, false>(F.lds, g, S, E, nullptr);
        __syncthreads();
        pg8::Gemm g2{WSP(bf16_t, WS_CKVB), WSP(bf16_t, WS_WKV_TG), NP, 2048, 256}; pg8::StaticOrder S2; S2.init(NP, 2048, 152, (gw || sw) ? (1 << 20) : 151 - jq);
        EpiKV E2{WSP(float, WS_SSQ_CKV), WSP(bf16_t, WS_KNB), WSP(float, WS_SSQ_KN), WSP(bf16_t, WS_VT)};
        pg8::gemm_phase<EpiKV, pg8::StaticOrder, false>(F.lds, g2, S2, E2, nullptr);
        __syncthreads();
#endif
#if PH & 8
        p2a_rows(F, P);
#endif
#if PH & 16
        for (int u = F.bid; u < 256; u += F.G) ssm_unit<0>(F, P, u);
#ifndef REP_SSM2
#define REP_SSM2 1
#endif
        for (int r2_ = 0; r2_ < REP_SSM2; ++r2_)
        if (F.bid >= 96 && F.bid < 128) ssm_unit<2>(F, P, F.bid - 96);
#endif
    }
    xcd_barrier(bar);

    {
#if (PH & 96) == 96
#ifndef STG_SH
#define STG_SH 3
#endif
        #ifdef STG_Q
        const bool smf_ = (STG_Q == 1) ? (((F.bid >> 3) & 3) == 0) : (((F.bid >> 3) & 3) != 3);
#else
        const bool smf_ = ((F.bid >> STG_SH) & 1) == 0;
#endif
        if (smf_) { for (int u = F.bid; u < 256; u += F.G) smla_unit(F, P, u); }
        for (int v = F.bid; v < 256; v += F.G) { const int u = (F.G == 256) ? ((v & 7) << 5) | (v >> 3) : v; const int b = u >> 7, h = (u >> 4) & 7, i = u & 15; attn_qblock<true>(F, b, h, 31 - i); attn_qblock<true>(F, b, h, i, true); }
        if (!smf_) { for (int u = F.bid; u < 256; u += F.G) smla_unit(F, P, u); }
#endif
#if PH & 128
        for (int r2_ = 0; r2_ < REP_MEMP; ++r2_) {
            if (F.G == 256) { if ((F.bid & 1) == 0) { for (int q = 0; q < 2; ++q) { const int u = F.bid + q; attn_qblock<false>(F, u >> 7, (u >> 5) & 3, u & 31); } } }
            else for (int u = F.bid; u < 256; u += F.G) attn_qblock<false>(F, u >> 7, (u >> 5) & 3, u & 31);
        }
#endif
#if PH & 256
        for (int r2_ = 0; r2_ < REP_SSM1; ++r2_)
        for (int u = F.bid; u < 256; u += F.G) ssm_unit<1>(F, P, u);
#endif
#if PH & 512
        for (int r2_ = 0; r2_ < REP_SMEM; ++r2_) {
            if (F.G == 256) { const int c = F.bid & 127; if (c < 96) smem_unit(F, P, F.bid); if (c < 32) smem_unit(F, P, F.bid + 96); }
            else for (int u = F.bid; u < 256; u += F.G) smem_unit(F, P, u);
        }
#endif
    }
    xcd_barrier(bar);

#if PH & 1024
    for (int rep_ = 0; rep_ < REP_P4; ++rep_) oprep_rows(F, P);
#endif
    xcd_barrier(bar);

#if PH & 2048
    {
        const bool two = (F.G == 256);
        const bool clsA = two && (((F.bid >> 3) & 1) == 0);
        const int ja = ((F.bid >> 4) << 3) | (F.bid & 7);
        const int tile = two ? (ja & 31) : (F.bid & 31), sl = two ? (ja >> 5) : (F.bid >> 5), ksl = two ? 512 : 256;
        pg8::Gemm g{WSP(bf16_t, WS_O), WSP(bf16_t, WS_WOUT_T), NP, 2048, 2048};
        EpiMerge E{P.in[0], P.in[1], F.out + O_Y};
        pg8::Gemm g2{WSP(bf16_t, WS_O) + (size_t)NP * 2048 + sl * ksl, WSP(bf16_t, WS_WOUT_T) + sl * ksl, NS, 2048, ksl, 2048};
        EpiPart E2{WSP(float, WS_PART) + (size_t)(sl & 7) * NS * 2048};
        for (int it = 0; it < 2; ++it) {
            SchedOne S2{tile >> 3, tile & 7, two ? (clsA && it == 0) : (it == 1 && F.bid < 256)};
            pg8::gemm_phase<EpiPart, SchedOne, false>(F.lds, g2, S2, E2, nullptr);
            __syncthreads();
            const bool pon = two ? ((it == 0) ? !clsA : clsA) : (it == 0);
            pg8::StaticOrder S; S.init(NP, 2048, F.G, pon ? F.bid : (1 << 20));
            pg8::gemm_phase<EpiMerge, pg8::StaticOrder, false>(F.lds, g, S, E, nullptr);
            __syncthreads();
        }
    }
    xcd_barrier(bar);
    {
        int tid = F.tid; asm volatile("" : "+v"(tid));
        const bool two = (F.G == 256);
        const f32x4* xs = (const f32x4*)P.in[1]; f32x4* ys = (f32x4*)(F.out + O_Y + (size_t)NP * 2048); const f32x4* pt = WSP(f32x4, WS_PART);
        for (int i = F.bid * 512 + tid; i < NS * 2048 / 4; i += F.G * 512) {
            f32x4 v[4];
#pragma unroll
            for (int s = 0; s < 4; ++s) v[s] = pt[(size_t)s * (NS * 2048 / 4) + i];
            f32x4 r = xs[i] + ((v[0] + v[1]) + (v[2] + v[3]));
            if (!two) {
#pragma unroll
                for (int s = 0; s < 4; ++s) v[s] = pt[(size_t)(4 + s) * (NS * 2048 / 4) + i];
                r += ((v[0] + v[1]) + (v[2] + v[3]));
            }
            ys[i] = r;
        }
    }
#endif
}

extern "C" void kernel_launch(void* const* d_in, const int* in_sizes, int n_in, void* d_out, int out_size, void* d_ws, size_t ws_size, hipStream_t stream) {
    static int grid = 0;
    if (grid == 0) {
        if (n_in != 37 || ws_size < WS_END) { fprintf(stderr, "kernel_launch: unexpected problem (n_in %d, ws %zu)\n", n_in, ws_size); grid = -1; return; }
        int dev = 0, cus = 0, per_cu = 0;
        if (hipGetDevice(&dev) != hipSuccess || hipDeviceGetAttribute(&cus, hipDeviceAttributeMultiprocessorCount, dev) != hipSuccess) { grid = -1; return; }
        if (hipFuncSetAttribute((const void*)hymba_fwd, hipFuncAttributeMaxDynamicSharedMemorySize, LDS_TOTAL) != hipSuccess) { fprintf(stderr, "kernel_launch: hipFuncSetAttribute failed\n"); grid = -1; return; }
        if (hipOccupancyMaxActiveBlocksPerMultiprocessor(&per_cu, (const void*)hymba_fwd, 512, LDS_TOTAL) != hipSuccess || per_cu < 1)
            fprintf(stderr, "kernel_launch: note: occupancy query reports %d workgroups per CU\n", per_cu);
        (void)hipGetLastError();
        grid = cus;
    }
    if (grid < 0) return;
    (void)in_sizes; (void)out_size;
    hipMemsetAsync((char*)d_ws + WS_CTL, 0, 16384, stream);
    Params p{};
    for (int i = 0; i < 37; ++i) p.in[i] = (const float*)d_in[i];
    p.out = (float*)d_out; p.ws = (unsigned char*)d_ws;
    hipLaunchKernelGGL(hymba_fwd, dim3(grid), dim3(512), LDS_TOTAL, stream, p);
}
```
